# Optimizing an MI355X kernel written in HIP

```python
import math
import jax, jax.numpy as jnp
from jax import lax
import numpy as np

D_MODEL = 1024
BATCH = 4
SEQ = 8192
DEPTH = 1

HEAD_DIM = 64
DIL_PAIRS = ((128, 1), (512, 4), (2048, 16))
N_GROUPS = len(DIL_PAIRS)
H_A = 8
H_B = 8
DV_B = 2 * HEAD_DIM
D_FF = 4 * D_MODEL
NUM_BUCKETS = 32
T5_MAX_DISTANCE = 128
BLK = 128
LN_EPS = 1e-5
NEG_INF = -1e30
H_TOTAL = N_GROUPS * H_A + H_B
W_A_OUT = H_A * HEAD_DIM
W_B_OUT = H_B * DV_B
COLS_A = 3 * N_GROUPS * H_A * HEAD_DIM
COLS_B_QK = 4 * H_B * HEAD_DIM
COLS_B = COLS_B_QK + H_B * DV_B
COLS_GATE = 2 * D_MODEL
COLS_IN = COLS_A + COLS_B + COLS_GATE
DEEPNORM_ALPHA = (2.0 * DEPTH) ** 0.25
DEEPNORM_BETA = (8.0 * DEPTH) ** -0.25

kernel_name = "hybrid_dilated_diff_attn_gated_deepnorm"


def t5_bucket(dist):
    n = jnp.maximum(dist, 0)
    max_exact = NUM_BUCKETS // 2
    nf = jnp.maximum(n, 1).astype(jnp.float32)
    large = max_exact + (jnp.log(nf / max_exact) / math.log(T5_MAX_DISTANCE / max_exact)
                         * (NUM_BUCKETS - max_exact)).astype(jnp.int32)
    large = jnp.minimum(large, NUM_BUCKETS - 1)
    return jnp.where(n < max_exact, n, large)


def layer_norm(x, g, b):
    xf = x.astype(jnp.float32)
    mu = jnp.mean(xf, axis=-1, keepdims=True)
    var = jnp.mean(jnp.square(xf - mu), axis=-1, keepdims=True)
    return ((xf - mu) * lax.rsqrt(var + LN_EPS) * g + b).astype(x.dtype)


def rms_norm(x, g):
    xf = x.astype(jnp.float32)
    return xf * lax.rsqrt(jnp.mean(jnp.square(xf), axis=-1, keepdims=True) + LN_EPS) * g


def dilated_group_attention(q, k, v, bias_table, dil, n_steps):
    B, S, H, dh = q.shape
    L = S // dil
    nb = -(-L // BLK)
    Lp = nb * BLK

    def to_blocks(t):
        t = t.reshape(B, L, dil, H, dh).transpose(0, 2, 1, 3, 4)
        t = jnp.pad(t, ((0, 0), (0, 0), (0, Lp - L), (0, 0), (0, 0)))
        return t.reshape(B, dil, nb, BLK, H, dh)

    def with_prev(t):
        prev = jnp.pad(t, ((0, 0), (0, 0), (1, 0), (0, 0), (0, 0), (0, 0)))[:, :, :-1]
        return jnp.concatenate([prev, t], axis=3)

    qb = to_blocks(q * (HEAD_DIM ** -0.5))
    kw = with_prev(to_blocks(k))
    vw = with_prev(to_blocks(v))
    s = jnp.einsum('brnqhd,brnkhd->brnhqk', qb, kw).astype(jnp.float32)

    qi = jnp.arange(BLK)[:, None]
    ki = jnp.arange(2 * BLK)[None, :]
    steps = BLK + qi - ki
    bias = bias_table[t5_bucket(steps * dil)].astype(jnp.float32).transpose(2, 0, 1)
    in_band = (steps >= 0) & (steps <= n_steps)
    first_ok = (jnp.arange(nb)[:, None, None] > 0) | (ki >= BLK)[None]
    valid = in_band[None] & first_ok
    s = jnp.where(valid[None, None, :, None], s + bias, NEG_INF)

    m = jnp.max(s, axis=-1, keepdims=True)
    p = jnp.exp(s - m)
    den = jnp.sum(p, axis=-1, keepdims=True)
    o = jnp.einsum('brnhqk,brnkhd->brnqhd', p, vw) / jnp.moveaxis(den, 3, 4)
    lse = jnp.moveaxis((m + jnp.log(den))[..., 0], 3, 4)

    o = o.reshape(B, dil, Lp, H, dh)[:, :, :L].transpose(0, 2, 1, 3, 4).reshape(B, S, H, dh)
    lse = lse.reshape(B, dil, Lp, H)[:, :, :L].transpose(0, 2, 1, 3).reshape(B, S, H)
    return o, lse


def diff_attention(q1, q2, k1, k2, v, bias_table, lam):
    B, S, H, dh = q1.shape
    nb = S // BLK
    kpos = jnp.arange(S)
    scale = HEAD_DIM ** -0.5

    def block(n):
        qpos = n * BLK + jnp.arange(BLK)
        dist = qpos[:, None] - kpos[None, :]
        bias = bias_table[t5_bucket(dist)].astype(jnp.float32).transpose(2, 0, 1)
        causal = dist >= 0

        def attn_map(qf, kf):
            qb = lax.dynamic_slice_in_dim(qf, n * BLK, BLK, axis=1)
            s = jnp.einsum('bqhd,bkhd->bhqk', qb, kf).astype(jnp.float32) * scale + bias
            return jax.nn.softmax(jnp.where(causal, s, NEG_INF), axis=-1)

        a = attn_map(q1, k1) - lam * attn_map(q2, k2)
        return jnp.einsum('bhqk,bkhe->bqhe', a, v)

    out = lax.map(block, jnp.arange(nb))
    return out.transpose(1, 0, 2, 3, 4).reshape(B, S, H, DV_B)


def mixing_sublayer(h, w_in, b_gate, lq1, lk1, lq2, lk2, subln_g, rel_bias,
                    w_proj_a, w_proj_b, w_out, layer_idx):
    B, S, D = h.shape
    proj = h @ w_in

    pa = proj[..., :COLS_A].reshape(B, S, 3, N_GROUPS, H_A, HEAD_DIM)
    outs, lses = [], []
    for g, (win, dil) in enumerate(DIL_PAIRS):
        o, l = dilated_group_attention(pa[:, :, 0, g], pa[:, :, 1, g], pa[:, :, 2, g],
                                       rel_bias[:, g * H_A:(g + 1) * H_A], dil, win // dil)
        outs.append(o)
        lses.append(l)
    wts = jax.nn.softmax(jnp.stack(lses), axis=0)
    o_a = jnp.sum(wts[..., None] * jnp.stack(outs), axis=0)
    y_a = o_a.reshape(B, S, W_A_OUT).astype(h.dtype) @ w_proj_a

    pb = proj[..., COLS_A:COLS_A + COLS_B]
    qk = pb[..., :COLS_B_QK].reshape(B, S, 4, H_B, HEAD_DIM)
    v_b = pb[..., COLS_B_QK:].reshape(B, S, H_B, DV_B)
    lam_init = 0.8 - 0.6 * math.exp(-0.3 * layer_idx)
    lam = (jnp.exp(jnp.sum(lq1.astype(jnp.float32) * lk1.astype(jnp.float32)))
           - jnp.exp(jnp.sum(lq2.astype(jnp.float32) * lk2.astype(jnp.float32))) + lam_init)
    o_b = diff_attention(qk[:, :, 0], qk[:, :, 1], qk[:, :, 2], qk[:, :, 3], v_b,
                         rel_bias[:, N_GROUPS * H_A:], lam)
    o_b = rms_norm(o_b, subln_g) * (1.0 - lam_init)
    y_b = o_b.reshape(B, S, W_B_OUT).astype(h.dtype) @ w_proj_b

    gates = jax.nn.sigmoid(proj[..., COLS_A + COLS_B:] + b_gate).reshape(B, S, 2, D)
    return (gates[:, :, 0] * y_a + gates[:, :, 1] * y_b) @ w_out


def setup_inputs(seed: int = 0) -> dict:
    key = jax.random.key(seed)
    ks = jax.random.split(key, 20)
    nrm = jax.random.normal
    beta = DEEPNORM_BETA
    col_scale = np.ones((COLS_IN,), dtype=np.float32)
    col_scale[2 * N_GROUPS * H_A * HEAD_DIM:COLS_A] = beta
    col_scale[COLS_A + COLS_B_QK:COLS_A + COLS_B] = beta
    return {
        "x": nrm(ks[0], (BATCH, SEQ, D_MODEL), jnp.float32),
        "w_in": nrm(ks[1], (DEPTH, D_MODEL, COLS_IN), jnp.float32) * (D_MODEL ** -0.5) * jnp.asarray(col_scale),
        "b_gate": 0.1 * nrm(ks[2], (DEPTH, COLS_GATE), jnp.float32),
        "lambda_q1": 0.1 * nrm(ks[3], (DEPTH, HEAD_DIM), jnp.float32),
        "lambda_k1": 0.1 * nrm(ks[4], (DEPTH, HEAD_DIM), jnp.float32),
        "lambda_q2": 0.1 * nrm(ks[5], (DEPTH, HEAD_DIM), jnp.float32),
        "lambda_k2": 0.1 * nrm(ks[6], (DEPTH, HEAD_DIM), jnp.float32),
        "subln_g": 1.0 + 0.05 * nrm(ks[7], (DEPTH, DV_B), jnp.float32),
        "rel_bias": 0.1 * nrm(ks[8], (NUM_BUCKETS, H_TOTAL), jnp.float32),
        "w_proj_a": nrm(ks[9], (DEPTH, W_A_OUT, D_MODEL), jnp.float32) * beta * (W_A_OUT ** -0.5),
        "w_proj_b": nrm(ks[10], (DEPTH, W_B_OUT, D_MODEL), jnp.float32) * beta * (W_B_OUT ** -0.5),
        "w_out": nrm(ks[11], (DEPTH, D_MODEL, D_MODEL), jnp.float32) * beta * (D_MODEL ** -0.5),
        "ln1_g": 1.0 + 0.05 * nrm(ks[12], (DEPTH, D_MODEL), jnp.float32),
        "ln1_b": 0.02 * nrm(ks[13], (DEPTH, D_MODEL), jnp.float32),
        "ln2_g": 1.0 + 0.05 * nrm(ks[14], (DEPTH, D_MODEL), jnp.float32),
        "ln2_b": 0.02 * nrm(ks[15], (DEPTH, D_MODEL), jnp.float32),
        "w_mlp1": nrm(ks[16], (DEPTH, D_MODEL, D_FF), jnp.float32) * beta * (D_MODEL ** -0.5),
        "w_mlp2": nrm(ks[17], (DEPTH, D_FF, D_MODEL), jnp.float32) * beta * (D_FF ** -0.5),
    }


def reference(x, w_in, b_gate, lambda_q1, lambda_k1, lambda_q2, lambda_k2, subln_g, rel_bias,
              w_proj_a, w_proj_b, w_out, ln1_g, ln1_b, ln2_g, ln2_b, w_mlp1, w_mlp2):
    h = x
    for l in range(DEPTH):
        mix = mixing_sublayer(h, w_in[l], b_gate[l], lambda_q1[l], lambda_k1[l], lambda_q2[l],
                              lambda_k2[l], subln_g[l], rel_bias, w_proj_a[l], w_proj_b[l],
                              w_out[l], l)
        h = layer_norm(DEEPNORM_ALPHA * h + mix, ln1_g[l], ln1_b[l])
        ff = jnp.square(jax.nn.relu(h @ w_mlp1[l])) @ w_mlp2[l]
        h = layer_norm(DEEPNORM_ALPHA * h + ff, ln2_g[l], ln2_b[l])
    return h
```

```cpp
#include <hip/hip_runtime.h>
#include <hip/hip_cooperative_groups.h>
#include <cstdio>
#include <cstdint>
namespace cg = cooperative_groups;
namespace pg8 {
#define PG8_LAS __attribute__((address_space(3)))
typedef unsigned short bf16_t;
typedef short bf16x8 __attribute__((ext_vector_type(8)));
typedef float f32x4 __attribute__((ext_vector_type(4)));
typedef unsigned u32x4 __attribute__((ext_vector_type(4)));
constexpr int BM = 256, BK = 64, HALF = 128, HTB = HALF * BK * 2  , STAGE_BYTES = 8 * HTB, NXCD = 8, WGM = 8;

__host__ __device__ __forceinline__ int lds_byte(int r, int c) { const int st = (r >> 4) * 2 + (c >> 5), rr = r & 15, cc = c & 31, ob = rr * 64 + cc * 2; return st * 1024 + (ob ^ (((ob >> 9) & 1) << 5)); }
__host__ __device__ __forceinline__ void stage_rc(int b, int& R, int& C) { const int st = b / 1024, sb = b % 1024, swz = sb ^ (((sb >> 9) & 1) << 5); R = (st >> 1) * 16 + swz / 64; C = (st & 1) * 32 + (swz % 64) / 2; }
__host__ __device__ __forceinline__ int perm32(int rho) { const int n = rho >> 4, i = rho & 15; return 8 * (i >> 2) + 4 * n + (i & 3); }

struct Unit { int pm, pn; };
struct Gemm { const bf16_t* A; const bf16_t* Bt; int M, N, K; };

struct StaticOrder {
    int nM, nN, nwg, G, c;
    __host__ __device__ void init(int M, int N, int G_, int c_) { nM = M / BM; nN = N / BM; nwg = nM * nN; G = G_; c = c_; }
    __host__ __device__ bool next(int i, Unit& u) const {
        const long L = (long)i * G + c; if (L >= nwg) return false;
        int wgid = (int)L; { const int q = nwg / NXCD, r = nwg % NXCD, xcd = wgid % NXCD, off = wgid / NXCD; wgid = (xcd < r ? xcd * (q + 1) : r * (q + 1) + (xcd - r) * q) + off; }
        const int nig = WGM * nN, gid = wgid / nig, fm = gid * WGM, gsz = (nM - fm) < WGM ? (nM - fm) : WGM;
        u.pm = fm + ((wgid % nig) % gsz); u.pn = (wgid % nig) / gsz; return true;
    }
    __device__ __forceinline__ void a_ready(const Unit&) const {}
    __device__ __forceinline__ void done(const Unit&) const {}
};

__device__ __forceinline__ unsigned cvt_pk_bf16(float lo, float hi) { unsigned r; asm volatile("v_cvt_pk_bf16_f32 %0, %1, %2" : "=v"(r) : "v"(lo), "v"(hi)); return r; }
typedef float f32x2 __attribute__((ext_vector_type(2)));
constexpr float QK_C2 = 0.125f * 1.4426950408889634f;
constexpr int MROWS = 32768;
__device__ __forceinline__ float bf_lo(unsigned w) { return __uint_as_float(w << 16); }
__device__ __forceinline__ float bf_hi(unsigned w) { return __uint_as_float(w & 0xffff0000u); }
typedef float f32x2c_t __attribute__((ext_vector_type(2))); typedef __bf16 bf16x2c_t __attribute__((ext_vector_type(2)));
__device__ __forceinline__ unsigned cvt_pk_bf16_c(float lo, float hi) { f32x2c_t v = {lo, hi}; bf16x2c_t b = __builtin_convertvector(v, bf16x2c_t); return __builtin_bit_cast(unsigned, b); }
__device__ __forceinline__ u32x4 pack8c(const f32x4 v0, const f32x4 v1) { u32x4 w; w.x = cvt_pk_bf16_c(v0[0], v0[1]); w.y = cvt_pk_bf16_c(v0[2], v0[3]); w.z = cvt_pk_bf16_c(v1[0], v1[1]); w.w = cvt_pk_bf16_c(v1[2], v1[3]); return w; }
__device__ __forceinline__ u32x4 pack8(const f32x4 v0, const f32x4 v1) { u32x4 w; w.x = cvt_pk_bf16(v0[0], v0[1]); w.y = cvt_pk_bf16(v0[2], v0[3]); w.z = cvt_pk_bf16(v1[0], v1[1]); w.w = cvt_pk_bf16(v1[2], v1[3]); return w; }
struct EpiA {
    static constexpr bool PERM = true, AFTER_DRAIN = false;
    bf16_t* base;
    __device__ __forceinline__ void operator()(const f32x4 (&acc)[2][2][4][2], const Unit& u, int wr, int wc, int fr, int fq) const {
        const int which = u.pn / 6, rem = u.pn - which * 6, g = rem >> 1, half = rem & 1, sh = 2 * g;
        const float sc = which == 0 ? QK_C2 : 1.f;
        bf16_t* b0 = base + (size_t)(which * 3 + g) * ((size_t)MROWS * 512) + half * 256 + wc * 32 + 8 * fq;
#pragma unroll
        for (int ai = 0; ai < 2; ++ai)
#pragma unroll
            for (int m = 0; m < 4; ++m) { const int row = u.pm * BM + ai * HALF + wr * 64 + m * 16 + fr; const int bb = row >> 13, t = row & 8191;
                const int pos = (bb << 13) + ((t & ((1 << sh) - 1)) << (13 - sh)) + (t >> sh);
                bf16_t* rowp = b0 + (size_t)pos * 512;
#pragma unroll
                for (int bj = 0; bj < 2; ++bj) *(u32x4*)(rowp + bj * HALF) = pack8(acc[ai][bj][m][0] * sc, acc[ai][bj][m][1] * sc); }
    }
};
struct EpiB {
    static constexpr bool PERM = true, AFTER_DRAIN = false;
    bf16_t* qkv;
    __device__ __forceinline__ void operator()(const f32x4 (&acc)[2][2][4][2], const Unit& u, int wr, int wc, int fr, int fq) const {
        const int row0 = u.pm * BM + wr * 64 + fr;
        const int which = u.pn >> 2; const float sc = which == 0 ? QK_C2 : 1.f;
        bf16_t* b0 = qkv + (size_t)which * ((size_t)MROWS * 1024) + (u.pn & 3) * 256 + wc * 32 + 8 * fq;
#pragma unroll
        for (int ai = 0; ai < 2; ++ai)
#pragma unroll
            for (int m = 0; m < 4; ++m) { bf16_t* rowp = b0 + (size_t)(row0 + ai * HALF + m * 16) * 1024;
#pragma unroll
                for (int bj = 0; bj < 2; ++bj) *(u32x4*)(rowp + bj * HALF) = pack8(acc[ai][bj][m][0] * sc, acc[ai][bj][m][1] * sc); }
    }
};
struct EpiSig {
    static constexpr bool PERM = true, AFTER_DRAIN = false;
    bf16_t* gates; const float* bgate;
    __device__ __forceinline__ void operator()(const f32x4 (&acc)[2][2][4][2], const Unit& u, int wr, int wc, int fr, int fq) const {
        const int row0 = u.pm * BM + wr * 64 + fr;
        const int gc = u.pn * 256 + wc * 32 + 8 * fq;
        f32x4 bv[2][2];
#pragma unroll
        for (int bj = 0; bj < 2; ++bj)
#pragma unroll
            for (int n = 0; n < 2; ++n) bv[bj][n] = *(const f32x4*)(bgate + gc + bj * HALF + 4 * n);
#pragma unroll
        for (int ai = 0; ai < 2; ++ai)
#pragma unroll
            for (int m = 0; m < 4; ++m) { bf16_t* rowp = gates + (size_t)(row0 + ai * HALF + m * 16) * 2048 + gc;
#pragma unroll
                for (int bj = 0; bj < 2; ++bj) { f32x4 v[2];
#pragma unroll
                    for (int n = 0; n < 2; ++n) { const f32x4 x = acc[ai][bj][m][n] + bv[bj][n];
#pragma unroll
                        for (int e = 0; e < 4; ++e) v[n][e] = __builtin_amdgcn_rcpf(1.f + __builtin_amdgcn_exp2f(-1.4426950408889634f * x[e])); }
                    *(u32x4*)(rowp + bj * HALF) = pack8c(v[0], v[1]); } }
    }
};
template <bool ADD> struct EpiGate {
    static constexpr bool PERM = true, AFTER_DRAIN = false;
    const bf16_t* gates; const bf16_t* tin; bf16_t* out;
    __device__ __forceinline__ void operator()(const f32x4 (&acc)[2][2][4][2], const Unit& u, int wr, int wc, int fr, int fq) const {
        const int row0 = u.pm * BM + wr * 64 + fr, col0 = u.pn * BM + wc * 32 + 8 * fq;
#pragma unroll
        for (int ai = 0; ai < 2; ++ai)
#pragma unroll
            for (int m = 0; m < 4; ++m) { const size_t row = (size_t)(row0 + ai * HALF + m * 16);
#pragma unroll
                for (int bj = 0; bj < 2; ++bj) { const u32x4 gw = *(const u32x4*)(gates + row * 2048 + col0 + bj * HALF);
                    f32x4 v0 = acc[ai][bj][m][0], v1 = acc[ai][bj][m][1];
                    v0[0] *= bf_lo(gw.x); v0[1] *= bf_hi(gw.x); v0[2] *= bf_lo(gw.y); v0[3] *= bf_hi(gw.y);
                    v1[0] *= bf_lo(gw.z); v1[1] *= bf_hi(gw.z); v1[2] *= bf_lo(gw.w); v1[3] *= bf_hi(gw.w);
                    if (ADD) { const u32x4 tw = *(const u32x4*)(tin + row * 1024 + col0 + bj * HALF);
                        v0[0] += bf_lo(tw.x); v0[1] += bf_hi(tw.x); v0[2] += bf_lo(tw.y); v0[3] += bf_hi(tw.y);
                        v1[0] += bf_lo(tw.z); v1[1] += bf_hi(tw.z); v1[2] += bf_lo(tw.w); v1[3] += bf_hi(tw.w); }
                    *(u32x4*)(out + row * 1024 + col0 + bj * HALF) = pack8(v0, v1); } }
    }
};
struct EpiZ {
    static constexpr bool PERM = false, AFTER_DRAIN = false;
    const float* res; float* out; float alpha;
    __device__ __forceinline__ void operator()(const f32x4 (&acc)[2][2][4][2], const Unit& u, int wr, int wc, int fr, int fq) const {
        const int row0 = u.pm * BM + wr * 64 + fr, col0 = u.pn * BM + wc * 32 + 4 * fq;
#pragma unroll
        for (int ai = 0; ai < 2; ++ai)
#pragma unroll
            for (int m = 0; m < 4; ++m) { const size_t off = (size_t)(row0 + ai * HALF + m * 16) * 1024 + col0;
#pragma unroll
                for (int bj = 0; bj < 2; ++bj)
#pragma unroll
                    for (int n = 0; n < 2; ++n) { const f32x4 r = *(const f32x4*)(res + off + bj * HALF + n * 16); *(f32x4*)(out + off + bj * HALF + n * 16) = r * alpha + acc[ai][bj][m][n]; } }
    }
};
struct EpiRelu2 {
    static constexpr bool PERM = true, AFTER_DRAIN = false;
    bf16_t* out;
    __device__ __forceinline__ void operator()(const f32x4 (&acc)[2][2][4][2], const Unit& u, int wr, int wc, int fr, int fq) const {
        const int row0 = u.pm * BM + wr * 64 + fr, col0 = u.pn * BM + wc * 32 + 8 * fq;
#pragma unroll
        for (int ai = 0; ai < 2; ++ai)
#pragma unroll
            for (int m = 0; m < 4; ++m) { bf16_t* rowp = out + (size_t)(row0 + ai * HALF + m * 16) * 4096 + col0;
#pragma unroll
                for (int bj = 0; bj < 2; ++bj) { f32x4 v0 = acc[ai][bj][m][0], v1 = acc[ai][bj][m][1];
#pragma unroll
                    for (int e = 0; e < 4; ++e) { const float a = fmaxf(v0[e], 0.f), b = fmaxf(v1[e], 0.f); v0[e] = a * a; v1[e] = b * b; }
                    *(u32x4*)(rowp + bj * HALF) = pack8(v0, v1); } }
    }
};

template <class Epi, class Sched, bool ALIGN_EPI = false, bool SP2 = false>
__device__ __forceinline__ void gemm_phase(PG8_LAS unsigned char* lds, const Gemm g, const Sched& S, const Epi& E) {
    const int tid = threadIdx.x, wid = __builtin_amdgcn_readfirstlane(tid >> 6), lane = tid & 63, wr = wid >> 2, wc = wid & 3, fr = lane & 15, fq = lane >> 4;
    const int K = g.K, nt = K / BK;
    unsigned voffA[2], voffB[2];
#pragma unroll
    for (int i = 0; i < 2; ++i) { int R, C; stage_rc(tid * 16 + i * 8192, R, C); const int Rb = Epi::PERM ? ((R & ~31) + perm32(R & 31)) : R;
        voffA[i] = (unsigned)(R * K + C) * 2u; voffB[i] = (unsigned)(Rb * K + C) * 2u; }
    const size_t kstep = (size_t)(BK * 2);
    const size_t hstep = (size_t)HALF * K * 2;
    const size_t tstep = 2 * hstep;
    const unsigned ldsw = (unsigned)wid * 1024u;
    const int aoff = lds_byte(wr * 64 + fr, fq * 8), boff = lds_byte(wc * 32 + fr, fq * 8);
#define PG8_SA(b, h) (((b) * 2 + (h)) * HTB)
#define PG8_SB(b, h) ((4 + (b) * 2 + (h)) * HTB)
#define PG8_STAGE(bufoff, gbase, voff) do { _Pragma("unroll") for (int _i = 0; _i < 2; ++_i) \
        __builtin_amdgcn_global_load_lds((const unsigned*)((const char*)(gbase) + (voff)[_i]), (PG8_LAS unsigned*)(lds + (bufoff) + ldsw + _i * 8192), 16, 0, 0); } while (0)
#define PG8_LDA(dst, b, h) do { _Pragma("unroll") for (int m = 0; m < 4; ++m) _Pragma("unroll") for (int k = 0; k < 2; ++k) dst[m][k] = *(const PG8_LAS bf16x8*)(lds + PG8_SA(b, h) + aoff + m * 2048 + k * 1024); } while (0)
#define PG8_LDB(dst, b, h) do { _Pragma("unroll") for (int n = 0; n < 2; ++n) _Pragma("unroll") for (int k = 0; k < 2; ++k) dst[n][k] = *(const PG8_LAS bf16x8*)(lds + PG8_SB(b, h) + boff + n * 2048 + k * 1024); } while (0)
#define PG8_MMA(ai, bj, At, Bt) do { __builtin_amdgcn_s_setprio(1); _Pragma("unroll") for (int m = 0; m < 4; ++m) _Pragma("unroll") for (int n = 0; n < 2; ++n) _Pragma("unroll") for (int k = 0; k < 2; ++k) \
        acc[ai][bj][m][n] = __builtin_amdgcn_mfma_f32_16x16x32_bf16(Bt[n][k], At[m][k], acc[ai][bj][m][n], 0, 0, 0); __builtin_amdgcn_s_setprio(0); } while (0)
#define PG8_WAIT_V(n) asm volatile("s_waitcnt vmcnt(" #n ")" ::: "memory")
#define PG8_WAIT_L(n) asm volatile("s_waitcnt lgkmcnt(" #n ")" ::: "memory")
#define PG8_BAR __builtin_amdgcn_s_barrier()
#define PG8_SCHED __builtin_amdgcn_sched_barrier(0)
    Unit cur, nxt; int ui = 0;
    if (!S.next(0, cur)) return;
    f32x4 acc[2][2][4][2];
#pragma unroll
    for (int a = 0; a < 2; ++a)
#pragma unroll
        for (int b = 0; b < 2; ++b)
#pragma unroll
            for (int m = 0; m < 4; ++m)
#pragma unroll
                for (int n = 0; n < 2; ++n) acc[a][b][m][n] = (f32x4){0.f, 0.f, 0.f, 0.f};
    bf16x8 At[4][2], B0[2][2], B1[2][2];
    const char* cA = (const char*)g.A + (size_t)cur.pm * tstep; const char* cB = (const char*)g.Bt + (size_t)cur.pn * tstep;
    S.a_ready(cur);
    if constexpr (SP2) {
        PG8_STAGE(PG8_SB(0, 0), cB, voffB); PG8_STAGE(PG8_SB(0, 1), cB + hstep, voffB); PG8_STAGE(PG8_SA(0, 0), cA, voffA); PG8_STAGE(PG8_SA(0, 1), cA + hstep, voffA);
        if (wr == 1) PG8_BAR;
        PG8_WAIT_V(2); PG8_BAR;
        PG8_STAGE(PG8_SB(1, 0), cB + kstep, voffB); PG8_STAGE(PG8_SA(1, 0), cA + kstep, voffA); PG8_STAGE(PG8_SB(1, 1), cB + hstep + kstep, voffB);
        PG8_WAIT_V(6); PG8_BAR;
    } else {
        PG8_STAGE(PG8_SB(0, 0), cB, voffB); PG8_STAGE(PG8_SA(0, 0), cA, voffA); PG8_STAGE(PG8_SB(0, 1), cB + hstep, voffB); PG8_STAGE(PG8_SA(0, 1), cA + hstep, voffA);
        if (wr == 1) PG8_BAR;
        PG8_WAIT_V(4); PG8_BAR;
        PG8_STAGE(PG8_SB(1, 0), cB + kstep, voffB); PG8_STAGE(PG8_SA(1, 0), cA + kstep, voffA); PG8_STAGE(PG8_SB(1, 1), cB + hstep + kstep, voffB);
        PG8_WAIT_V(6); PG8_BAR;
    }
    for (;;) {
        const bool has_next = S.next(ui + 1, nxt);
        const char* nA = has_next ? (const char*)g.A + (size_t)nxt.pm * tstep : cA; const char* nB = has_next ? (const char*)g.Bt + (size_t)nxt.pn * tstep : cB;
        for (int t = 0; t < nt; t += 2) {
            const bool last = (t == nt - 2);
            const char* a1 = cA + (size_t)(t + 1) * kstep;
            const char* a2 = last ? nA : cA + (size_t)(t + 2) * kstep; const char* b2 = last ? nB : cB + (size_t)(t + 2) * kstep;
            const char* a3 = a2 + kstep; const char* b3 = b2 + kstep;
            if (last && has_next) S.a_ready(nxt);
            if constexpr (SP2) {
            PG8_LDB(B0, 0, 0); PG8_LDB(B1, 0, 1); PG8_SCHED; PG8_LDA(At, 0, 0); PG8_STAGE(PG8_SA(1, 1), a1 + hstep, voffA);
            PG8_WAIT_V(8); PG8_WAIT_L(0); PG8_BAR; PG8_MMA(0, 0, At, B0); PG8_MMA(0, 1, At, B1); PG8_BAR; PG8_SCHED;
            PG8_LDA(At, 0, 1); PG8_STAGE(PG8_SB(0, 0), b2, voffB); PG8_STAGE(PG8_SB(0, 1), b2 + hstep, voffB); PG8_STAGE(PG8_SA(0, 0), a2, voffA);
            PG8_WAIT_V(8); PG8_WAIT_L(0); PG8_BAR; PG8_MMA(1, 0, At, B0); PG8_MMA(1, 1, At, B1); PG8_BAR; PG8_SCHED;
            PG8_LDB(B0, 1, 0); PG8_LDB(B1, 1, 1); PG8_SCHED; PG8_LDA(At, 1, 0); PG8_STAGE(PG8_SA(0, 1), a2 + hstep, voffA);
            PG8_WAIT_V(8); PG8_WAIT_L(0); PG8_BAR; PG8_MMA(0, 0, At, B0); PG8_MMA(0, 1, At, B1); PG8_BAR; PG8_SCHED;
            PG8_LDA(At, 1, 1); PG8_STAGE(PG8_SB(1, 0), b3, voffB); PG8_STAGE(PG8_SB(1, 1), b3 + hstep, voffB); PG8_STAGE(PG8_SA(1, 0), a3, voffA);
            PG8_WAIT_V(8); PG8_WAIT_L(0); PG8_BAR; PG8_MMA(1, 0, At, B0); PG8_MMA(1, 1, At, B1); PG8_BAR; PG8_SCHED;
            } else {
            PG8_LDB(B0, 0, 0); PG8_SCHED; PG8_LDA(At, 0, 0); PG8_STAGE(PG8_SA(1, 1), a1 + hstep, voffA);
            PG8_WAIT_L(8); PG8_BAR; PG8_WAIT_L(0); PG8_MMA(0, 0, At, B0); PG8_BAR; PG8_SCHED;
            PG8_LDB(B1, 0, 1); PG8_STAGE(PG8_SB(0, 0), b2, voffB);
            PG8_BAR; PG8_WAIT_L(0); PG8_MMA(0, 1, At, B1); PG8_BAR;
            PG8_LDA(At, 0, 1); PG8_STAGE(PG8_SA(0, 0), a2, voffA);
            PG8_BAR; PG8_WAIT_L(0); PG8_MMA(1, 0, At, B0); PG8_BAR; PG8_SCHED;
            PG8_STAGE(PG8_SB(0, 1), b2 + hstep, voffB);
            PG8_WAIT_V(6); PG8_BAR; PG8_MMA(1, 1, At, B1); PG8_BAR;
            PG8_LDB(B0, 1, 0); PG8_SCHED; PG8_LDA(At, 1, 0); PG8_STAGE(PG8_SA(0, 1), a2 + hstep, voffA);
            PG8_WAIT_L(8); PG8_BAR; PG8_WAIT_L(0); PG8_MMA(0, 0, At, B0); PG8_BAR; PG8_SCHED;
            PG8_LDB(B1, 1, 1); PG8_STAGE(PG8_SB(1, 0), b3, voffB);
            PG8_BAR; PG8_WAIT_L(0); PG8_MMA(0, 1, At, B1); PG8_BAR;
            PG8_LDA(At, 1, 1); PG8_STAGE(PG8_SA(1, 0), a3, voffA);
            PG8_BAR; PG8_WAIT_L(0); PG8_MMA(1, 0, At, B0); PG8_BAR; PG8_SCHED;
            PG8_STAGE(PG8_SB(1, 1), b3 + hstep, voffB);
            PG8_WAIT_V(6); PG8_BAR; PG8_MMA(1, 1, At, B1); PG8_BAR;
            }
        }
        if constexpr (ALIGN_EPI) { if (wr == 0) PG8_BAR; }
        if constexpr (!Epi::AFTER_DRAIN) { E(acc, cur, wr, wc, fr, fq); S.done(cur); }
        if (!has_next) break;
#pragma unroll
        for (int a = 0; a < 2; ++a)
#pragma unroll
            for (int b = 0; b < 2; ++b)
#pragma unroll
                for (int m = 0; m < 4; ++m)
#pragma unroll
                    for (int n = 0; n < 2; ++n) acc[a][b][m][n] = (f32x4){0.f, 0.f, 0.f, 0.f};
        cur = nxt; cA = nA; cB = nB; ++ui;
        if constexpr (ALIGN_EPI) { if (wr == 1) PG8_BAR; }
    }
    PG8_WAIT_V(0);
    if constexpr (!ALIGN_EPI) { if (wr == 0) PG8_BAR; }
    PG8_BAR;
    if constexpr (Epi::AFTER_DRAIN) { E.fused(acc, cur, wr, wc, fr, fq, lds, wid, lane); S.done(cur); }
#undef PG8_SA
#undef PG8_SB
#undef PG8_STAGE
#undef PG8_LDA
#undef PG8_LDB
#undef PG8_MMA
#undef PG8_WAIT_V
#undef PG8_WAIT_L
#undef PG8_BAR
#undef PG8_SCHED
}
}
#include <hip/hip_bf16.h>
#include <cmath>
namespace attn_body {
using bf16=__hip_bfloat16;
using bf16x8=__attribute__((ext_vector_type(8)))short;
using s16x4=__attribute__((ext_vector_type(4)))short;
using f32x16=__attribute__((ext_vector_type(16)))float;
using u32x4=__attribute__((ext_vector_type(4)))unsigned;
constexpr int SEQ=8192,D=64,DM=1024;
constexpr int NW=8,QBLK=32,QB=QBLK*NW,KVBLK=64,NQB=SEQ/QB;
constexpr int ATTN_PITCH=DM, ATTN_UNIT_ROWS=QB;
__device__ __forceinline__ int crow(int r,int hi){return (r&3)+8*(r>>2)+4*hi;}
#define SBAR() __builtin_amdgcn_sched_barrier(0)
__device__ __forceinline__ void cmask(f32x16&p0,f32x16&p1,int jb,int qrel,int hi){
  const float NEG=-INFINITY; int kb=64*jb+4*hi;
  #pragma unroll
  for(int r=0;r<16;++r){int kv=kb+(r&3)+8*(r>>2); if(kv>qrel)p0[r]=NEG; if(kv+32>qrel)p1[r]=NEG;}
}

typedef __attribute__((address_space(3))) const float* lds_fptr;
__device__ __forceinline__ void bmask(f32x16&p0,f32x16&p1,int jb,int qrel,int hi,lds_fptr tab){
  lds_fptr tp=tab+(qrel-64*jb-4*hi+196);
  #pragma unroll
  for(int r=0;r<16;++r){const int off=(r&3)+8*(r>>2); p0[r]+=tp[59-off]; p1[r]+=tp[27-off];}
}
constexpr int NSLOT=3, SLOTB=8192;
constexpr int LDS_K=0, LDS_V=NSLOT*SLOTB, LDS_WS=2*NSLOT*SLOTB, LDS_OST=LDS_WS+NW*64*4, LDS_BYTES=LDS_OST+NW*4096;
constexpr float C2=0.125f*1.4426950408889634f;
__device__ __forceinline__ void glds16(const void*gsrc,unsigned lds_dst){unsigned keep;
  asm volatile("s_mov_b32 %0, m0\n\ts_mov_b32 m0, %2\n\ts_nop 0\n\tglobal_load_lds_dwordx4 %1, off\n\ts_mov_b32 m0, %0":"=&s"(keep):"v"(gsrc),"s"(lds_dst):"memory");}
__device__ __forceinline__ float max3f(float a,float b,float c){float r;asm("v_max3_f32 %0, %1, %2, %3":"=v"(r):"v"(a),"v"(b),"v"(c));return r;}
__device__ __forceinline__ float max2f(float a,float b){float r;asm("v_max_f32_e32 %0, %1, %2":"=v"(r):"v"(a),"v"(b));return r;}
__device__ __forceinline__ float fadd_s(float a,float b){float r;asm("v_add_f32_e32 %0, %1, %2":"=v"(r):"v"(a),"v"(b));return r;}
__device__ __forceinline__ float fsub_s(float a,float b){float r;asm("v_sub_f32_e32 %0, %1, %2":"=v"(r):"v"(a),"v"(b));return r;}
typedef float f32x2_t __attribute__((ext_vector_type(2))); typedef __bf16 bf16x2_t __attribute__((ext_vector_type(2)));
__device__ __forceinline__ unsigned cvtpk_s(float lo,float hi){f32x2_t v={lo,hi};bf16x2_t b=__builtin_convertvector(v,bf16x2_t);return __builtin_bit_cast(unsigned,b);}
#define WAIT_BAR(N) asm volatile("s_waitcnt vmcnt(" #N ") lgkmcnt(0)\n\ts_barrier":::"memory")

__device__ __forceinline__ void qkt(f32x16&p0,f32x16&p1,const char*Kslot,const bf16x8*qr,const f32x16&negm,int r32,int hi){
  const char*kb=Kslot+hi*1024+r32*16;
  #pragma unroll
  for(int d0=0;d0<4;++d0){
    const bf16x8 b0=*reinterpret_cast<const bf16x8*>(kb+d0*2048);
    const bf16x8 b1=*reinterpret_cast<const bf16x8*>(kb+d0*2048+512);
    if(d0==0){p0=__builtin_amdgcn_mfma_f32_32x32x16_bf16(b0,qr[0],negm,0,0,0);p1=__builtin_amdgcn_mfma_f32_32x32x16_bf16(b1,qr[0],negm,0,0,0);}
    else{p0=__builtin_amdgcn_mfma_f32_32x32x16_bf16(b0,qr[d0],p0,0,0,0);p1=__builtin_amdgcn_mfma_f32_32x32x16_bf16(b1,qr[d0],p1,0,0,0);}}
}
typedef __attribute__((address_space(3))) const char* lds_cptr;
typedef short v4i16_t __attribute__((ext_vector_type(4)));
__device__ __forceinline__ void kload8(bf16x8*kf,lds_cptr kp){
  kf[0]=*(const __attribute__((address_space(3))) bf16x8*)(kp);      kf[1]=*(const __attribute__((address_space(3))) bf16x8*)(kp+512);
  kf[2]=*(const __attribute__((address_space(3))) bf16x8*)(kp+2048); kf[3]=*(const __attribute__((address_space(3))) bf16x8*)(kp+2560);
  kf[4]=*(const __attribute__((address_space(3))) bf16x8*)(kp+4096); kf[5]=*(const __attribute__((address_space(3))) bf16x8*)(kp+4608);
  kf[6]=*(const __attribute__((address_space(3))) bf16x8*)(kp+6144); kf[7]=*(const __attribute__((address_space(3))) bf16x8*)(kp+6656);
}
__device__ __forceinline__ void kload2(bf16x8*kf,lds_cptr kp,int j){ kf[2*j]=*(const __attribute__((address_space(3))) bf16x8*)(kp+j*2048); kf[2*j+1]=*(const __attribute__((address_space(3))) bf16x8*)(kp+j*2048+512); }
__device__ __forceinline__ s16x4 vtr(lds_cptr p){ return __builtin_bit_cast(s16x4,__builtin_amdgcn_ds_read_tr16_b64_v4i16((__attribute__((address_space(3))) v4i16_t*)p)); }
__device__ __forceinline__ float rowmax(const f32x16&p0,const f32x16&p1){
  float a=max3f(p0[0],p0[1],p1[0]),b=max3f(p0[2],p0[3],p1[1]);a=max3f(a,p1[2],p1[3]);
  #pragma unroll
  for(int r=4;r<16;r+=4){a=max3f(a,p0[r],p0[r+1]);b=max3f(b,p0[r+2],p0[r+3]);a=max3f(a,p1[r],p1[r+1]);b=max3f(b,p1[r+2],p1[r+3]);}
  const float m=max2f(a,b);
  auto rr=__builtin_amdgcn_permlane32_swap(__float_as_uint(m),__float_as_uint(m),false,false);
  return max2f(__uint_as_float(rr[0]),__uint_as_float(rr[1]));
}
__device__ __forceinline__ void pv(f32x16*o,int vb,bf16x8 pa0,bf16x8 pa1,bf16x8 pa2,bf16x8 pa3){
  #pragma unroll
  for(int d0=0;d0<2;++d0){s16x4 lo[4],hi[4];
    #pragma unroll
    for(int ks=0;ks<4;++ks){
      asm volatile("ds_read_b64_tr_b16 %0,%1 offset:%c2":"=&v"(lo[ks]):"v"(vb),"i"(d0*4096+ks*1024):"memory");
      asm volatile("ds_read_b64_tr_b16 %0,%1 offset:%c2":"=&v"(hi[ks]):"v"(vb),"i"(d0*4096+ks*1024+512):"memory");}
    asm volatile("s_waitcnt lgkmcnt(0)":::"memory");SBAR();
    #define PK(k) (bf16x8){lo[k][0],lo[k][1],lo[k][2],lo[k][3],hi[k][0],hi[k][1],hi[k][2],hi[k][3]}
    o[d0]=__builtin_amdgcn_mfma_f32_32x32x16_bf16(pa0,PK(0),o[d0],0,0,0);
    o[d0]=__builtin_amdgcn_mfma_f32_32x32x16_bf16(pa1,PK(1),o[d0],0,0,0);
    o[d0]=__builtin_amdgcn_mfma_f32_32x32x16_bf16(pa2,PK(2),o[d0],0,0,0);
    o[d0]=__builtin_amdgcn_mfma_f32_32x32x16_bf16(pa3,PK(3),o[d0],0,0,0);
    #undef PK
  }
}

#ifndef ATTN_STORE16
#define ATTN_STORE16(p,v) (*(u32x4*)(p)=(v))
#endif
template<int THRL> __device__ __forceinline__ void attn_unit(int qb,const bf16*Q,const bf16*__restrict__ K,const bf16*__restrict__ V,bf16*O,lds_fptr tab,char*shm){
  __builtin_amdgcn_sched_barrier(0); int tid_=threadIdx.x; asm volatile("":"+v"(tid_));
  const int tid=tid_,lane=tid&63,r32=lane&31,hi=lane>>5; const int wid=__builtin_amdgcn_readfirstlane(tid>>6);
  const int q0=qb*QB;
  const bf16*Qw=Q+(long)(q0+wid*QBLK)*DM;
  const bf16*Kh=K,*Vh=V;
  const unsigned lds0=(unsigned)(uintptr_t)shm;
  float*wsf=(float*)(shm+LDS_WS)+wid*64;
  const bf16*ksrc=Kh+(long)lane*DM+wid*8;
  const bf16*vsrc=Vh+(long)(16*(wid&3)+(lane>>2))*DM+(wid>>2)*32+(lane&3)*8;
  const unsigned kdst=lds0+LDS_K+wid*1024, vdst=lds0+LDS_V+wid*1024;
  #define DMA_K(t,slot) glds16(ksrc+(long)(t)*KVBLK*DM,(unsigned)__builtin_amdgcn_readfirstlane(kdst+(slot)))
  #define DMA_V(t,slot) glds16(vsrc+(long)(t)*KVBLK*DM,(unsigned)__builtin_amdgcn_readfirstlane(vdst+(slot)))
  const int vb0=(int)(lds0+LDS_V)+((lane>>4)&1)*32+(lane&3)*8+(4*hi+((lane&15)>>2))*64;
  const char*Kbase=shm+LDS_K; bf16x8 kf[8];
  const lds_cptr shm3=(lds_cptr)shm; const lds_cptr kp0=shm3+LDS_K+hi*1024+r32*16; const lds_cptr vp0=shm3+LDS_V+((lane>>4)&1)*32+(lane&3)*8+(4*hi+((lane&15)>>2))*64;
  const int NT=(q0+QB)/KVBLK;
  DMA_K(0,0);DMA_V(0,0);DMA_K(1,SLOTB);
  bf16x8 qr[4];
  #pragma unroll
  for(int d0=0;d0<4;++d0)qr[d0]=*reinterpret_cast<const bf16x8*>(&Qw[(long)r32*DM+d0*16+hi*8]);
  float mhat=0.f,l_reg=0.f;f32x16 o[2];o[0]=f32x16{};o[1]=f32x16{};f32x16 negm=f32x16{};asm volatile("":"+v"(negm));
  const int qrel=wid*QBLK+r32;
  #define CMASK(P0,P1,t) do{int jb_=(t)-(NT-4); if(jb_>=-2)bmask(P0,P1,jb_,qrel,hi,tab);}while(0)
  bool resc=false;
  #define START(P0,P1) do{ const float rm=rowmax(P0,P1); resc=false; \
    { const float dl=rm; mhat=fadd_s(mhat,dl); \
      _Pragma("unroll") for(int r=0;r<16;++r){P0[r]=fsub_s(P0[r],dl);P1[r]=fsub_s(P1[r],dl);} \
      _Pragma("unroll") for(int r=0;r<16;++r)negm[r]=-mhat; asm volatile("":"+v"(negm)); } \
    _Pragma("unroll") for(int r=0;r<16;++r)P0[r]=__builtin_amdgcn_exp2f(P0[r]); }while(0)
  #define RESC() do{ if(resc){ asm volatile("s_waitcnt lgkmcnt(0)":::"memory"); \
      _Pragma("unroll") for(int d_=0;d_<2;++d_) _Pragma("unroll") for(int r=0;r<16;++r)o[d_][r]*=wsf[crow(r,hi)]; } }while(0)
  f32x16 pA0,pA1,pB0,pB1;
  int sl_prev=0,sl_cur=0,sl_next=SLOTB;
  #define ROT() do{sl_prev=sl_cur;sl_cur=sl_next;sl_next=(sl_next==(NSLOT-1)*SLOTB)?0:sl_next+SLOTB;}while(0)
  DMA_K(2,2*SLOTB);
  WAIT_BAR(3);
  qkt(pA0,pA1,Kbase,qr,negm,r32,hi);asm volatile("s_nop 15\n\ts_nop 7":"+v"(pA0),"+v"(pA1));CMASK(pA0,pA1,0);
  START(pA0,pA1);
  _Pragma("unroll") for(int r=0;r<16;++r)pA1[r]=__builtin_amdgcn_exp2f(pA1[r]);
  WAIT_BAR(0);
  DMA_K(3,0);DMA_V(1,SLOTB);
  ROT();
  kload8(kf,kp0+sl_cur);
  WAIT_BAR(2);
  s16x4 vlo[8],vhi[8]; u32x4 pw0,pw1,pw2,pw3;
  #define PKW(P,B) cvtpk_s(P[B],P[B+1])
  #define PAF(k) __builtin_bit_cast(bf16x8,pw##k)
  #define VFR(i) (bf16x8){vlo[i][0],vlo[i][1],vlo[i][2],vlo[i][3],vhi[i][0],vhi[i][1],vhi[i][2],vhi[i][3]}
  #define PIN(x) asm volatile("":"+v"(x))
  #define MX3(a,b,c) __builtin_fmaxf(__builtin_fmaxf((a),(b)),(c))
  #define GAPA(MF,A0,A1,A2,A3,W0,W1,PW) do{ MF; sacc+=A0; sacc+=A1; sacc+=A2; sacc+=A3; PIN(sacc); W0; W1; PIN(PW); SBAR(); }while(0)
  #define EX(v) __builtin_amdgcn_exp2f(v)
  #define GAPB(MF,X,B) do{ MF; X[B]=EX(X[B]); X[B+1]=EX(X[B+1]); X[B+2]=EX(X[B+2]); X[B+3]=EX(X[B+3]); PIN(X); SBAR(); }while(0)
  #define VRD(i) do{ vlo[i]=vtr(vp_+(((i)>>2)*4096+((i)&3)*1024)); vhi[i]=vtr(vp_+(((i)>>2)*4096+((i)&3)*1024+512)); }while(0)
  #define KRD(G,j) do{ if(G){ kload2(kf,kp0+sl_next,j); SBAR(); } }while(0)
  #define STEP(C0,C1,P0,P1,t,GK,GV,GL) do{ SBAR(); \
    const lds_cptr vp_=vp0+sl_prev; \
    VRD(0); SBAR(); float sacc=(P0[0]+P0[1]); \
    GAPA(C0=__builtin_amdgcn_mfma_f32_32x32x16_bf16(kf[0],qr[0],negm,0,0,0), P0[2],P0[3],P0[4],P0[5],     pw0[0]=PKW(P0,0), pw0[1]=PKW(P0,2), pw0); \
    VRD(4); SBAR(); GAPA(C1=__builtin_amdgcn_mfma_f32_32x32x16_bf16(kf[1],qr[0],negm,0,0,0), P0[6],P0[7],P0[8],P0[9],     pw0[2]=PKW(P0,4), pw0[3]=PKW(P0,6), pw0); \
    VRD(1); SBAR(); GAPA(C0=__builtin_amdgcn_mfma_f32_32x32x16_bf16(kf[2],qr[1],C0,0,0,0),   P0[10],P0[11],P0[12],P0[13], pw1[0]=PKW(P0,8), pw1[1]=PKW(P0,10), pw1); \
    VRD(5); SBAR(); GAPA(C1=__builtin_amdgcn_mfma_f32_32x32x16_bf16(kf[3],qr[1],C1,0,0,0),   P0[14],P0[15],P1[0],P1[1],   pw1[2]=PKW(P0,12),pw1[3]=PKW(P0,14), pw1); \
    VRD(2); SBAR(); GAPA(C0=__builtin_amdgcn_mfma_f32_32x32x16_bf16(kf[4],qr[2],C0,0,0,0),   P1[2],P1[3],P1[4],P1[5],     pw2[0]=PKW(P1,0), pw2[1]=PKW(P1,2), pw2); \
    VRD(6); SBAR(); GAPA(C1=__builtin_amdgcn_mfma_f32_32x32x16_bf16(kf[5],qr[2],C1,0,0,0),   P1[6],P1[7],P1[8],P1[9],     pw2[2]=PKW(P1,4), pw2[3]=PKW(P1,6), pw2); \
    VRD(3); SBAR(); GAPA(C0=__builtin_amdgcn_mfma_f32_32x32x16_bf16(kf[6],qr[3],C0,0,0,0),   P1[10],P1[11],P1[12],P1[13], pw3[0]=PKW(P1,8), pw3[1]=PKW(P1,10), pw3); \
    VRD(7); SBAR(); GAPA(C1=__builtin_amdgcn_mfma_f32_32x32x16_bf16(kf[7],qr[3],C1,0,0,0),   P1[14],P1[15],0.f,0.f,       pw3[2]=PKW(P1,12),pw3[3]=PKW(P1,14), pw3); \
    l_reg+=sacc; \
    if(GK){DMA_K((t)+3,sl_cur);} if(GV){DMA_V((t)+1,sl_next);} \
    CMASK(C0,C1,t); \
    { float a=MX3(C0[0],C0[1],C1[0]),b=MX3(C0[2],C0[3],C1[1]); a=MX3(a,C1[2],C1[3]); \
      _Pragma("unroll") for(int r=4;r<16;r+=4){a=MX3(a,C0[r],C0[r+1]);b=MX3(b,C0[r+2],C0[r+3]);a=MX3(a,C1[r],C1[r+1]);b=MX3(b,C1[r+2],C1[r+3]);} \
      float rm=__builtin_fmaxf(a,b); { auto rr=__builtin_amdgcn_permlane32_swap(__float_as_uint(rm),__float_as_uint(rm),false,false); rm=__builtin_fmaxf(__uint_as_float(rr[0]),__uint_as_float(rr[1])); } \
      resc=false; \
      if(__builtin_expect(__any(rm>(float)THRL),0)){ const float dl=__builtin_fmaxf(rm,0.f); mhat+=dl; \
        _Pragma("unroll") for(int r=0;r<16;++r){C0[r]-=dl;C1[r]-=dl;} \
        _Pragma("unroll") for(int r=0;r<16;++r)negm[r]=-mhat; asm volatile("":"+v"(negm)); \
        const float f=__builtin_amdgcn_exp2f(-dl); l_reg*=f; if(hi==0)wsf[r32]=f; resc=true; } } \
    SBAR(); \
    GAPB(o[0]=__builtin_amdgcn_mfma_f32_32x32x16_bf16(PAF(0),VFR(0),o[0],0,0,0), C0,0); \
    GAPB(o[1]=__builtin_amdgcn_mfma_f32_32x32x16_bf16(PAF(0),VFR(4),o[1],0,0,0), C0,4); \
    KRD(GL,0); GAPB(o[0]=__builtin_amdgcn_mfma_f32_32x32x16_bf16(PAF(1),VFR(1),o[0],0,0,0), C0,8); \
    KRD(GL,1); GAPB(o[1]=__builtin_amdgcn_mfma_f32_32x32x16_bf16(PAF(1),VFR(5),o[1],0,0,0), C0,12); \
    KRD(GL,2); GAPB(o[0]=__builtin_amdgcn_mfma_f32_32x32x16_bf16(PAF(2),VFR(2),o[0],0,0,0), C1,0); \
    KRD(GL,3); GAPB(o[1]=__builtin_amdgcn_mfma_f32_32x32x16_bf16(PAF(2),VFR(6),o[1],0,0,0), C1,4); \
    GAPB(o[0]=__builtin_amdgcn_mfma_f32_32x32x16_bf16(PAF(3),VFR(3),o[0],0,0,0), C1,8); \
    GAPB(o[1]=__builtin_amdgcn_mfma_f32_32x32x16_bf16(PAF(3),VFR(7),o[1],0,0,0), C1,12); \
    }while(0)
  int t=1;
  #undef CMASK
  #define CMASK(P0,P1,t) do{}while(0)
  for(;t+7<NT;t+=2){
    STEP(pB0,pB1,pA0,pA1,t,true,true,true);     WAIT_BAR(2); RESC(); ROT();
    STEP(pA0,pA1,pB0,pB1,t+1,true,true,true);   WAIT_BAR(2); RESC(); ROT();
  }
  #undef CMASK
  #define CMASK(P0,P1,t) do{int jb_=(t)-(NT-4); if(jb_>=-2)bmask(P0,P1,jb_,qrel,hi,tab);}while(0)
  #define ENDW(tt) do{ if((tt)+3<NT){WAIT_BAR(2);} else if((tt)+2<NT){WAIT_BAR(1);} else {WAIT_BAR(0);} }while(0)
  for(;t+1<NT;t+=2){
    STEP(pB0,pB1,pA0,pA1,t,(t+3<NT),(t+1<NT),(t+1<NT));       ENDW(t);   RESC(); ROT();
    STEP(pA0,pA1,pB0,pB1,t+1,(t+4<NT),(t+2<NT),(t+2<NT));     ENDW(t+1); RESC(); ROT();
  }
  STEP(pB0,pB1,pA0,pA1,NT-1,false,false,false); RESC();
  { float sacc=pB0[0]+pB0[1]; _Pragma("unroll") for(int r=2;r<16;++r)sacc+=pB0[r]; _Pragma("unroll") for(int r=0;r<16;++r)sacc+=pB1[r]; l_reg+=sacc;
    pw0=(u32x4){PKW(pB0,0),PKW(pB0,2),PKW(pB0,4),PKW(pB0,6)};pw1=(u32x4){PKW(pB0,8),PKW(pB0,10),PKW(pB0,12),PKW(pB0,14)};pw2=(u32x4){PKW(pB1,0),PKW(pB1,2),PKW(pB1,4),PKW(pB1,6)};pw3=(u32x4){PKW(pB1,8),PKW(pB1,10),PKW(pB1,12),PKW(pB1,14)};
    SBAR(); pv(o,vb0+sl_cur,PAF(0),PAF(1),PAF(2),PAF(3)); }
  #undef PKW
  #undef PAF
  #undef VFR
  #undef PIN
  #undef MX3
  #undef GAPA
  #undef GAPB
  #undef EX
  #undef VRD
  #undef KRD
  #undef STEP
  #undef ENDW
  {auto rr=__builtin_amdgcn_permlane32_swap(__float_as_uint(l_reg),__float_as_uint(l_reg),false,false);l_reg=__uint_as_float(rr[0])+__uint_as_float(rr[1]);}
  if(hi==0)wsf[32+r32]=l_reg;asm volatile("s_waitcnt lgkmcnt(0)":::"memory");
  float rli[16];
  #pragma unroll
  for(int r=0;r<16;++r)rli[r]=__builtin_amdgcn_rcpf(wsf[32+crow(r,hi)]);
  bf16*Ow=O+(long)(q0+wid*QBLK)*DM;
  { bf16*stg=(bf16*)(shm+LDS_OST)+wid*2048;
    #pragma unroll
    for(int r=0;r<16;++r){const int orow=crow(r,hi);
      #pragma unroll
      for(int d0=0;d0<2;++d0)stg[orow*64+d0*32+r32]=__float2bfloat16(o[d0][r]*rli[r]);}
    asm volatile("s_waitcnt lgkmcnt(0)":::"memory");
    #pragma unroll
    for(int i=0;i<4;++i){const int row=i*8+(lane>>3),ch=lane&7; const u32x4 v=*(const u32x4*)(stg+row*64+ch*8); ATTN_STORE16(Ow+(long)row*DM+ch*8,v);} }
  asm volatile("s_waitcnt lgkmcnt(0)\n\ts_barrier":::"memory");
  __builtin_amdgcn_sched_barrier(0);
  #undef DMA_K
  #undef DMA_V
  #undef CMASK
  #undef START
  #undef RESC
  #undef ROT
}
constexpr int ATTN_LDS_BYTES=LDS_BYTES;
#undef SBAR
#undef WAIT_BAR
}
constexpr int SEQ = 8192, DMODEL = 1024, M = 4 * SEQ, FF = 4096, COLS_A = 4608, COLS_B2 = 5120;
constexpr float LN_EPS = 1e-5f, LOG2E = 1.4426950408889634f;
constexpr float DN_ALPHA = 1.189207115002721f;
constexpr size_t MiB = 1u << 20;
constexpr size_t WS_WIN = 0, WS_WPA = 19 * MiB, WS_WPB = 20 * MiB, WS_WO = 22 * MiB, WS_W1 = 24 * MiB, WS_W2 = 32 * MiB;
constexpr size_t WS_R1 = 40 * MiB;
constexpr size_t WS_R2 = 328 * MiB;
constexpr size_t WS_OG = WS_R2, WS_LSE = WS_R2 + 96 * MiB;
constexpr size_t WS_XB = 427 * MiB;
constexpr size_t WS_OA = WS_R1, WS_QB = WS_R1 + 32 * MiB, WS_O1 = WS_R1 + 224 * MiB, WS_O2 = WS_R2;
constexpr size_t WS_OB = WS_R1 + 32 * MiB, WS_GATES = WS_R1 + 96 * MiB, WS_TMP = WS_R1 + 224 * MiB, WS_MERGED = WS_XB;
constexpr size_t WS_Z = WS_R1, WS_X1B = WS_XB, WS_H = WS_R1 + 128 * MiB, WS_END = 491 * MiB;
constexpr int RING_BYTES = 131072, LDS_BYTES = 147456;

#define GAS __attribute__((address_space(1)))
#define LAS __attribute__((address_space(3)))
typedef unsigned short bf16;
typedef unsigned v4u __attribute__((ext_vector_type(4)));
typedef unsigned v2u __attribute__((ext_vector_type(2)));
typedef float f32x4 __attribute__((ext_vector_type(4)));
typedef float f32x16 __attribute__((ext_vector_type(16)));
typedef short bf16x8 __attribute__((ext_vector_type(8)));
typedef short s16x4 __attribute__((ext_vector_type(4)));
#define LDS_WAIT() asm volatile("s_waitcnt lgkmcnt(0)" ::: "memory")
__device__ __forceinline__ unsigned f2bf(float f) { unsigned u = __builtin_bit_cast(unsigned, f); return (u + 0x7fffu + ((u >> 16) & 1u)) >> 16; }
__device__ __forceinline__ unsigned pk2(float lo, float hi) { return f2bf(lo) | (f2bf(hi) << 16); }
__device__ __forceinline__ float blo(unsigned w) { return __uint_as_float(w << 16); }
__device__ __forceinline__ float bhi(unsigned w) { return __uint_as_float(w & 0xffff0000u); }
__device__ __forceinline__ float wave_sum(float v) {
#pragma unroll
    for (int o = 1; o < 64; o <<= 1) v += __shfl_xor(v, o);
    return v;
}
__device__ __forceinline__ int t5_bucket(int n) {
    if (n < 16) return n;
    const float v = logf((float)n / 16.0f) / 2.0794415416798357f * 16.0f;
    int l = 16 + (int)v; return l > 31 ? 31 : l;
}
__device__ __forceinline__ void p0_transpose_item(const float* W, int K, int N, bf16* WT, LAS float* scr, int item, int lane) {
    const int nblk = N / 32, kb = item / nblk, nb = item % nblk, k0 = 64 * kb, n0 = 32 * nb;
#pragma unroll 8
    for (int i = 0; i < 32; ++i) { const int kk = 2 * i + (lane >> 5); scr[kk * 33 + (lane & 31)] = W[(size_t)(k0 + kk) * N + n0 + (lane & 31)]; }
    LDS_WAIT(); asm volatile("" ::: "memory");
    const int c = lane & 7;
#pragma unroll
    for (int j = 0; j < 4; ++j) { const int n = (lane >> 3) + 8 * j; const LAS float* s = scr + (8 * c) * 33 + n;
        v4u o; o.x = pk2(s[0 * 33], s[1 * 33]); o.y = pk2(s[2 * 33], s[3 * 33]); o.z = pk2(s[4 * 33], s[5 * 33]); o.w = pk2(s[6 * 33], s[7 * 33]);
        *(v4u*)(WT + (size_t)(n0 + n) * K + k0 + 8 * c) = o; }
    LDS_WAIT(); asm volatile("" ::: "memory");
}

namespace attn_a {
constexpr int KP = 144, LDS_KS = 0, LDS_VS = 384 * KP, LDS_TAB = 2 * 384 * KP;
typedef __attribute__((address_space(3))) const char* lds_cptr;
typedef short v4i16_t __attribute__((ext_vector_type(4)));
__device__ __forceinline__ s16x4 vtr(lds_cptr p) { return __builtin_bit_cast(s16x4, __builtin_amdgcn_ds_read_tr16_b64_v4i16((__attribute__((address_space(3))) v4i16_t*)p)); }
typedef float f32x2_t __attribute__((ext_vector_type(2))); typedef __bf16 bf16x2_t __attribute__((ext_vector_type(2)));
__device__ __forceinline__ unsigned cvtpk(float lo, float hi) { f32x2_t v = {lo, hi}; bf16x2_t b = __builtin_convertvector(v, bf16x2_t); return __builtin_bit_cast(unsigned, b); }
__device__ __forceinline__ void unit(int g, int h, int blk, const bf16* qa, const bf16* ka, const bf16* va, bf16* og, float* lse, const float* rel_bias, LAS unsigned char* lds) {
    const int tid = threadIdx.x, lane = tid & 63, r32 = lane & 31, hi = lane >> 5; const int wid = __builtin_amdgcn_readfirstlane(tid >> 6);
    const int sh = 2 * g, Lm1 = (SEQ >> sh) - 1, p0 = blk * 256;
    const bool first = ((p0 & Lm1) == 0);
    const size_t gofs = (size_t)g * ((size_t)M * 512);
    const bf16* kg = ka + gofs + h * 64; const bf16* vg = va + gofs + h * 64;
#pragma unroll
    for (int it = 0; it < 6; ++it) { const int idx = it * 512 + tid, row = idx >> 3, ch = idx & 7; const long prow = (long)p0 - 128 + row;
        v4u kv4 = {0u, 0u, 0u, 0u}, vv4 = {0u, 0u, 0u, 0u};
        if (!(first && row < 128)) { kv4 = *(const v4u*)(kg + prow * 512 + ch * 8); vv4 = *(const v4u*)(vg + prow * 512 + ch * 8); }
        *(LAS v4u*)(lds + LDS_KS + row * KP + ch * 16) = kv4; *(LAS v4u*)(lds + LDS_VS + row * KP + ch * 16) = vv4; }
    LAS float* tab = (LAS float*)(lds + LDS_TAB);
    if (tid < 129) tab[tid] = rel_bias[t5_bucket(tid << sh) * 32 + g * 8 + h] * LOG2E;
    bf16x8 qr[4];
    { const bf16* qrow = qa + gofs + (size_t)(p0 + wid * 32 + r32) * 512 + h * 64 + hi * 8;
#pragma unroll
      for (int d0 = 0; d0 < 4; ++d0) qr[d0] = *(const bf16x8*)(qrow + d0 * 16); }
    __syncthreads();
    f32x16 S[5];
    { const LAS unsigned char* kb = lds + LDS_KS + (wid * 32 + r32) * KP + hi * 16;
#pragma unroll
      for (int c = 0; c < 5; ++c) { f32x16 a = {};
#pragma unroll
          for (int d0 = 0; d0 < 4; ++d0) { const bf16x8 kf = *(const LAS bf16x8*)(kb + c * 32 * KP + d0 * 32); a = __builtin_amdgcn_mfma_f32_32x32x16_bf16(kf, qr[d0], a, 0, 0, 0); }
          S[c] = a; } }
    float mx = -1e30f;
#pragma unroll
    for (int c = 0; c < 5; ++c)
#pragma unroll
        for (int i = 0; i < 16; ++i) { const int cr = (i & 3) + 8 * (i >> 2) + 4 * hi; const int steps = r32 + 128 - 32 * c - cr;
            bool valid = (steps >= 0) && (steps <= 128); if (first) valid = valid && (wid * 32 + 32 * c + cr >= 128);
            const int si = steps < 0 ? 0 : (steps > 128 ? 128 : steps);
            const float v = valid ? S[c][i] + tab[si] : -1e30f; S[c][i] = v; mx = fmaxf(mx, v); }
    mx = fmaxf(mx, __shfl_xor(mx, 32));
    float l = 0.f;
#pragma unroll
    for (int c = 0; c < 5; ++c)
#pragma unroll
        for (int i = 0; i < 16; ++i) { const float p = __builtin_amdgcn_exp2f(S[c][i] - mx); S[c][i] = p; l += p; }
    l += __shfl_xor(l, 32);
    f32x16 O[2]; O[0] = f32x16{}; O[1] = f32x16{};
    { const lds_cptr vb = (lds_cptr)(lds + LDS_VS) + (wid * 32 + 4 * hi + ((lane & 15) >> 2)) * KP + ((lane >> 4) & 1) * 32 + (lane & 3) * 8;
#pragma unroll
      for (int c = 0; c < 5; ++c)
#pragma unroll
          for (int s = 0; s < 2; ++s) { v4u pw; pw.x = cvtpk(S[c][8 * s], S[c][8 * s + 1]); pw.y = cvtpk(S[c][8 * s + 2], S[c][8 * s + 3]); pw.z = cvtpk(S[c][8 * s + 4], S[c][8 * s + 5]); pw.w = cvtpk(S[c][8 * s + 6], S[c][8 * s + 7]);
              const bf16x8 pk = __builtin_bit_cast(bf16x8, pw);
#pragma unroll
              for (int db = 0; db < 2; ++db) { const s16x4 lo = vtr(vb + (c * 32 + 16 * s) * KP + db * 64), h4 = vtr(vb + (c * 32 + 16 * s + 8) * KP + db * 64);
                  const bf16x8 vf = (bf16x8){lo[0], lo[1], lo[2], lo[3], h4[0], h4[1], h4[2], h4[3]};
                  O[db] = __builtin_amdgcn_mfma_f32_32x32x16_bf16(vf, pk, O[db], 0, 0, 0); } } }
    const float rl = 1.0f / l;
    const int p = p0 + wid * 32 + r32, bb = p >> 13, pp = p & 8191, rr = pp >> (13 - sh), ii = pp & Lm1; const int tok = (bb << 13) + (ii << sh) + rr;
    bf16* orow = og + gofs + (size_t)tok * 512 + h * 64 + 4 * hi;
#pragma unroll
    for (int db = 0; db < 2; ++db)
#pragma unroll
        for (int k4 = 0; k4 < 4; ++k4) { v2u w; w.x = cvtpk(O[db][4 * k4] * rl, O[db][4 * k4 + 1] * rl); w.y = cvtpk(O[db][4 * k4 + 2] * rl, O[db][4 * k4 + 3] * rl);
            *(v2u*)(orow + 32 * db + 8 * k4) = w; }
    if (hi == 0) lse[(size_t)g * ((size_t)M * 8) + (size_t)tok * 8 + h] = mx + __builtin_amdgcn_logf(l);
    __syncthreads();
}
}
constexpr int NPHASE = 12;
#ifndef MK_N_LAUNCHES
#define MK_N_LAUNCHES 1
#endif
struct Args { const float* in[18]; float* out; unsigned char* ws; int ph_lo, ph_hi; };
__device__ __forceinline__ void ln_rows(const float* zin, float* fout, bf16* bout, const float* gam, const float* bet, int gw, int ngw, int lane) {
    f32x4 gv[4], bv[4];
#pragma unroll
    for (int j = 0; j < 4; ++j) { gv[j] = *(const f32x4*)(gam + 4 * (64 * j + lane)); bv[j] = *(const f32x4*)(bet + 4 * (64 * j + lane)); }
    for (int m = gw; m < M; m += ngw) {
        const f32x4* xr = (const f32x4*)(zin + (size_t)m * 1024) + lane;
        f32x4 v[4]; float s = 0.f;
#pragma unroll
        for (int j = 0; j < 4; ++j) { v[j] = xr[64 * j]; s += (v[j].x + v[j].y) + (v[j].z + v[j].w); }
        const float mean = wave_sum(s) * (1.f / 1024.f); float s2 = 0.f;
#pragma unroll
        for (int j = 0; j < 4; ++j) { v[j] = v[j] - mean; s2 += (v[j].x * v[j].x + v[j].y * v[j].y) + (v[j].z * v[j].z + v[j].w * v[j].w); }
        const float rstd = 1.f / sqrtf(wave_sum(s2) * (1.f / 1024.f) + LN_EPS);
        f32x4* fo = (f32x4*)(fout + (size_t)m * 1024) + lane;
#pragma unroll
        for (int j = 0; j < 4; ++j) { v[j] = v[j] * rstd * gv[j] + bv[j]; fo[64 * j] = v[j]; }
        if (bout) { v2u* bo = (v2u*)(bout + (size_t)m * 1024) + lane;
#pragma unroll
            for (int j = 0; j < 4; ++j) { v2u w; w.x = pk2(v[j].x, v[j].y); w.y = pk2(v[j].z, v[j].w); bo[64 * j] = w; } }
    }
}

__global__ void __launch_bounds__(512, 2) fwd_mega(Args args) {
    extern __shared__ __attribute__((aligned(16))) unsigned char lds[];
    cg::grid_group grid = cg::this_grid();
    LAS unsigned char* L = (LAS unsigned char*)lds;
#define TIDS const int tid = threadIdx.x, lane = tid & 63, wave = __builtin_amdgcn_readfirstlane(tid >> 6); (void)tid; (void)lane; (void)wave
#define GRIDV const int G = gridDim.x, bx = blockIdx.x, vcu = (bx & 7) * (G >> 3) + (bx >> 3); (void)vcu
#define WSP(name, off) bf16* name = (bf16*)(args.ws + (off))
#define IN(k) (args.ph_lo <= (k) && (k) < args.ph_hi)
#define SEAM(k) do { if (IN(k) && IN((k) + 1)) { asm volatile("s_waitcnt vmcnt(0) lgkmcnt(0)" ::: "memory"); grid.sync(); __builtin_amdgcn_fence(__ATOMIC_ACQUIRE, "agent"); asm volatile("s_waitcnt vmcnt(0)" ::: "memory"); } } while (0)

    if (IN(0)) {
        TIDS; GRIDV; const int gw = vcu * 8 + wave, ngw = G * 8; const float* x = args.in[0];
        WSP(WinT, WS_WIN); WSP(WpaT, WS_WPA); WSP(WpbT, WS_WPB); WSP(WoT, WS_WO); WSP(W1T, WS_W1); WSP(W2T, WS_W2); WSP(XB, WS_XB);
        LAS float* scr = (LAS float*)(L + wave * 16384);
        constexpr int I_IN = 16 * 304, I_PA = 8 * 32, I_PB = 16 * 32, I_O = 16 * 32, I_1 = 16 * 128, I_2 = 64 * 32;
        constexpr int NITEMS = I_IN + I_PA + I_PB + I_O + I_1 + I_2;
        for (int it = gw; it < NITEMS; it += ngw) {
            int r = it;
            if (r < I_IN) { p0_transpose_item(args.in[1], 1024, 9728, WinT, scr, r, lane); continue; } r -= I_IN;
            if (r < I_PA) { p0_transpose_item(args.in[9], 512, 1024, WpaT, scr, r, lane); continue; } r -= I_PA;
            if (r < I_PB) { p0_transpose_item(args.in[10], 1024, 1024, WpbT, scr, r, lane); continue; } r -= I_PB;
            if (r < I_O) { p0_transpose_item(args.in[11], 1024, 1024, WoT, scr, r, lane); continue; } r -= I_O;
            if (r < I_1) { p0_transpose_item(args.in[16], 1024, 4096, W1T, scr, r, lane); continue; } r -= I_1;
            p0_transpose_item(args.in[17], 4096, 1024, W2T, scr, r, lane);
        }
        for (int m = gw; m < M; m += ngw) {
            const f32x4* xr = (const f32x4*)(x + (size_t)m * 1024) + lane; v2u* bo = (v2u*)(XB + (size_t)m * 1024) + lane;
#pragma unroll
            for (int j = 0; j < 4; ++j) { const f32x4 v = xr[64 * j]; v2u w; w.x = pk2(v.x, v.y); w.y = pk2(v.z, v.w); bo[64 * j] = w; }
        }
    }
    SEAM(0);
    if (IN(1)) {
        GRIDV; WSP(XB, WS_XB); WSP(WinT, WS_WIN); WSP(QA, WS_R1);
        pg8::Gemm g{XB, WinT, M, COLS_A, 1024}; pg8::StaticOrder S; S.init(M, COLS_A, G, bx);
        pg8::EpiA E{QA};
        pg8::gemm_phase<pg8::EpiA, pg8::StaticOrder, true, true>(L, g, S, E);
    }
    SEAM(1);
    if (IN(2)) {
        GRIDV; WSP(QA, WS_R1); WSP(OG, WS_OG); float* LSE = (float*)(args.ws + WS_LSE);
        const bf16* KA = QA + (size_t)3 * M * 512; const bf16* VA = KA + (size_t)3 * M * 512;
        for (int u = vcu; u < 3072; u += G) attn_a::unit(u >> 10, (u >> 7) & 7, u & 127, QA, KA, VA, OG, LSE, args.in[8], L);
    }
    SEAM(2);
    if (IN(3)) {
        { TIDS; GRIDV; const int gw = vcu * 8 + wave, ngw = G * 8; WSP(OG, WS_OG); const float* LSE = (const float*)(args.ws + WS_LSE); WSP(OA, WS_OA);
          for (int m = gw; m < M; m += ngw) {
            { const int hh = lane >> 3; float l0 = LSE[(size_t)m * 8 + hh], l1 = LSE[(size_t)M * 8 + (size_t)m * 8 + hh], l2 = LSE[(size_t)2 * M * 8 + (size_t)m * 8 + hh];
              const float mx = fmaxf(l0, fmaxf(l1, l2)); float w0 = exp2f(l0 - mx), w1 = exp2f(l1 - mx), w2 = exp2f(l2 - mx); const float rs = 1.f / (w0 + w1 + w2); w0 *= rs; w1 *= rs; w2 *= rs;
              const v4u a = *(const v4u*)(OG + (size_t)m * 512 + lane * 8), b = *(const v4u*)(OG + (size_t)M * 512 + (size_t)m * 512 + lane * 8), c = *(const v4u*)(OG + (size_t)2 * M * 512 + (size_t)m * 512 + lane * 8);
              v4u o;
              o.x = pk2(w0 * blo(a.x) + w1 * blo(b.x) + w2 * blo(c.x), w0 * bhi(a.x) + w1 * bhi(b.x) + w2 * bhi(c.x));
              o.y = pk2(w0 * blo(a.y) + w1 * blo(b.y) + w2 * blo(c.y), w0 * bhi(a.y) + w1 * bhi(b.y) + w2 * bhi(c.y));
              o.z = pk2(w0 * blo(a.z) + w1 * blo(b.z) + w2 * blo(c.z), w0 * bhi(a.z) + w1 * bhi(b.z) + w2 * bhi(c.z));
              o.w = pk2(w0 * blo(a.w) + w1 * blo(b.w) + w2 * blo(c.w), w0 * bhi(a.w) + w1 * bhi(b.w) + w2 * bhi(c.w));
              *(v4u*)(OA + (size_t)m * 512 + lane * 8) = o; }
          } }
        GRIDV; WSP(XB, WS_XB); WSP(WinT, WS_WIN); WSP(QB, WS_QB);
        pg8::Gemm g{XB, WinT + (size_t)COLS_A * 1024, M, 3072, 1024}; pg8::StaticOrder S; S.init(M, 3072, G, bx);
        pg8::EpiB E{QB};
        pg8::gemm_phase<pg8::EpiB, pg8::StaticOrder, true, true>(L, g, S, E);
    }
    SEAM(3);
    if (IN(4)) {
        TIDS; GRIDV; WSP(QB, WS_QB); WSP(O1, WS_O1); WSP(O2, WS_O2);
        LAS float* btab = (LAS float*)(L + attn_body::ATTN_LDS_BYTES);
        const float* rb = args.in[8];
        for (int i = tid; i < 8 * 640; i += 512) { const int hh = i / 640, d = i - hh * 640 - 255;
            btab[i] = d < 0 ? -INFINITY : (d < 128 ? (rb[t5_bucket(d) * 32 + 24 + hh] - rb[31 * 32 + 24 + hh]) * LOG2E : 0.f); }
        __syncthreads();
        const bf16* KB = QB + (size_t)M * 1024; const bf16* VB = KB + (size_t)M * 1024;
        for (int i = 0; i < 16; ++i) {
            const int ph = (vcu >> 3) * 4 + (i >> 2), k = i & 3, s = vcu & 7;
            const int qb = (k == 0) ? s : (k == 1) ? 15 - s : (k == 2) ? 16 + s : 31 - s;
            const int vh = ph & 1, mp = (ph >> 1) & 1, hh = (ph >> 2) & 7, bb = ph >> 5;
            const size_t rb0 = (size_t)bb * SEQ * 1024;
            const attn_body::bf16* Qp = (const attn_body::bf16*)(QB + rb0 + mp * 512 + hh * 64);
            const attn_body::bf16* Kp = (const attn_body::bf16*)(KB + rb0 + mp * 512 + hh * 64);
            const attn_body::bf16* Vp = (const attn_body::bf16*)(VB + rb0 + hh * 128 + vh * 64);
            attn_body::bf16* Op = (attn_body::bf16*)((mp ? O2 : O1) + rb0 + hh * 128 + vh * 64);
            attn_body::attn_unit<8>(qb, Qp, Kp, Vp, Op, (attn_body::lds_fptr)(btab + hh * 640), (char*)lds);
        }
    }
    SEAM(4);
    if (IN(5)) {
        { TIDS; GRIDV; const int gw = vcu * 8 + wave, ngw = G * 8; WSP(O1, WS_O1); WSP(O2, WS_O2); WSP(OB, WS_OB);
          const float d1 = wave_sum(args.in[3][lane] * args.in[4][lane]), d2 = wave_sum(args.in[5][lane] * args.in[6][lane]);
          const float lam = expf(d1) - expf(d2) + 0.2f;
          const float* sg = args.in[7] + (lane & 7) * 16;
          float gsc[16];
#pragma unroll
          for (int e = 0; e < 16; ++e) gsc[e] = sg[e] * 0.8f;
          for (int m = gw; m < M; m += ngw) {
            { const v4u a0 = *(const v4u*)(O1 + (size_t)m * 1024 + lane * 16), a1 = *(const v4u*)(O1 + (size_t)m * 1024 + lane * 16 + 8);
              const v4u b0 = *(const v4u*)(O2 + (size_t)m * 1024 + lane * 16), b1 = *(const v4u*)(O2 + (size_t)m * 1024 + lane * 16 + 8);
              float d[16];
              d[0] = blo(a0.x) - lam * blo(b0.x); d[1] = bhi(a0.x) - lam * bhi(b0.x); d[2] = blo(a0.y) - lam * blo(b0.y); d[3] = bhi(a0.y) - lam * bhi(b0.y);
              d[4] = blo(a0.z) - lam * blo(b0.z); d[5] = bhi(a0.z) - lam * bhi(b0.z); d[6] = blo(a0.w) - lam * blo(b0.w); d[7] = bhi(a0.w) - lam * bhi(b0.w);
              d[8] = blo(a1.x) - lam * blo(b1.x); d[9] = bhi(a1.x) - lam * bhi(b1.x); d[10] = blo(a1.y) - lam * blo(b1.y); d[11] = bhi(a1.y) - lam * bhi(b1.y);
              d[12] = blo(a1.z) - lam * blo(b1.z); d[13] = bhi(a1.z) - lam * bhi(b1.z); d[14] = blo(a1.w) - lam * blo(b1.w); d[15] = bhi(a1.w) - lam * bhi(b1.w);
              float ss = 0.f;
#pragma unroll
              for (int e = 0; e < 16; ++e) ss += d[e] * d[e];
              ss += __shfl_xor(ss, 1); ss += __shfl_xor(ss, 2); ss += __shfl_xor(ss, 4);
              const float rn = 1.f / sqrtf(ss * (1.f / 128.f) + LN_EPS);
              v4u o0, o1;
              o0.x = pk2(d[0] * rn * gsc[0], d[1] * rn * gsc[1]); o0.y = pk2(d[2] * rn * gsc[2], d[3] * rn * gsc[3]); o0.z = pk2(d[4] * rn * gsc[4], d[5] * rn * gsc[5]); o0.w = pk2(d[6] * rn * gsc[6], d[7] * rn * gsc[7]);
              o1.x = pk2(d[8] * rn * gsc[8], d[9] * rn * gsc[9]); o1.y = pk2(d[10] * rn * gsc[10], d[11] * rn * gsc[11]); o1.z = pk2(d[12] * rn * gsc[12], d[13] * rn * gsc[13]); o1.w = pk2(d[14] * rn * gsc[14], d[15] * rn * gsc[15]);
              *(v4u*)(OB + (size_t)m * 1024 + lane * 16) = o0; *(v4u*)(OB + (size_t)m * 1024 + lane * 16 + 8) = o1; }
          } }
        GRIDV; WSP(XB, WS_XB); WSP(WinT, WS_WIN); WSP(GATES, WS_GATES);
        pg8::Gemm g{XB, WinT + (size_t)7680 * 1024, M, 2048, 1024}; pg8::StaticOrder S; S.init(M, 2048, G, bx);
        pg8::EpiSig E{GATES, args.in[2]};
        pg8::gemm_phase<pg8::EpiSig, pg8::StaticOrder, true, true>(L, g, S, E);
    }
    SEAM(5);
    if (IN(6)) {
        GRIDV; WSP(OA, WS_OA); WSP(OB, WS_OB); WSP(WpaT, WS_WPA); WSP(WpbT, WS_WPB); WSP(TMP, WS_TMP); WSP(MERGED, WS_MERGED); WSP(GATES, WS_GATES);
        { pg8::Gemm g{OA, WpaT, M, 1024, 512}; pg8::StaticOrder S; S.init(M, 1024, G, bx);
          pg8::EpiGate<false> E{GATES, nullptr, TMP};
          pg8::gemm_phase<pg8::EpiGate<false>, pg8::StaticOrder, true, true>(L, g, S, E); }
        { pg8::Gemm g{OB, WpbT, M, 1024, 1024}; pg8::StaticOrder S; S.init(M, 1024, G, bx);
          pg8::EpiGate<true> E{GATES + 1024, TMP, MERGED};
          pg8::gemm_phase<pg8::EpiGate<true>, pg8::StaticOrder, true, true>(L, g, S, E); }
    }
    SEAM(6);
    if (IN(7)) {
        GRIDV; WSP(MERGED, WS_MERGED); WSP(WoT, WS_WO); const float* x = args.in[0]; float* Z = (float*)(args.ws + WS_Z);
        pg8::Gemm g{MERGED, WoT, M, 1024, 1024}; pg8::StaticOrder S; S.init(M, 1024, G, bx);
        pg8::EpiZ E{x, Z, DN_ALPHA};
        pg8::gemm_phase<pg8::EpiZ, pg8::StaticOrder, true, true>(L, g, S, E);
    }
    SEAM(7);
    if (IN(8)) { TIDS; GRIDV; WSP(X1B, WS_X1B); float* Z = (float*)(args.ws + WS_Z); ln_rows(Z, Z, X1B, args.in[12], args.in[13], vcu * 8 + wave, G * 8, lane); }
    SEAM(8);
    if (IN(9)) {
        GRIDV; WSP(X1B, WS_X1B); WSP(W1T, WS_W1); WSP(HB, WS_H);
        pg8::Gemm g{X1B, W1T, M, FF, 1024}; pg8::StaticOrder S; S.init(M, FF, G, bx);
        pg8::EpiRelu2 E{HB};
        pg8::gemm_phase<pg8::EpiRelu2, pg8::StaticOrder, true, true>(L, g, S, E);
    }
    SEAM(9);
    if (IN(10)) {
        GRIDV; WSP(HB, WS_H); WSP(W2T, WS_W2);
        pg8::Gemm g{HB, W2T, M, 1024, FF}; pg8::StaticOrder S; S.init(M, 1024, G, bx);
        float* Z = (float*)(args.ws + WS_Z); pg8::EpiZ E{Z, Z, DN_ALPHA};
        pg8::gemm_phase<pg8::EpiZ, pg8::StaticOrder, true, true>(L, g, S, E);
    }
    SEAM(10);
    if (IN(11)) { TIDS; GRIDV; const float* Z = (const float*)(args.ws + WS_Z); ln_rows(Z, args.out, nullptr, args.in[14], args.in[15], vcu * 8 + wave, G * 8, lane); }
#undef IN
#undef SEAM
}

extern "C" void kernel_launch(void* const* d_in, const int* in_sizes, int n_in, void* d_out, int out_size, void* d_ws, size_t ws_size, hipStream_t stream) {
    static int grid = 0;
    if (grid == 0) {
        if (n_in != 18 || in_sizes[0] != M * DMODEL || out_size != M * DMODEL || ws_size < WS_END) { fprintf(stderr, "kernel_launch: unexpected shapes (n_in %d, x %d, out %d, ws %zu)\n", n_in, n_in > 0 ? in_sizes[0] : -1, out_size, ws_size); grid = -1; return; }
        int dev = 0, cus = 0, per_cu = 0;
        hipGetDevice(&dev); hipDeviceGetAttribute(&cus, hipDeviceAttributeMultiprocessorCount, dev);
        if (hipFuncSetAttribute((const void*)fwd_mega, hipFuncAttributeMaxDynamicSharedMemorySize, LDS_BYTES) != hipSuccess) { fprintf(stderr, "kernel_launch: hipFuncSetAttribute failed\n"); grid = -1; return; }
        if (hipOccupancyMaxActiveBlocksPerMultiprocessor(&per_cu, (const void*)fwd_mega, 512, LDS_BYTES) != hipSuccess || per_cu < 1) { fprintf(stderr, "kernel_launch: occupancy query says %d\n", per_cu); per_cu = 1; }
        (void)hipGetLastError();
        grid = cus * 1;
    }
    if (grid < 0) return;
    Args a{};
    for (int i = 0; i < 18; ++i) a.in[i] = (const float*)d_in[i];
    a.out = (float*)d_out; a.ws = (unsigned char*)d_ws;
    constexpr int NL = MK_N_LAUNCHES;
    for (int li = 0; li < NL; ++li) {
        a.ph_lo = (NL == 1) ? 0 : li; a.ph_hi = (NL == 1) ? NPHASE : li + 1;
        void* kargs[] = {&a};
        const hipError_t e = hipLaunchCooperativeKernel((const void*)fwd_mega, dim3(grid), dim3(512), kargs, LDS_BYTES, stream);
        if (e != hipSuccess) { fprintf(stderr, "kernel_launch: cooperative launch %d failed: %s (grid %d)\n", li, hipGetErrorString(e), grid); break; }
    }
}
```

```cpp
#include <hip/hip_runtime.h>
#include <hip/hip_cooperative_groups.h>
#include <cstdio>
#include <cstdint>
namespace cg = cooperative_groups;
namespace pg8 {
#define PG8_LAS __attribute__((address_space(3)))
typedef unsigned short bf16_t;
typedef short bf16x8 __attribute__((ext_vector_type(8)));
typedef float f32x4 __attribute__((ext_vector_type(4)));
typedef unsigned u32x4 __attribute__((ext_vector_type(4)));
constexpr int BM = 256, BK = 64, HALF = 128, HTB = HALF * BK * 2  , STAGE_BYTES = 8 * HTB, NXCD = 8, WGM = 8;

__host__ __device__ __forceinline__ int lds_byte(int r, int c) { const int st = (r >> 4) * 2 + (c >> 5), rr = r & 15, cc = c & 31, ob = rr * 64 + cc * 2; return st * 1024 + (ob ^ (((ob >> 9) & 1) << 5)); }
__host__ __device__ __forceinline__ void stage_rc(int b, int& R, int& C) { const int st = b / 1024, sb = b % 1024, swz = sb ^ (((sb >> 9) & 1) << 5); R = (st >> 1) * 16 + swz / 64; C = (st & 1) * 32 + (swz % 64) / 2; }
__host__ __device__ __forceinline__ int perm32(int rho) { const int n = rho >> 4, i = rho & 15; return 8 * (i >> 2) + 4 * n + (i & 3); }

struct Unit { int pm, pn; };
struct Gemm { const bf16_t* A; const bf16_t* Bt; int M, N, K; };

struct StaticOrder {
    int nM, nN, nwg, G, c;
    __host__ __device__ void init(int M, int N, int G_, int c_) { nM = M / BM; nN = N / BM; nwg = nM * nN; G = G_; c = c_; }
    __host__ __device__ bool next(int i, Unit& u) const {
        const long L = (long)i * G + c; if (L >= nwg) return false;
        int wgid = (int)L; { const int q = nwg / NXCD, r = nwg % NXCD, xcd = wgid % NXCD, off = wgid / NXCD; wgid = (xcd < r ? xcd * (q + 1) : r * (q + 1) + (xcd - r) * q) + off; }
        const int nig = WGM * nN, gid = wgid / nig, fm = gid * WGM, gsz = (nM - fm) < WGM ? (nM - fm) : WGM;
        u.pm = fm + ((wgid % nig) % gsz); u.pn = (wgid % nig) / gsz; return true;
    }
    __device__ __forceinline__ void a_ready(const Unit&) const {}
    __device__ __forceinline__ void done(const Unit&) const {}
};

__device__ __forceinline__ unsigned cvt_pk_bf16(float lo, float hi) { unsigned r; asm volatile("v_cvt_pk_bf16_f32 %0, %1, %2" : "=v"(r) : "v"(lo), "v"(hi)); return r; }
typedef float f32x2 __attribute__((ext_vector_type(2)));
constexpr float QK_C2 = 0.125f * 1.4426950408889634f;
constexpr int MROWS = 32768;
__device__ __forceinline__ float bf_lo(unsigned w) { return __uint_as_float(w << 16); }
__device__ __forceinline__ float bf_hi(unsigned w) { return __uint_as_float(w & 0xffff0000u); }
typedef float f32x2c_t __attribute__((ext_vector_type(2))); typedef __bf16 bf16x2c_t __attribute__((ext_vector_type(2)));
__device__ __forceinline__ unsigned cvt_pk_bf16_c(float lo, float hi) { f32x2c_t v = {lo, hi}; bf16x2c_t b = __builtin_convertvector(v, bf16x2c_t); return __builtin_bit_cast(unsigned, b); }
__device__ __forceinline__ u32x4 pack8c(const f32x4 v0, const f32x4 v1) { u32x4 w; w.x = cvt_pk_bf16_c(v0[0], v0[1]); w.y = cvt_pk_bf16_c(v0[2], v0[3]); w.z = cvt_pk_bf16_c(v1[0], v1[1]); w.w = cvt_pk_bf16_c(v1[2], v1[3]); return w; }
__device__ __forceinline__ u32x4 pack8(const f32x4 v0, const f32x4 v1) { u32x4 w; w.x = cvt_pk_bf16(v0[0], v0[1]); w.y = cvt_pk_bf16(v0[2], v0[3]); w.z = cvt_pk_bf16(v1[0], v1[1]); w.w = cvt_pk_bf16(v1[2], v1[3]); return w; }
struct EpiA {
    static constexpr bool PERM = true, AFTER_DRAIN = false;
    bf16_t* base;
    __device__ __forceinline__ void operator()(const f32x4 (&acc)[2][2][4][2], const Unit& u, int wr, int wc, int fr, int fq) const {
        const int which = u.pn / 6, rem = u.pn - which * 6, g = rem >> 1, half = rem & 1, sh = 2 * g;
        const float sc = which == 0 ? QK_C2 : 1.f;
        bf16_t* b0 = base + (size_t)(which * 3 + g) * ((size_t)MROWS * 512) + half * 256 + wc * 32 + 8 * fq;
#pragma unroll
        for (int ai = 0; ai < 2; ++ai)
#pragma unroll
            for (int m = 0; m < 4; ++m) { const int row = u.pm * BM + ai * HALF + wr * 64 + m * 16 + fr; const int bb = row >> 13, t = row & 8191;
                const int pos = (bb << 13) + ((t & ((1 << sh) - 1)) << (13 - sh)) + (t >> sh);
                bf16_t* rowp = b0 + (size_t)pos * 512;
#pragma unroll
                for (int bj = 0; bj < 2; ++bj) *(u32x4*)(rowp + bj * HALF) = pack8(acc[ai][bj][m][0] * sc, acc[ai][bj][m][1] * sc); }
    }
};
struct EpiB {
    static constexpr bool PERM = true, AFTER_DRAIN = false;
    bf16_t* qkv;
    __device__ __forceinline__ void operator()(const f32x4 (&acc)[2][2][4][2], const Unit& u, int wr, int wc, int fr, int fq) const {
        const int row0 = u.pm * BM + wr * 64 + fr;
        const int which = u.pn >> 2; const float sc = which == 0 ? QK_C2 : 1.f;
        bf16_t* b0 = qkv + (size_t)which * ((size_t)MROWS * 1024);
        const int c0 = (u.pn & 3) * 256 + wc * 32 + 8 * fq;
#pragma unroll
        for (int ai = 0; ai < 2; ++ai)
#pragma unroll
            for (int m = 0; m < 4; ++m) { const int row = row0 + ai * HALF + m * 16, bb = row >> 13, t = row & 8191;
#pragma unroll
                for (int bj = 0; bj < 2; ++bj) { const int c = c0 + bj * HALF;
                    const size_t off = (which == 2) ? ((size_t)((bb * 8 + (c >> 7)) * 8192 + t) * 128 + (c & 127)) : ((size_t)((bb * 16 + (c >> 6)) * 8192 + t) * 64 + (c & 63));
                    *(u32x4*)(b0 + off) = pack8(acc[ai][bj][m][0] * sc, acc[ai][bj][m][1] * sc); } }
    }
};
struct EpiSig {
    static constexpr bool PERM = true, AFTER_DRAIN = false;
    bf16_t* gates; const float* bgate;
    __device__ __forceinline__ void operator()(const f32x4 (&acc)[2][2][4][2], const Unit& u, int wr, int wc, int fr, int fq) const {
        const int row0 = u.pm * BM + wr * 64 + fr;
        const int gc = u.pn * 256 + wc * 32 + 8 * fq;
        f32x4 bv[2][2];
#pragma unroll
        for (int bj = 0; bj < 2; ++bj)
#pragma unroll
            for (int n = 0; n < 2; ++n) bv[bj][n] = *(const f32x4*)(bgate + gc + bj * HALF + 4 * n);
#pragma unroll
        for (int ai = 0; ai < 2; ++ai)
#pragma unroll
            for (int m = 0; m < 4; ++m) { bf16_t* rowp = gates + (size_t)(row0 + ai * HALF + m * 16) * 2048 + gc;
#pragma unroll
                for (int bj = 0; bj < 2; ++bj) { f32x4 v[2];
#pragma unroll
                    for (int n = 0; n < 2; ++n) { const f32x4 x = acc[ai][bj][m][n] + bv[bj][n];
#pragma unroll
                        for (int e = 0; e < 4; ++e) v[n][e] = __builtin_amdgcn_rcpf(1.f + __builtin_amdgcn_exp2f(-1.4426950408889634f * x[e])); }
                    *(u32x4*)(rowp + bj * HALF) = pack8c(v[0], v[1]); } }
    }
};
template <bool ADD> struct EpiGate {
    static constexpr bool PERM = true, AFTER_DRAIN = false;
    const bf16_t* gates; const bf16_t* tin; bf16_t* out;
    __device__ __forceinline__ void operator()(const f32x4 (&acc)[2][2][4][2], const Unit& u, int wr, int wc, int fr, int fq) const {
        const int row0 = u.pm * BM + wr * 64 + fr, col0 = u.pn * BM + wc * 32 + 8 * fq;
#pragma unroll
        for (int ai = 0; ai < 2; ++ai) {
            u32x4 gw[4][2], tw[4][2];
#pragma unroll
            for (int m = 0; m < 4; ++m)
#pragma unroll
                for (int bj = 0; bj < 2; ++bj) { const size_t row = (size_t)(row0 + ai * HALF + m * 16);
                    gw[m][bj] = *(const u32x4*)(gates + row * 2048 + col0 + bj * HALF);
                    if (ADD) tw[m][bj] = *(const u32x4*)(tin + row * 1024 + col0 + bj * HALF); }
#pragma unroll
            for (int m = 0; m < 4; ++m)
#pragma unroll
                for (int bj = 0; bj < 2; ++bj) { const size_t row = (size_t)(row0 + ai * HALF + m * 16); const u32x4 g = gw[m][bj];
                    f32x4 v0 = acc[ai][bj][m][0], v1 = acc[ai][bj][m][1];
                    v0[0] *= bf_lo(g.x); v0[1] *= bf_hi(g.x); v0[2] *= bf_lo(g.y); v0[3] *= bf_hi(g.y);
                    v1[0] *= bf_lo(g.z); v1[1] *= bf_hi(g.z); v1[2] *= bf_lo(g.w); v1[3] *= bf_hi(g.w);
                    if (ADD) { const u32x4 t = tw[m][bj];
                        v0[0] += bf_lo(t.x); v0[1] += bf_hi(t.x); v0[2] += bf_lo(t.y); v0[3] += bf_hi(t.y);
                        v1[0] += bf_lo(t.z); v1[1] += bf_hi(t.z); v1[2] += bf_lo(t.w); v1[3] += bf_hi(t.w); }
                    *(u32x4*)(out + row * 1024 + col0 + bj * HALF) = pack8(v0, v1); }
        }
    }
};
struct EpiZ {
    static constexpr bool PERM = false, AFTER_DRAIN = false;
    const float* res; float* out; float alpha;
    __device__ __forceinline__ void operator()(const f32x4 (&acc)[2][2][4][2], const Unit& u, int wr, int wc, int fr, int fq) const {
        const int row0 = u.pm * BM + wr * 64 + fr, col0 = u.pn * BM + wc * 32 + 4 * fq;
#pragma unroll
        for (int ai = 0; ai < 2; ++ai) {
            f32x4 r[4][2][2];
#pragma unroll
            for (int m = 0; m < 4; ++m) { const size_t off = (size_t)(row0 + ai * HALF + m * 16) * 1024 + col0;
#pragma unroll
                for (int bj = 0; bj < 2; ++bj)
#pragma unroll
                    for (int n = 0; n < 2; ++n) r[m][bj][n] = *(const f32x4*)(res + off + bj * HALF + n * 16); }
#pragma unroll
            for (int m = 0; m < 4; ++m) { const size_t off = (size_t)(row0 + ai * HALF + m * 16) * 1024 + col0;
#pragma unroll
                for (int bj = 0; bj < 2; ++bj)
#pragma unroll
                    for (int n = 0; n < 2; ++n) *(f32x4*)(out + off + bj * HALF + n * 16) = r[m][bj][n] * alpha + acc[ai][bj][m][n]; }
        }
    }
};
struct EpiRelu2 {
    static constexpr bool PERM = true, AFTER_DRAIN = false;
    bf16_t* out;
    __device__ __forceinline__ void operator()(const f32x4 (&acc)[2][2][4][2], const Unit& u, int wr, int wc, int fr, int fq) const {
        const int row0 = u.pm * BM + wr * 64 + fr, col0 = u.pn * BM + wc * 32 + 8 * fq;
#pragma unroll
        for (int ai = 0; ai < 2; ++ai)
#pragma unroll
            for (int m = 0; m < 4; ++m) { bf16_t* rowp = out + (size_t)(row0 + ai * HALF + m * 16) * 4096 + col0;
#pragma unroll
                for (int bj = 0; bj < 2; ++bj) { f32x4 v0 = acc[ai][bj][m][0], v1 = acc[ai][bj][m][1];
#pragma unroll
                    for (int e = 0; e < 4; ++e) { const float a = fmaxf(v0[e], 0.f), b = fmaxf(v1[e], 0.f); v0[e] = a * a; v1[e] = b * b; }
                    *(u32x4*)(rowp + bj * HALF) = pack8(v0, v1); } }
    }
};

template <class Epi, class Sched, bool ALIGN_EPI = false, bool SP2 = false>
__device__ __forceinline__ void gemm_phase(PG8_LAS unsigned char* lds, const Gemm g, const Sched& S, const Epi& E) {
    const int tid = threadIdx.x, wid = __builtin_amdgcn_readfirstlane(tid >> 6), lane = tid & 63, wr = wid >> 2, wc = wid & 3, fr = lane & 15, fq = lane >> 4;
    const int K = g.K, nt = K / BK;
    unsigned voffA[2], voffB[2];
#pragma unroll
    for (int i = 0; i < 2; ++i) { int R, C; stage_rc(tid * 16 + i * 8192, R, C); const int Rb = Epi::PERM ? ((R & ~31) + perm32(R & 31)) : R;
        voffA[i] = (unsigned)(R * K + C) * 2u; voffB[i] = (unsigned)(Rb * K + C) * 2u; }
    const size_t kstep = (size_t)(BK * 2);
    const size_t hstep = (size_t)HALF * K * 2;
    const size_t tstep = 2 * hstep;
    const unsigned ldsw = (unsigned)wid * 1024u;
    const int aoff = lds_byte(wr * 64 + fr, fq * 8), boff = lds_byte(wc * 32 + fr, fq * 8);
#define PG8_SA(b, h) (((b) * 2 + (h)) * HTB)
#define PG8_SB(b, h) ((4 + (b) * 2 + (h)) * HTB)
#define PG8_STAGE(bufoff, gbase, voff) do { _Pragma("unroll") for (int _i = 0; _i < 2; ++_i) \
        __builtin_amdgcn_global_load_lds((const unsigned*)((const char*)(gbase) + (voff)[_i]), (PG8_LAS unsigned*)(lds + (bufoff) + ldsw + _i * 8192), 16, 0, 0); } while (0)
#define PG8_LDA(dst, b, h) do { _Pragma("unroll") for (int m = 0; m < 4; ++m) _Pragma("unroll") for (int k = 0; k < 2; ++k) dst[m][k] = *(const PG8_LAS bf16x8*)(lds + PG8_SA(b, h) + aoff + m * 2048 + k * 1024); } while (0)
#define PG8_LDB(dst, b, h) do { _Pragma("unroll") for (int n = 0; n < 2; ++n) _Pragma("unroll") for (int k = 0; k < 2; ++k) dst[n][k] = *(const PG8_LAS bf16x8*)(lds + PG8_SB(b, h) + boff + n * 2048 + k * 1024); } while (0)
#define PG8_MMA(ai, bj, At, Bt) do { __builtin_amdgcn_s_setprio(1); _Pragma("unroll") for (int m = 0; m < 4; ++m) _Pragma("unroll") for (int n = 0; n < 2; ++n) _Pragma("unroll") for (int k = 0; k < 2; ++k) \
        acc[ai][bj][m][n] = __builtin_amdgcn_mfma_f32_16x16x32_bf16(Bt[n][k], At[m][k], acc[ai][bj][m][n], 0, 0, 0); __builtin_amdgcn_s_setprio(0); } while (0)
#define PG8_WAIT_V(n) asm volatile("s_waitcnt vmcnt(" #n ")" ::: "memory")
#define PG8_WAIT_L(n) asm volatile("s_waitcnt lgkmcnt(" #n ")" ::: "memory")
#define PG8_BAR __builtin_amdgcn_s_barrier()
#define PG8_SCHED __builtin_amdgcn_sched_barrier(0)
    Unit cur, nxt; int ui = 0;
    if (!S.next(0, cur)) return;
    f32x4 acc[2][2][4][2];
#pragma unroll
    for (int a = 0; a < 2; ++a)
#pragma unroll
        for (int b = 0; b < 2; ++b)
#pragma unroll
            for (int m = 0; m < 4; ++m)
#pragma unroll
                for (int n = 0; n < 2; ++n) acc[a][b][m][n] = (f32x4){0.f, 0.f, 0.f, 0.f};
    bf16x8 At[4][2], B0[2][2], B1[2][2];
    const char* cA = (const char*)g.A + (size_t)cur.pm * tstep; const char* cB = (const char*)g.Bt + (size_t)cur.pn * tstep;
    S.a_ready(cur);
    if constexpr (SP2) {
        PG8_STAGE(PG8_SB(0, 0), cB, voffB); PG8_STAGE(PG8_SB(0, 1), cB + hstep, voffB); PG8_STAGE(PG8_SA(0, 0), cA, voffA); PG8_STAGE(PG8_SA(0, 1), cA + hstep, voffA);
        if (wr == 1) PG8_BAR;
        PG8_WAIT_V(2); PG8_BAR;
        PG8_STAGE(PG8_SB(1, 0), cB + kstep, voffB); PG8_STAGE(PG8_SA(1, 0), cA + kstep, voffA); PG8_STAGE(PG8_SB(1, 1), cB + hstep + kstep, voffB);
        PG8_WAIT_V(6); PG8_BAR;
    } else {
        PG8_STAGE(PG8_SB(0, 0), cB, voffB); PG8_STAGE(PG8_SA(0, 0), cA, voffA); PG8_STAGE(PG8_SB(0, 1), cB + hstep, voffB); PG8_STAGE(PG8_SA(0, 1), cA + hstep, voffA);
        if (wr == 1) PG8_BAR;
        PG8_WAIT_V(4); PG8_BAR;
        PG8_STAGE(PG8_SB(1, 0), cB + kstep, voffB); PG8_STAGE(PG8_SA(1, 0), cA + kstep, voffA); PG8_STAGE(PG8_SB(1, 1), cB + hstep + kstep, voffB);
        PG8_WAIT_V(6); PG8_BAR;
    }
    for (;;) {
        const bool has_next = S.next(ui + 1, nxt);
        const char* nA = has_next ? (const char*)g.A + (size_t)nxt.pm * tstep : cA; const char* nB = has_next ? (const char*)g.Bt + (size_t)nxt.pn * tstep : cB;
        for (int t = 0; t < nt; t += 2) {
            const bool last = (t == nt - 2);
            const char* a1 = cA + (size_t)(t + 1) * kstep;
            const char* a2 = last ? nA : cA + (size_t)(t + 2) * kstep; const char* b2 = last ? nB : cB + (size_t)(t + 2) * kstep;
            const char* a3 = a2 + kstep; const char* b3 = b2 + kstep;
            if (last && has_next) S.a_ready(nxt);
            if constexpr (SP2) {
            PG8_LDB(B0, 0, 0); PG8_LDB(B1, 0, 1); PG8_SCHED; PG8_LDA(At, 0, 0); PG8_STAGE(PG8_SA(1, 1), a1 + hstep, voffA);
            PG8_WAIT_V(8); PG8_WAIT_L(0); PG8_BAR; PG8_MMA(0, 0, At, B0); PG8_MMA(0, 1, At, B1); PG8_BAR; PG8_SCHED;
            PG8_LDA(At, 0, 1); PG8_STAGE(PG8_SB(0, 0), b2, voffB); PG8_STAGE(PG8_SB(0, 1), b2 + hstep, voffB); PG8_STAGE(PG8_SA(0, 0), a2, voffA);
            PG8_WAIT_V(8); PG8_WAIT_L(0); PG8_BAR; PG8_MMA(1, 0, At, B0); PG8_MMA(1, 1, At, B1); PG8_BAR; PG8_SCHED;
            PG8_LDB(B0, 1, 0); PG8_LDB(B1, 1, 1); PG8_SCHED; PG8_LDA(At, 1, 0); PG8_STAGE(PG8_SA(0, 1), a2 + hstep, voffA);
            PG8_WAIT_V(8); PG8_WAIT_L(0); PG8_BAR; PG8_MMA(0, 0, At, B0); PG8_MMA(0, 1, At, B1); PG8_BAR; PG8_SCHED;
            PG8_LDA(At, 1, 1); PG8_STAGE(PG8_SB(1, 0), b3, voffB); PG8_STAGE(PG8_SB(1, 1), b3 + hstep, voffB); PG8_STAGE(PG8_SA(1, 0), a3, voffA);
            PG8_WAIT_V(8); PG8_WAIT_L(0); PG8_BAR; PG8_MMA(1, 0, At, B0); PG8_MMA(1, 1, At, B1); PG8_BAR; PG8_SCHED;
            } else {
            PG8_LDB(B0, 0, 0); PG8_SCHED; PG8_LDA(At, 0, 0); PG8_STAGE(PG8_SA(1, 1), a1 + hstep, voffA);
            PG8_WAIT_L(8); PG8_BAR; PG8_WAIT_L(0); PG8_MMA(0, 0, At, B0); PG8_BAR; PG8_SCHED;
            PG8_LDB(B1, 0, 1); PG8_STAGE(PG8_SB(0, 0), b2, voffB);
            PG8_BAR; PG8_WAIT_L(0); PG8_MMA(0, 1, At, B1); PG8_BAR;
            PG8_LDA(At, 0, 1); PG8_STAGE(PG8_SA(0, 0), a2, voffA);
            PG8_BAR; PG8_WAIT_L(0); PG8_MMA(1, 0, At, B0); PG8_BAR; PG8_SCHED;
            PG8_STAGE(PG8_SB(0, 1), b2 + hstep, voffB);
            PG8_WAIT_V(6); PG8_BAR; PG8_MMA(1, 1, At, B1); PG8_BAR;
            PG8_LDB(B0, 1, 0); PG8_SCHED; PG8_LDA(At, 1, 0); PG8_STAGE(PG8_SA(0, 1), a2 + hstep, voffA);
            PG8_WAIT_L(8); PG8_BAR; PG8_WAIT_L(0); PG8_MMA(0, 0, At, B0); PG8_BAR; PG8_SCHED;
            PG8_LDB(B1, 1, 1); PG8_STAGE(PG8_SB(1, 0), b3, voffB);
            PG8_BAR; PG8_WAIT_L(0); PG8_MMA(0, 1, At, B1); PG8_BAR;
            PG8_LDA(At, 1, 1); PG8_STAGE(PG8_SA(1, 0), a3, voffA);
            PG8_BAR; PG8_WAIT_L(0); PG8_MMA(1, 0, At, B0); PG8_BAR; PG8_SCHED;
            PG8_STAGE(PG8_SB(1, 1), b3 + hstep, voffB);
            PG8_WAIT_V(6); PG8_BAR; PG8_MMA(1, 1, At, B1); PG8_BAR;
            }
        }
        if constexpr (ALIGN_EPI) { if (wr == 0) PG8_BAR; }
        if constexpr (!Epi::AFTER_DRAIN) { E(acc, cur, wr, wc, fr, fq); S.done(cur); }
        if (!has_next) break;
#pragma unroll
        for (int a = 0; a < 2; ++a)
#pragma unroll
            for (int b = 0; b < 2; ++b)
#pragma unroll
                for (int m = 0; m < 4; ++m)
#pragma unroll
                    for (int n = 0; n < 2; ++n) acc[a][b][m][n] = (f32x4){0.f, 0.f, 0.f, 0.f};
        cur = nxt; cA = nA; cB = nB; ++ui;
        if constexpr (ALIGN_EPI) { if (wr == 1) PG8_BAR; }
    }
    PG8_WAIT_V(0);
    if constexpr (!ALIGN_EPI) { if (wr == 0) PG8_BAR; }
    PG8_BAR;
    if constexpr (Epi::AFTER_DRAIN) { E.fused(acc, cur, wr, wc, fr, fq, lds, wid, lane); S.done(cur); }
#undef PG8_SA
#undef PG8_SB
#undef PG8_STAGE
#undef PG8_LDA
#undef PG8_LDB
#undef PG8_MMA
#undef PG8_WAIT_V
#undef PG8_WAIT_L
#undef PG8_BAR
#undef PG8_SCHED
}
}
#include <hip/hip_bf16.h>
#include <cmath>
namespace attn_body {
using bf16=__hip_bfloat16;
using bf16x8=__attribute__((ext_vector_type(8)))short;
using s16x4=__attribute__((ext_vector_type(4)))short;
using f32x16=__attribute__((ext_vector_type(16)))float;
using u32x4=__attribute__((ext_vector_type(4)))unsigned;
constexpr int SEQ=8192,D=64,DM=1024;
constexpr int NW=8,QBLK=32,QB=QBLK*NW,KVBLK=64,NQB=SEQ/QB;
constexpr int ATTN_PITCH=DM, ATTN_UNIT_ROWS=QB;
__device__ __forceinline__ int crow(int r,int hi){return (r&3)+8*(r>>2)+4*hi;}
#define SBAR() __builtin_amdgcn_sched_barrier(0)
__device__ __forceinline__ void cmask(f32x16&p0,f32x16&p1,int jb,int qrel,int hi){
  const float NEG=-INFINITY; int kb=64*jb+4*hi;
  #pragma unroll
  for(int r=0;r<16;++r){int kv=kb+(r&3)+8*(r>>2); if(kv>qrel)p0[r]=NEG; if(kv+32>qrel)p1[r]=NEG;}
}

typedef __attribute__((address_space(3))) const float* lds_fptr;
__device__ __forceinline__ void bmask(f32x16&p0,f32x16&p1,int jb,int qrel,int hi,lds_fptr tab){
  lds_fptr tp=tab+(qrel-64*jb-4*hi+196);
  #pragma unroll
  for(int r=0;r<16;++r){const int off=(r&3)+8*(r>>2); p0[r]+=tp[59-off]; p1[r]+=tp[27-off];}
}
constexpr int NSLOT=3, SLOTB=8192;
constexpr int LDS_K=0, LDS_V=NSLOT*SLOTB, LDS_WS=2*NSLOT*SLOTB, LDS_OST=LDS_WS+NW*64*4, LDS_BYTES=LDS_OST+NW*4096;
constexpr float C2=0.125f*1.4426950408889634f;
__device__ __forceinline__ void glds16(const void*gsrc,unsigned lds_dst){unsigned keep;
  asm volatile("s_mov_b32 %0, m0\n\ts_mov_b32 m0, %2\n\ts_nop 0\n\tglobal_load_lds_dwordx4 %1, off\n\ts_mov_b32 m0, %0":"=&s"(keep):"v"(gsrc),"s"(lds_dst):"memory");}
__device__ __forceinline__ float max3f(float a,float b,float c){float r;asm("v_max3_f32 %0, %1, %2, %3":"=v"(r):"v"(a),"v"(b),"v"(c));return r;}
__device__ __forceinline__ float max2f(float a,float b){float r;asm("v_max_f32_e32 %0, %1, %2":"=v"(r):"v"(a),"v"(b));return r;}
__device__ __forceinline__ float fadd_s(float a,float b){float r;asm("v_add_f32_e32 %0, %1, %2":"=v"(r):"v"(a),"v"(b));return r;}
__device__ __forceinline__ float fsub_s(float a,float b){float r;asm("v_sub_f32_e32 %0, %1, %2":"=v"(r):"v"(a),"v"(b));return r;}
typedef float f32x2_t __attribute__((ext_vector_type(2))); typedef __bf16 bf16x2_t __attribute__((ext_vector_type(2)));
__device__ __forceinline__ unsigned cvtpk_s(float lo,float hi){f32x2_t v={lo,hi};bf16x2_t b=__builtin_convertvector(v,bf16x2_t);return __builtin_bit_cast(unsigned,b);}
#define WAIT_BAR(N) asm volatile("s_waitcnt vmcnt(" #N ") lgkmcnt(0)\n\ts_barrier":::"memory")

__device__ __forceinline__ void qkt(f32x16&p0,f32x16&p1,const char*Kslot,const bf16x8*qr,const f32x16&negm,int r32,int hi){
  const char*kb=Kslot+hi*1024+r32*16;
  #pragma unroll
  for(int d0=0;d0<4;++d0){
    const bf16x8 b0=*reinterpret_cast<const bf16x8*>(kb+d0*2048);
    const bf16x8 b1=*reinterpret_cast<const bf16x8*>(kb+d0*2048+512);
    if(d0==0){p0=__builtin_amdgcn_mfma_f32_32x32x16_bf16(b0,qr[0],negm,0,0,0);p1=__builtin_amdgcn_mfma_f32_32x32x16_bf16(b1,qr[0],negm,0,0,0);}
    else{p0=__builtin_amdgcn_mfma_f32_32x32x16_bf16(b0,qr[d0],p0,0,0,0);p1=__builtin_amdgcn_mfma_f32_32x32x16_bf16(b1,qr[d0],p1,0,0,0);}}
}
typedef __attribute__((address_space(3))) const char* lds_cptr;
typedef short v4i16_t __attribute__((ext_vector_type(4)));
__device__ __forceinline__ void kload8(bf16x8*kf,lds_cptr kp){
  kf[0]=*(const __attribute__((address_space(3))) bf16x8*)(kp);      kf[1]=*(const __attribute__((address_space(3))) bf16x8*)(kp+512);
  kf[2]=*(const __attribute__((address_space(3))) bf16x8*)(kp+2048); kf[3]=*(const __attribute__((address_space(3))) bf16x8*)(kp+2560);
  kf[4]=*(const __attribute__((address_space(3))) bf16x8*)(kp+4096); kf[5]=*(const __attribute__((address_space(3))) bf16x8*)(kp+4608);
  kf[6]=*(const __attribute__((address_space(3))) bf16x8*)(kp+6144); kf[7]=*(const __attribute__((address_space(3))) bf16x8*)(kp+6656);
}
__device__ __forceinline__ void kload2(bf16x8*kf,lds_cptr kp,int j){ kf[2*j]=*(const __attribute__((address_space(3))) bf16x8*)(kp+j*2048); kf[2*j+1]=*(const __attribute__((address_space(3))) bf16x8*)(kp+j*2048+512); }
__device__ __forceinline__ s16x4 vtr(lds_cptr p){ return __builtin_bit_cast(s16x4,__builtin_amdgcn_ds_read_tr16_b64_v4i16((__attribute__((address_space(3))) v4i16_t*)p)); }
__device__ __forceinline__ float rowmax(const f32x16&p0,const f32x16&p1){
  float a=max3f(p0[0],p0[1],p1[0]),b=max3f(p0[2],p0[3],p1[1]);a=max3f(a,p1[2],p1[3]);
  #pragma unroll
  for(int r=4;r<16;r+=4){a=max3f(a,p0[r],p0[r+1]);b=max3f(b,p0[r+2],p0[r+3]);a=max3f(a,p1[r],p1[r+1]);b=max3f(b,p1[r+2],p1[r+3]);}
  const float m=max2f(a,b);
  auto rr=__builtin_amdgcn_permlane32_swap(__float_as_uint(m),__float_as_uint(m),false,false);
  return max2f(__uint_as_float(rr[0]),__uint_as_float(rr[1]));
}
__device__ __forceinline__ void pv(f32x16*o,int vb,bf16x8 pa0,bf16x8 pa1,bf16x8 pa2,bf16x8 pa3){
  #pragma unroll
  for(int d0=0;d0<2;++d0){s16x4 lo[4],hi[4];
    #pragma unroll
    for(int ks=0;ks<4;++ks){
      asm volatile("ds_read_b64_tr_b16 %0,%1 offset:%c2":"=&v"(lo[ks]):"v"(vb),"i"(d0*4096+ks*1024):"memory");
      asm volatile("ds_read_b64_tr_b16 %0,%1 offset:%c2":"=&v"(hi[ks]):"v"(vb),"i"(d0*4096+ks*1024+512):"memory");}
    asm volatile("s_waitcnt lgkmcnt(0)":::"memory");SBAR();
    #define PK(k) (bf16x8){lo[k][0],lo[k][1],lo[k][2],lo[k][3],hi[k][0],hi[k][1],hi[k][2],hi[k][3]}
    o[d0]=__builtin_amdgcn_mfma_f32_32x32x16_bf16(pa0,PK(0),o[d0],0,0,0);
    o[d0]=__builtin_amdgcn_mfma_f32_32x32x16_bf16(pa1,PK(1),o[d0],0,0,0);
    o[d0]=__builtin_amdgcn_mfma_f32_32x32x16_bf16(pa2,PK(2),o[d0],0,0,0);
    o[d0]=__builtin_amdgcn_mfma_f32_32x32x16_bf16(pa3,PK(3),o[d0],0,0,0);
    #undef PK
  }
}

#ifndef ATTN_STORE16
#define ATTN_STORE16(p,v) (*(u32x4*)(p)=(v))
#endif
template<int THRL> __device__ __forceinline__ void attn_unit(int qb,const bf16*Q,const bf16*__restrict__ K,const bf16*__restrict__ V,bf16*O,lds_fptr tab,char*shm){
  __builtin_amdgcn_sched_barrier(0); int tid_=threadIdx.x; asm volatile("":"+v"(tid_));
  const int tid=tid_,lane=tid&63,r32=lane&31,hi=lane>>5; const int wid=__builtin_amdgcn_readfirstlane(tid>>6);
  const int q0=qb*QB;
  const bf16*Qw=Q+(long)(q0+wid*QBLK)*DM;
  const bf16*Kh=K,*Vh=V;
  const unsigned lds0=(unsigned)(uintptr_t)shm;
  float*wsf=(float*)(shm+LDS_WS)+wid*64;
  const bf16*ksrc=Kh+(long)lane*DM+wid*8;
  const bf16*vsrc=Vh+(long)(16*(wid&3)+(lane>>2))*DM+(wid>>2)*32+(lane&3)*8;
  const unsigned kdst=lds0+LDS_K+wid*1024, vdst=lds0+LDS_V+wid*1024;
  #define DMA_K(t,slot) glds16(ksrc+(long)(t)*KVBLK*DM,(unsigned)__builtin_amdgcn_readfirstlane(kdst+(slot)))
  #define DMA_V(t,slot) glds16(vsrc+(long)(t)*KVBLK*DM,(unsigned)__builtin_amdgcn_readfirstlane(vdst+(slot)))
  const int vb0=(int)(lds0+LDS_V)+((lane>>4)&1)*32+(lane&3)*8+(4*hi+((lane&15)>>2))*64;
  const char*Kbase=shm+LDS_K; bf16x8 kf[8];
  const lds_cptr shm3=(lds_cptr)shm; const lds_cptr kp0=shm3+LDS_K+hi*1024+r32*16; const lds_cptr vp0=shm3+LDS_V+((lane>>4)&1)*32+(lane&3)*8+(4*hi+((lane&15)>>2))*64;
  const int NT=(q0+QB)/KVBLK;
  DMA_K(0,0);DMA_V(0,0);DMA_K(1,SLOTB);
  bf16x8 qr[4];
  #pragma unroll
  for(int d0=0;d0<4;++d0)qr[d0]=*reinterpret_cast<const bf16x8*>(&Qw[(long)r32*DM+d0*16+hi*8]);
  float mhat=0.f,l_reg=0.f;f32x16 o[2];o[0]=f32x16{};o[1]=f32x16{};f32x16 negm=f32x16{};asm volatile("":"+v"(negm));
  const int qrel=wid*QBLK+r32;
  #define CMASK(P0,P1,t) do{int jb_=(t)-(NT-4); if(jb_>=-2)bmask(P0,P1,jb_,qrel,hi,tab);}while(0)
  bool resc=false;
  #define START(P0,P1) do{ const float rm=rowmax(P0,P1); resc=false; \
    { const float dl=rm; mhat=fadd_s(mhat,dl); \
      _Pragma("unroll") for(int r=0;r<16;++r){P0[r]=fsub_s(P0[r],dl);P1[r]=fsub_s(P1[r],dl);} \
      _Pragma("unroll") for(int r=0;r<16;++r)negm[r]=-mhat; asm volatile("":"+v"(negm)); } \
    _Pragma("unroll") for(int r=0;r<16;++r)P0[r]=__builtin_amdgcn_exp2f(P0[r]); }while(0)
  #define RESC() do{ if(resc){ asm volatile("s_waitcnt lgkmcnt(0)":::"memory"); \
      _Pragma("unroll") for(int d_=0;d_<2;++d_) _Pragma("unroll") for(int r=0;r<16;++r)o[d_][r]*=wsf[crow(r,hi)]; } }while(0)
  f32x16 pA0,pA1,pB0,pB1;
  int sl_prev=0,sl_cur=0,sl_next=SLOTB;
  #define ROT() do{sl_prev=sl_cur;sl_cur=sl_next;sl_next=(sl_next==(NSLOT-1)*SLOTB)?0:sl_next+SLOTB;}while(0)
  DMA_K(2,2*SLOTB);
  WAIT_BAR(3);
  qkt(pA0,pA1,Kbase,qr,negm,r32,hi);asm volatile("s_nop 15\n\ts_nop 7":"+v"(pA0),"+v"(pA1));CMASK(pA0,pA1,0);
  START(pA0,pA1);
  _Pragma("unroll") for(int r=0;r<16;++r)pA1[r]=__builtin_amdgcn_exp2f(pA1[r]);
  WAIT_BAR(0);
  DMA_K(3,0);DMA_V(1,SLOTB);
  ROT();
  kload8(kf,kp0+sl_cur);
  WAIT_BAR(2);
  s16x4 vlo[8],vhi[8]; u32x4 pw0,pw1,pw2,pw3;
  #define PKW(P,B) cvtpk_s(P[B],P[B+1])
  #define PAF(k) __builtin_bit_cast(bf16x8,pw##k)
  #define VFR(i) (bf16x8){vlo[i][0],vlo[i][1],vlo[i][2],vlo[i][3],vhi[i][0],vhi[i][1],vhi[i][2],vhi[i][3]}
  #define PIN(x) asm volatile("":"+v"(x))
  #define MX3(a,b,c) __builtin_fmaxf(__builtin_fmaxf((a),(b)),(c))
  #define GAPA(MF,A0,A1,A2,A3,W0,W1,PW) do{ MF; sacc+=A0; sacc+=A1; sacc+=A2; sacc+=A3; PIN(sacc); W0; W1; PIN(PW); SBAR(); }while(0)
  #define EX(v) __builtin_amdgcn_exp2f(v)
  #define GAPB(MF,X,B) do{ MF; X[B]=EX(X[B]); X[B+1]=EX(X[B+1]); X[B+2]=EX(X[B+2]); X[B+3]=EX(X[B+3]); PIN(X); SBAR(); }while(0)
  #define VRD(i) do{ vlo[i]=vtr(vp_+(((i)>>2)*4096+((i)&3)*1024)); vhi[i]=vtr(vp_+(((i)>>2)*4096+((i)&3)*1024+512)); }while(0)
  #define KRD(G,j) do{ if(G){ kload2(kf,kp0+sl_next,j); SBAR(); } }while(0)
  #define STEP(C0,C1,P0,P1,t,GK,GV,GL) do{ SBAR(); \
    const lds_cptr vp_=vp0+sl_prev; \
    VRD(0); SBAR(); float sacc=(P0[0]+P0[1]); \
    GAPA(C0=__builtin_amdgcn_mfma_f32_32x32x16_bf16(kf[0],qr[0],negm,0,0,0), P0[2],P0[3],P0[4],P0[5],     pw0[0]=PKW(P0,0), pw0[1]=PKW(P0,2), pw0); \
    VRD(4); SBAR(); GAPA(C1=__builtin_amdgcn_mfma_f32_32x32x16_bf16(kf[1],qr[0],negm,0,0,0), P0[6],P0[7],P0[8],P0[9],     pw0[2]=PKW(P0,4), pw0[3]=PKW(P0,6), pw0); \
    VRD(1); SBAR(); GAPA(C0=__builtin_amdgcn_mfma_f32_32x32x16_bf16(kf[2],qr[1],C0,0,0,0),   P0[10],P0[11],P0[12],P0[13], pw1[0]=PKW(P0,8), pw1[1]=PKW(P0,10), pw1); \
    VRD(5); SBAR(); GAPA(C1=__builtin_amdgcn_mfma_f32_32x32x16_bf16(kf[3],qr[1],C1,0,0,0),   P0[14],P0[15],P1[0],P1[1],   pw1[2]=PKW(P0,12),pw1[3]=PKW(P0,14), pw1); \
    VRD(2); SBAR(); GAPA(C0=__builtin_amdgcn_mfma_f32_32x32x16_bf16(kf[4],qr[2],C0,0,0,0),   P1[2],P1[3],P1[4],P1[5],     pw2[0]=PKW(P1,0), pw2[1]=PKW(P1,2), pw2); \
    VRD(6); SBAR(); GAPA(C1=__builtin_amdgcn_mfma_f32_32x32x16_bf16(kf[5],qr[2],C1,0,0,0),   P1[6],P1[7],P1[8],P1[9],     pw2[2]=PKW(P1,4), pw2[3]=PKW(P1,6), pw2); \
    VRD(3); SBAR(); GAPA(C0=__builtin_amdgcn_mfma_f32_32x32x16_bf16(kf[6],qr[3],C0,0,0,0),   P1[10],P1[11],P1[12],P1[13], pw3[0]=PKW(P1,8), pw3[1]=PKW(P1,10), pw3); \
    VRD(7); SBAR(); GAPA(C1=__builtin_amdgcn_mfma_f32_32x32x16_bf16(kf[7],qr[3],C1,0,0,0),   P1[14],P1[15],0.f,0.f,       pw3[2]=PKW(P1,12),pw3[3]=PKW(P1,14), pw3); \
    l_reg+=sacc; \
    if(GK){DMA_K((t)+3,sl_cur);} if(GV){DMA_V((t)+1,sl_next);} \
    CMASK(C0,C1,t); \
    { float a=MX3(C0[0],C0[1],C1[0]),b=MX3(C0[2],C0[3],C1[1]); a=MX3(a,C1[2],C1[3]); \
      _Pragma("unroll") for(int r=4;r<16;r+=4){a=MX3(a,C0[r],C0[r+1]);b=MX3(b,C0[r+2],C0[r+3]);a=MX3(a,C1[r],C1[r+1]);b=MX3(b,C1[r+2],C1[r+3]);} \
      float rm=__builtin_fmaxf(a,b); { auto rr=__builtin_amdgcn_permlane32_swap(__float_as_uint(rm),__float_as_uint(rm),false,false); rm=__builtin_fmaxf(__uint_as_float(rr[0]),__uint_as_float(rr[1])); } \
      resc=false; \
      if(__builtin_expect(__any(rm>(float)THRL),0)){ const float dl=__builtin_fmaxf(rm,0.f); mhat+=dl; \
        _Pragma("unroll") for(int r=0;r<16;++r){C0[r]-=dl;C1[r]-=dl;} \
        _Pragma("unroll") for(int r=0;r<16;++r)negm[r]=-mhat; asm volatile("":"+v"(negm)); \
        const float f=__builtin_amdgcn_exp2f(-dl); l_reg*=f; if(hi==0)wsf[r32]=f; resc=true; } } \
    SBAR(); \
    GAPB(o[0]=__builtin_amdgcn_mfma_f32_32x32x16_bf16(PAF(0),VFR(0),o[0],0,0,0), C0,0); \
    GAPB(o[1]=__builtin_amdgcn_mfma_f32_32x32x16_bf16(PAF(0),VFR(4),o[1],0,0,0), C0,4); \
    KRD(GL,0); GAPB(o[0]=__builtin_amdgcn_mfma_f32_32x32x16_bf16(PAF(1),VFR(1),o[0],0,0,0), C0,8); \
    KRD(GL,1); GAPB(o[1]=__builtin_amdgcn_mfma_f32_32x32x16_bf16(PAF(1),VFR(5),o[1],0,0,0), C0,12); \
    KRD(GL,2); GAPB(o[0]=__builtin_amdgcn_mfma_f32_32x32x16_bf16(PAF(2),VFR(2),o[0],0,0,0), C1,0); \
    KRD(GL,3); GAPB(o[1]=__builtin_amdgcn_mfma_f32_32x32x16_bf16(PAF(2),VFR(6),o[1],0,0,0), C1,4); \
    GAPB(o[0]=__builtin_amdgcn_mfma_f32_32x32x16_bf16(PAF(3),VFR(3),o[0],0,0,0), C1,8); \
    GAPB(o[1]=__builtin_amdgcn_mfma_f32_32x32x16_bf16(PAF(3),VFR(7),o[1],0,0,0), C1,12); \
    }while(0)
  int t=1;
  #undef CMASK
  #define CMASK(P0,P1,t) do{}while(0)
  for(;t+7<NT;t+=2){
    STEP(pB0,pB1,pA0,pA1,t,true,true,true);     WAIT_BAR(2); RESC(); ROT();
    STEP(pA0,pA1,pB0,pB1,t+1,true,true,true);   WAIT_BAR(2); RESC(); ROT();
  }
  #undef CMASK
  #define CMASK(P0,P1,t) do{int jb_=(t)-(NT-4); if(jb_>=-2)bmask(P0,P1,jb_,qrel,hi,tab);}while(0)
  #define ENDW(tt) do{ if((tt)+3<NT){WAIT_BAR(2);} else if((tt)+2<NT){WAIT_BAR(1);} else {WAIT_BAR(0);} }while(0)
  for(;t+1<NT;t+=2){
    STEP(pB0,pB1,pA0,pA1,t,(t+3<NT),(t+1<NT),(t+1<NT));       ENDW(t);   RESC(); ROT();
    STEP(pA0,pA1,pB0,pB1,t+1,(t+4<NT),(t+2<NT),(t+2<NT));     ENDW(t+1); RESC(); ROT();
  }
  STEP(pB0,pB1,pA0,pA1,NT-1,false,false,false); RESC();
  { float sacc=pB0[0]+pB0[1]; _Pragma("unroll") for(int r=2;r<16;++r)sacc+=pB0[r]; _Pragma("unroll") for(int r=0;r<16;++r)sacc+=pB1[r]; l_reg+=sacc;
    pw0=(u32x4){PKW(pB0,0),PKW(pB0,2),PKW(pB0,4),PKW(pB0,6)};pw1=(u32x4){PKW(pB0,8),PKW(pB0,10),PKW(pB0,12),PKW(pB0,14)};pw2=(u32x4){PKW(pB1,0),PKW(pB1,2),PKW(pB1,4),PKW(pB1,6)};pw3=(u32x4){PKW(pB1,8),PKW(pB1,10),PKW(pB1,12),PKW(pB1,14)};
    SBAR(); pv(o,vb0+sl_cur,PAF(0),PAF(1),PAF(2),PAF(3)); }
  #undef PKW
  #undef PAF
  #undef VFR
  #undef PIN
  #undef MX3
  #undef GAPA
  #undef GAPB
  #undef EX
  #undef VRD
  #undef KRD
  #undef STEP
  #undef ENDW
  {auto rr=__builtin_amdgcn_permlane32_swap(__float_as_uint(l_reg),__float_as_uint(l_reg),false,false);l_reg=__uint_as_float(rr[0])+__uint_as_float(rr[1]);}
  if(hi==0)wsf[32+r32]=l_reg;asm volatile("s_waitcnt lgkmcnt(0)":::"memory");
  float rli[16];
  #pragma unroll
  for(int r=0;r<16;++r)rli[r]=__builtin_amdgcn_rcpf(wsf[32+crow(r,hi)]);
  bf16*Ow=O+(long)(q0+wid*QBLK)*DM;
  { bf16*stg=(bf16*)(shm+LDS_OST)+wid*2048;
    #pragma unroll
    for(int r=0;r<16;++r){const int orow=crow(r,hi);
      #pragma unroll
      for(int d0=0;d0<2;++d0)stg[orow*64+d0*32+r32]=__float2bfloat16(o[d0][r]*rli[r]);}
    asm volatile("s_waitcnt lgkmcnt(0)":::"memory");
    #pragma unroll
    for(int i=0;i<4;++i){const int row=i*8+(lane>>3),ch=lane&7; const u32x4 v=*(const u32x4*)(stg+row*64+ch*8); ATTN_STORE16(Ow+(long)row*DM+ch*8,v);} }
  asm volatile("s_waitcnt lgkmcnt(0)\n\ts_barrier":::"memory");
  __builtin_amdgcn_sched_barrier(0);
  #undef DMA_K
  #undef DMA_V
  #undef CMASK
  #undef START
  #undef RESC
  #undef ROT
}
constexpr int ATTN_LDS_BYTES=LDS_BYTES;
#undef SBAR
#undef WAIT_BAR
}
constexpr int SEQ = 8192, DMODEL = 1024, M = 4 * SEQ, FF = 4096, COLS_A = 4608, COLS_B2 = 5120;
constexpr float LN_EPS = 1e-5f, LOG2E = 1.4426950408889634f;
constexpr float DN_ALPHA = 1.189207115002721f;
constexpr size_t MiB = 1u << 20;
constexpr size_t WS_WIN = 0, WS_WPA = 19 * MiB, WS_WPB = 20 * MiB, WS_WO = 22 * MiB, WS_W1 = 24 * MiB, WS_W2 = 32 * MiB;
constexpr size_t WS_R1 = 40 * MiB;
constexpr size_t WS_R2 = 328 * MiB;
constexpr size_t WS_OG = WS_R2, WS_LSE = WS_R2 + 96 * MiB;
constexpr size_t WS_XB = 427 * MiB;
constexpr size_t WS_OA = WS_R1, WS_QB = WS_R1 + 32 * MiB, WS_O1 = WS_R1 + 224 * MiB, WS_O2 = WS_R2;
constexpr size_t WS_OB = WS_R1 + 32 * MiB, WS_GATES = WS_R1 + 96 * MiB, WS_TMP = WS_R1 + 224 * MiB, WS_MERGED = WS_XB;
constexpr size_t WS_Z = WS_R1, WS_X1B = WS_XB, WS_H = WS_R1 + 128 * MiB, WS_END = 491 * MiB;
constexpr int RING_BYTES = 131072, LDS_BYTES = 147456;

#define GAS __attribute__((address_space(1)))
#define LAS __attribute__((address_space(3)))
typedef unsigned short bf16;
typedef unsigned v4u __attribute__((ext_vector_type(4)));
typedef unsigned v2u __attribute__((ext_vector_type(2)));
typedef float f32x4 __attribute__((ext_vector_type(4)));
typedef float f32x16 __attribute__((ext_vector_type(16)));
typedef short bf16x8 __attribute__((ext_vector_type(8)));
typedef short s16x4 __attribute__((ext_vector_type(4)));
#define LDS_WAIT() asm volatile("s_waitcnt lgkmcnt(0)" ::: "memory")
__device__ __forceinline__ unsigned f2bf(float f) { unsigned u = __builtin_bit_cast(unsigned, f); return (u + 0x7fffu + ((u >> 16) & 1u)) >> 16; }
__device__ __forceinline__ unsigned pk2(float lo, float hi) { return f2bf(lo) | (f2bf(hi) << 16); }
__device__ __forceinline__ float blo(unsigned w) { return __uint_as_float(w << 16); }
__device__ __forceinline__ float bhi(unsigned w) { return __uint_as_float(w & 0xffff0000u); }
__device__ __forceinline__ float wave_sum(float v) {
#pragma unroll
    for (int o = 1; o < 64; o <<= 1) v += __shfl_xor(v, o);
    return v;
}
__device__ __forceinline__ int t5_bucket(int n) {
    if (n < 16) return n;
    const float v = logf((float)n / 16.0f) / 2.0794415416798357f * 16.0f;
    int l = 16 + (int)v; return l > 31 ? 31 : l;
}
__device__ __forceinline__ void p0_transpose_item(const float* W, int K, int N, bf16* WT, LAS float* scr, int item, int lane) {
    const int nblk = N / 32, kb = item / nblk, nb = item % nblk, k0 = 64 * kb, n0 = 32 * nb;
#pragma unroll 8
    for (int i = 0; i < 32; ++i) { const int kk = 2 * i + (lane >> 5); scr[kk * 33 + (lane & 31)] = W[(size_t)(k0 + kk) * N + n0 + (lane & 31)]; }
    LDS_WAIT(); asm volatile("" ::: "memory");
    const int c = lane & 7;
#pragma unroll
    for (int j = 0; j < 4; ++j) { const int n = (lane >> 3) + 8 * j; const LAS float* s = scr + (8 * c) * 33 + n;
        v4u o; o.x = pk2(s[0 * 33], s[1 * 33]); o.y = pk2(s[2 * 33], s[3 * 33]); o.z = pk2(s[4 * 33], s[5 * 33]); o.w = pk2(s[6 * 33], s[7 * 33]);
        *(v4u*)(WT + (size_t)(n0 + n) * K + k0 + 8 * c) = o; }
    LDS_WAIT(); asm volatile("" ::: "memory");
}

namespace attn_a {
constexpr int KP = 144, LDS_KS = 0, LDS_VS = 384 * KP, LDS_TAB = 2 * 384 * KP;
typedef __attribute__((address_space(3))) const char* lds_cptr;
typedef short v4i16_t __attribute__((ext_vector_type(4)));
__device__ __forceinline__ s16x4 vtr(lds_cptr p) { return __builtin_bit_cast(s16x4, __builtin_amdgcn_ds_read_tr16_b64_v4i16((__attribute__((address_space(3))) v4i16_t*)p)); }
typedef float f32x2_t __attribute__((ext_vector_type(2))); typedef __bf16 bf16x2_t __attribute__((ext_vector_type(2)));
__device__ __forceinline__ unsigned cvtpk(float lo, float hi) { f32x2_t v = {lo, hi}; bf16x2_t b = __builtin_convertvector(v, bf16x2_t); return __builtin_bit_cast(unsigned, b); }
__device__ __forceinline__ void unit(int g, int h, int blk, const bf16* qa, const bf16* ka, const bf16* va, bf16* og, float* lse, const float* rel_bias, LAS unsigned char* lds) {
    const int tid = threadIdx.x, lane = tid & 63, r32 = lane & 31, hi = lane >> 5; const int wid = __builtin_amdgcn_readfirstlane(tid >> 6);
    const int sh = 2 * g, Lm1 = (SEQ >> sh) - 1, p0 = blk * 256;
    const bool first = ((p0 & Lm1) == 0);
    const size_t gofs = (size_t)g * ((size_t)M * 512);
    const bf16* kg = ka + gofs + h * 64; const bf16* vg = va + gofs + h * 64;
#pragma unroll
    for (int it = 0; it < 6; ++it) { const int idx = it * 512 + tid, row = idx >> 3, ch = idx & 7; const long prow = (long)p0 - 128 + row;
        v4u kv4 = {0u, 0u, 0u, 0u}, vv4 = {0u, 0u, 0u, 0u};
        if (!(first && row < 128)) { kv4 = *(const v4u*)(kg + prow * 512 + ch * 8); vv4 = *(const v4u*)(vg + prow * 512 + ch * 8); }
        *(LAS v4u*)(lds + LDS_KS + row * KP + ch * 16) = kv4; *(LAS v4u*)(lds + LDS_VS + row * KP + ch * 16) = vv4; }
    LAS float* tab = (LAS float*)(lds + LDS_TAB);
    if (tid < 129) tab[tid] = rel_bias[t5_bucket(tid << sh) * 32 + g * 8 + h] * LOG2E;
    bf16x8 qr[4];
    { const bf16* qrow = qa + gofs + (size_t)(p0 + wid * 32 + r32) * 512 + h * 64 + hi * 8;
#pragma unroll
      for (int d0 = 0; d0 < 4; ++d0) qr[d0] = *(const bf16x8*)(qrow + d0 * 16); }
    __syncthreads();
    f32x16 S[5];
    { const LAS unsigned char* kb = lds + LDS_KS + (wid * 32 + r32) * KP + hi * 16;
#pragma unroll
      for (int c = 0; c < 5; ++c) { f32x16 a = {};
#pragma unroll
          for (int d0 = 0; d0 < 4; ++d0) { const bf16x8 kf = *(const LAS bf16x8*)(kb + c * 32 * KP + d0 * 32); a = __builtin_amdgcn_mfma_f32_32x32x16_bf16(kf, qr[d0], a, 0, 0, 0); }
          S[c] = a; } }
    float mx = -1e30f;
#pragma unroll
    for (int c = 0; c < 5; ++c)
#pragma unroll
        for (int i = 0; i < 16; ++i) { const int cr = (i & 3) + 8 * (i >> 2) + 4 * hi; const int steps = r32 + 128 - 32 * c - cr;
            bool valid = (steps >= 0) && (steps <= 128); if (first) valid = valid && (wid * 32 + 32 * c + cr >= 128);
            const int si = steps < 0 ? 0 : (steps > 128 ? 128 : steps);
            const float v = valid ? S[c][i] + tab[si] : -1e30f; S[c][i] = v; mx = fmaxf(mx, v); }
    mx = fmaxf(mx, __shfl_xor(mx, 32));
    float l = 0.f;
#pragma unroll
    for (int c = 0; c < 5; ++c)
#pragma unroll
        for (int i = 0; i < 16; ++i) { const float p = __builtin_amdgcn_exp2f(S[c][i] - mx); S[c][i] = p; l += p; }
    l += __shfl_xor(l, 32);
    f32x16 O[2]; O[0] = f32x16{}; O[1] = f32x16{};
    { const lds_cptr vb = (lds_cptr)(lds + LDS_VS) + (wid * 32 + 4 * hi + ((lane & 15) >> 2)) * KP + ((lane >> 4) & 1) * 32 + (lane & 3) * 8;
#pragma unroll
      for (int c = 0; c < 5; ++c)
#pragma unroll
          for (int s = 0; s < 2; ++s) { v4u pw; pw.x = cvtpk(S[c][8 * s], S[c][8 * s + 1]); pw.y = cvtpk(S[c][8 * s + 2], S[c][8 * s + 3]); pw.z = cvtpk(S[c][8 * s + 4], S[c][8 * s + 5]); pw.w = cvtpk(S[c][8 * s + 6], S[c][8 * s + 7]);
              const bf16x8 pk = __builtin_bit_cast(bf16x8, pw);
#pragma unroll
              for (int db = 0; db < 2; ++db) { const s16x4 lo = vtr(vb + (c * 32 + 16 * s) * KP + db * 64), h4 = vtr(vb + (c * 32 + 16 * s + 8) * KP + db * 64);
                  const bf16x8 vf = (bf16x8){lo[0], lo[1], lo[2], lo[3], h4[0], h4[1], h4[2], h4[3]};
                  O[db] = __builtin_amdgcn_mfma_f32_32x32x16_bf16(vf, pk, O[db], 0, 0, 0); } } }
    const float rl = 1.0f / l;
    const int p = p0 + wid * 32 + r32, bb = p >> 13, pp = p & 8191, rr = pp >> (13 - sh), ii = pp & Lm1; const int tok = (bb << 13) + (ii << sh) + rr;
    bf16* orow = og + gofs + (size_t)tok * 512 + h * 64 + 4 * hi;
#pragma unroll
    for (int db = 0; db < 2; ++db)
#pragma unroll
        for (int k4 = 0; k4 < 4; ++k4) { v2u w; w.x = cvtpk(O[db][4 * k4] * rl, O[db][4 * k4 + 1] * rl); w.y = cvtpk(O[db][4 * k4 + 2] * rl, O[db][4 * k4 + 3] * rl);
            *(v2u*)(orow + 32 * db + 8 * k4) = w; }
    if (hi == 0) lse[(size_t)g * ((size_t)M * 8) + (size_t)tok * 8 + h] = mx + __builtin_amdgcn_logf(l);
    __syncthreads();
}
}
namespace attn_b2 {
constexpr int KBUF = 8192, VBUF = 16384, NKS = 4, NVS = 5, L_K = 0, L_V = NKS * KBUF, L_END = NKS * KBUF + NVS * VBUF;
typedef __attribute__((address_space(3))) const char* lds_cptr;
using attn_a::vtr; using attn_a::cvtpk;
__device__ __forceinline__ void glds16(const void* gsrc, unsigned lds_dst) { unsigned keep;
    asm volatile("s_mov_b32 %0, m0\n\ts_mov_b32 m0, %2\n\ts_nop 0\n\tglobal_load_lds_dwordx4 %1, off\n\ts_mov_b32 m0, %0" : "=&s"(keep) : "v"(gsrc), "s"(lds_dst) : "memory"); }
template <int THR> __device__ __forceinline__ void unit(int qb, const bf16* Q, const bf16* K, const bf16* V, bf16* O, attn_body::lds_fptr tab, LAS unsigned char* lds) {
    const int tid = threadIdx.x, lane = tid & 63, r32 = lane & 31, hi = lane >> 5; const int wid = __builtin_amdgcn_readfirstlane(tid >> 6);
    const int q0 = qb * 256, NT = 4 * qb + 4, qrel = wid * 32 + r32;
    const unsigned lds0 = (unsigned)(uintptr_t)lds;
    const int krow = 8 * wid + (lane >> 3), kc = (lane & 7) ^ ((krow >> 1) & 7);
    const bf16* ksrc = K + krow * 64 + kc * 8;
    const int vrow0 = 8 * wid + (lane >> 4), vrow1 = vrow0 + 4, vc0 = (lane & 15) ^ ((vrow0 & 3) << 2), vc1 = (lane & 15) ^ ((vrow1 & 3) << 2);
    const bf16* vsrc0 = V + vrow0 * 128 + vc0 * 8; const bf16* vsrc1 = V + vrow1 * 128 + vc1 * 8;
    const unsigned kdst = lds0 + L_K + wid * 1024, vdst = lds0 + L_V + wid * 2048;
#define B2_DMA(tile, ks, vs) do { const int tt_ = (tile) < NT ? (tile) : NT - 1; \
        glds16(ksrc + (size_t)tt_ * 4096, (unsigned)__builtin_amdgcn_readfirstlane(kdst + (ks) * KBUF)); \
        glds16(vsrc0 + (size_t)tt_ * 8192, (unsigned)__builtin_amdgcn_readfirstlane(vdst + (vs) * VBUF)); \
        glds16(vsrc1 + (size_t)tt_ * 8192, (unsigned)__builtin_amdgcn_readfirstlane(vdst + (vs) * VBUF + 1024)); } while (0)
#define B2_WAITBAR(n) asm volatile("s_waitcnt vmcnt(" #n ") lgkmcnt(0)\n\ts_barrier" ::: "memory")
    B2_DMA(0, 0, 0); B2_DMA(1, 1, 1); B2_DMA(2, 2, 2);
    bf16x8 qr[4];
    { const bf16* qrow = Q + (size_t)(q0 + qrel) * 64 + hi * 8;
#pragma unroll
      for (int d0 = 0; d0 < 4; ++d0) qr[d0] = *(const bf16x8*)(qrow + d0 * 16); }
    asm volatile("s_waitcnt vmcnt(0)" ::: "memory");
    B2_WAITBAR(0);
    float m = 0.f, l = 0.f;
    f32x16 negm = f32x16{};
    f32x16 Oa[4]; Oa[0] = f32x16{}; Oa[1] = f32x16{}; Oa[2] = f32x16{}; Oa[3] = f32x16{};
    bf16x8 pk[4];
    const int sw = (r32 >> 1) & 7;
    int aK[4];
#pragma unroll
    for (int d0 = 0; d0 < 4; ++d0) aK[d0] = L_K + r32 * 128 + (((2 * d0 + hi) ^ sw) << 4);
    const int q4 = (lane & 15) >> 2, blk = (lane >> 4) & 1, p = lane & 3;
    int aV[4];
#pragma unroll
    for (int db = 0; db < 4; ++db) aV[db] = L_V + (4 * hi + q4) * 256 + ((((db ^ q4) << 2) + blk * 2 + (p >> 1)) << 4) + (p & 1) * 8;
    const lds_cptr L3 = (lds_cptr)lds;
    int ks = 0, vs = 0;
#define B2_PV(vslot) do { const int vo_ = (vslot) * VBUF; \
_Pragma("unroll") \
        for (int s = 0; s < 4; ++s) \
_Pragma("unroll") \
            for (int db = 0; db < 4; ++db) { const s16x4 lo = vtr(L3 + aV[db] + vo_ + s * 4096), h4 = vtr(L3 + aV[db] + vo_ + s * 4096 + 2048); \
                const bf16x8 vf = (bf16x8){lo[0], lo[1], lo[2], lo[3], h4[0], h4[1], h4[2], h4[3]}; \
                Oa[db] = __builtin_amdgcn_mfma_f32_32x32x16_bf16(vf, pk[s], Oa[db], 0, 0, 0); } } while (0)
#define MX3(a, b, c) __builtin_fmaxf(__builtin_fmaxf((a), (b)), (c))
#define B2_STEP(t, HASPREV) do { \
        { const int k3 = (ks + 3) & 3; int v3 = vs + 3; v3 = v3 >= NVS ? v3 - NVS : v3; B2_DMA((t) + 3, k3, v3); } \
        f32x16 p0 = negm, p1 = negm; \
_Pragma("unroll") \
        for (int d0 = 0; d0 < 4; ++d0) { const bf16x8 kf0 = *(const LAS bf16x8*)(lds + aK[d0] + ks * KBUF), kf1 = *(const LAS bf16x8*)(lds + aK[d0] + ks * KBUF + 4096); \
            p0 = __builtin_amdgcn_mfma_f32_32x32x16_bf16(kf0, qr[d0], p0, 0, 0, 0); p1 = __builtin_amdgcn_mfma_f32_32x32x16_bf16(kf1, qr[d0], p1, 0, 0, 0); } \
        if ((t) >= NT - 6) attn_body::bmask(p0, p1, (t) - (NT - 4), qrel, hi, tab); \
        float ra = MX3(p0[0], p0[1], p1[0]), rb = MX3(p0[2], p0[3], p1[1]); ra = MX3(ra, p1[2], p1[3]); \
_Pragma("unroll") \
        for (int i = 4; i < 16; i += 4) { ra = MX3(ra, p0[i], p0[i + 1]); rb = MX3(rb, p0[i + 2], p0[i + 3]); ra = MX3(ra, p1[i], p1[i + 1]); rb = MX3(rb, p1[i + 2], p1[i + 3]); } \
        float rm = fmaxf(ra, rb); rm = fmaxf(rm, __shfl_xor(rm, 32)); \
        const bool resc = !(HASPREV) || __any(rm > (float)THR); \
        float al = 1.f; \
        if (resc) { const float dl = (HASPREV) ? fmaxf(rm, 0.f) : rm; m += dl; if (HASPREV) { al = __builtin_amdgcn_exp2f(-dl); l *= al; } \
_Pragma("unroll") \
            for (int i = 0; i < 16; ++i) { p0[i] -= dl; p1[i] -= dl; negm[i] = -m; } } \
        float sum = 0.f; \
_Pragma("unroll") \
        for (int i = 0; i < 16; ++i) { p0[i] = __builtin_amdgcn_exp2f(p0[i]); p1[i] = __builtin_amdgcn_exp2f(p1[i]); sum += p0[i] + p1[i]; } \
        l += sum; \
        if (HASPREV) { const int vp_ = vs == 0 ? NVS - 1 : vs - 1; B2_PV(vp_); } \
        if (resc) { \
_Pragma("unroll") \
            for (int db = 0; db < 4; ++db) \
_Pragma("unroll") \
                for (int i = 0; i < 16; ++i) Oa[db][i] *= al; } \
_Pragma("unroll") \
        for (int s = 0; s < 2; ++s) { v4u w0, w1; \
            w0.x = cvtpk(p0[8 * s], p0[8 * s + 1]); w0.y = cvtpk(p0[8 * s + 2], p0[8 * s + 3]); w0.z = cvtpk(p0[8 * s + 4], p0[8 * s + 5]); w0.w = cvtpk(p0[8 * s + 6], p0[8 * s + 7]); \
            w1.x = cvtpk(p1[8 * s], p1[8 * s + 1]); w1.y = cvtpk(p1[8 * s + 2], p1[8 * s + 3]); w1.z = cvtpk(p1[8 * s + 4], p1[8 * s + 5]); w1.w = cvtpk(p1[8 * s + 6], p1[8 * s + 7]); \
            pk[s] = __builtin_bit_cast(bf16x8, w0); pk[2 + s] = __builtin_bit_cast(bf16x8, w1); } \
        ks = (ks + 1) & 3; vs = vs + 1 == NVS ? 0 : vs + 1; \
        B2_WAITBAR(6); \
    } while (0)
    B2_STEP(0, false);
    for (int t = 1; t < NT; ++t) B2_STEP(t, true);
    { const int vp_ = vs == 0 ? NVS - 1 : vs - 1; B2_PV(vp_); }
#undef B2_STEP
#undef MX3
#undef B2_PV
#undef B2_DMA
    l += __shfl_xor(l, 32);
    const float rl = 1.0f / l;
    bf16* orow = O + (size_t)(q0 + qrel) * 1024 + 4 * hi;
#pragma unroll
    for (int db = 0; db < 4; ++db)
#pragma unroll
        for (int k4 = 0; k4 < 4; ++k4) { v2u w; w.x = cvtpk(Oa[db][4 * k4] * rl, Oa[db][4 * k4 + 1] * rl); w.y = cvtpk(Oa[db][4 * k4 + 2] * rl, Oa[db][4 * k4 + 3] * rl);
            *(v2u*)(orow + 32 * db + 8 * k4) = w; }
    B2_WAITBAR(0);
#undef B2_WAITBAR
}
}

constexpr int NPHASE = 12;
#ifndef MK_N_LAUNCHES
#define MK_N_LAUNCHES 1
#endif
struct Args { const float* in[18]; float* out; unsigned char* ws; int ph_lo, ph_hi; };
__device__ __forceinline__ void ln_rows(const float* zin, float* fout, bf16* bout, const float* gam, const float* bet, int gw, int ngw, int lane) {
    f32x4 gv[4], bv[4];
#pragma unroll
    for (int j = 0; j < 4; ++j) { gv[j] = *(const f32x4*)(gam + 4 * (64 * j + lane)); bv[j] = *(const f32x4*)(bet + 4 * (64 * j + lane)); }
    for (int m = gw; m < M; m += ngw) {
        const f32x4* xr = (const f32x4*)(zin + (size_t)m * 1024) + lane;
        f32x4 v[4]; float s = 0.f;
#pragma unroll
        for (int j = 0; j < 4; ++j) { v[j] = xr[64 * j]; s += (v[j].x + v[j].y) + (v[j].z + v[j].w); }
        const float mean = wave_sum(s) * (1.f / 1024.f); float s2 = 0.f;
#pragma unroll
        for (int j = 0; j < 4; ++j) { v[j] = v[j] - mean; s2 += (v[j].x * v[j].x + v[j].y * v[j].y) + (v[j].z * v[j].z + v[j].w * v[j].w); }
        const float rstd = 1.f / sqrtf(wave_sum(s2) * (1.f / 1024.f) + LN_EPS);
        f32x4* fo = (f32x4*)(fout + (size_t)m * 1024) + lane;
#pragma unroll
        for (int j = 0; j < 4; ++j) { v[j] = v[j] * rstd * gv[j] + bv[j]; fo[64 * j] = v[j]; }
        if (bout) { v2u* bo = (v2u*)(bout + (size_t)m * 1024) + lane;
#pragma unroll
            for (int j = 0; j < 4; ++j) { v2u w; w.x = pk2(v[j].x, v[j].y); w.y = pk2(v[j].z, v[j].w); bo[64 * j] = w; } }
    }
}

__global__ void __launch_bounds__(512, 2) fwd_mega(Args args) {
    extern __shared__ __attribute__((aligned(16))) unsigned char lds[];
    cg::grid_group grid = cg::this_grid();
    LAS unsigned char* L = (LAS unsigned char*)lds;
#define TIDS const int tid = threadIdx.x, lane = tid & 63, wave = __builtin_amdgcn_readfirstlane(tid >> 6); (void)tid; (void)lane; (void)wave
#define GRIDV const int G = gridDim.x, bx = blockIdx.x, vcu = (bx & 7) * (G >> 3) + (bx >> 3); (void)vcu
#define WSP(name, off) bf16* name = (bf16*)(args.ws + (off))
#define IN(k) (args.ph_lo <= (k) && (k) < args.ph_hi)
#define SEAM(k) do { if (IN(k) && IN((k) + 1)) { asm volatile("s_waitcnt vmcnt(0) lgkmcnt(0)" ::: "memory"); grid.sync(); __builtin_amdgcn_fence(__ATOMIC_ACQUIRE, "agent"); asm volatile("s_waitcnt vmcnt(0)" ::: "memory"); } } while (0)

    if (IN(0)) {
        TIDS; GRIDV; const int gw = vcu * 8 + wave, ngw = G * 8; const float* x = args.in[0];
        WSP(WinT, WS_WIN); WSP(WpaT, WS_WPA); WSP(WpbT, WS_WPB); WSP(WoT, WS_WO); WSP(W1T, WS_W1); WSP(W2T, WS_W2); WSP(XB, WS_XB);
        LAS float* scr = (LAS float*)(L + wave * 16384);
        constexpr int I_IN = 16 * 304, I_PA = 8 * 32, I_PB = 16 * 32, I_O = 16 * 32, I_1 = 16 * 128, I_2 = 64 * 32;
        constexpr int NITEMS = I_IN + I_PA + I_PB + I_O + I_1 + I_2;
        for (int it = gw; it < NITEMS; it += ngw) {
            int r = it;
            if (r < I_IN) { p0_transpose_item(args.in[1], 1024, 9728, WinT, scr, r, lane); continue; } r -= I_IN;
            if (r < I_PA) { p0_transpose_item(args.in[9], 512, 1024, WpaT, scr, r, lane); continue; } r -= I_PA;
            if (r < I_PB) { p0_transpose_item(args.in[10], 1024, 1024, WpbT, scr, r, lane); continue; } r -= I_PB;
            if (r < I_O) { p0_transpose_item(args.in[11], 1024, 1024, WoT, scr, r, lane); continue; } r -= I_O;
            if (r < I_1) { p0_transpose_item(args.in[16], 1024, 4096, W1T, scr, r, lane); continue; } r -= I_1;
            p0_transpose_item(args.in[17], 4096, 1024, W2T, scr, r, lane);
        }
        for (int m = gw; m < M; m += ngw) {
            const f32x4* xr = (const f32x4*)(x + (size_t)m * 1024) + lane; v2u* bo = (v2u*)(XB + (size_t)m * 1024) + lane;
#pragma unroll
            for (int j = 0; j < 4; ++j) { const f32x4 v = xr[64 * j]; v2u w; w.x = pk2(v.x, v.y); w.y = pk2(v.z, v.w); bo[64 * j] = w; }
        }
    }
    SEAM(0);
    if (IN(1)) {
        GRIDV; WSP(XB, WS_XB); WSP(WinT, WS_WIN); WSP(QA, WS_R1);
        pg8::Gemm g{XB, WinT, M, COLS_A, 1024}; pg8::StaticOrder S; S.init(M, COLS_A, G, bx);
        pg8::EpiA E{QA};
        pg8::gemm_phase<pg8::EpiA, pg8::StaticOrder, true, true>(L, g, S, E);
    }
    SEAM(1);
    if (IN(2)) {
        GRIDV; WSP(QA, WS_R1); WSP(OG, WS_OG); float* LSE = (float*)(args.ws + WS_LSE);
        const bf16* KA = QA + (size_t)3 * M * 512; const bf16* VA = KA + (size_t)3 * M * 512;
        for (int u = vcu; u < 3072; u += G) attn_a::unit(u >> 10, (u >> 7) & 7, u & 127, QA, KA, VA, OG, LSE, args.in[8], L);
    }
    SEAM(2);
    if (IN(3)) {
        { TIDS; GRIDV; const int gw = vcu * 8 + wave, ngw = G * 8; WSP(OG, WS_OG); const float* LSE = (const float*)(args.ws + WS_LSE); WSP(OA, WS_OA);
          for (int m = gw; m < M; m += ngw) {
            { const int hh = lane >> 3; float l0 = LSE[(size_t)m * 8 + hh], l1 = LSE[(size_t)M * 8 + (size_t)m * 8 + hh], l2 = LSE[(size_t)2 * M * 8 + (size_t)m * 8 + hh];
              const float mx = fmaxf(l0, fmaxf(l1, l2)); float w0 = exp2f(l0 - mx), w1 = exp2f(l1 - mx), w2 = exp2f(l2 - mx); const float rs = 1.f / (w0 + w1 + w2); w0 *= rs; w1 *= rs; w2 *= rs;
              const v4u a = *(const v4u*)(OG + (size_t)m * 512 + lane * 8), b = *(const v4u*)(OG + (size_t)M * 512 + (size_t)m * 512 + lane * 8), c = *(const v4u*)(OG + (size_t)2 * M * 512 + (size_t)m * 512 + lane * 8);
              v4u o;
              o.x = pk2(w0 * blo(a.x) + w1 * blo(b.x) + w2 * blo(c.x), w0 * bhi(a.x) + w1 * bhi(b.x) + w2 * bhi(c.x));
              o.y = pk2(w0 * blo(a.y) + w1 * blo(b.y) + w2 * blo(c.y), w0 * bhi(a.y) + w1 * bhi(b.y) + w2 * bhi(c.y));
              o.z = pk2(w0 * blo(a.z) + w1 * blo(b.z) + w2 * blo(c.z), w0 * bhi(a.z) + w1 * bhi(b.z) + w2 * bhi(c.z));
              o.w = pk2(w0 * blo(a.w) + w1 * blo(b.w) + w2 * blo(c.w), w0 * bhi(a.w) + w1 * bhi(b.w) + w2 * bhi(c.w));
              *(v4u*)(OA + (size_t)m * 512 + lane * 8) = o; }
          } }
        GRIDV; WSP(XB, WS_XB); WSP(WinT, WS_WIN); WSP(QB, WS_QB);
        pg8::Gemm g{XB, WinT + (size_t)COLS_A * 1024, M, 3072, 1024}; pg8::StaticOrder S; S.init(M, 3072, G, bx);
        pg8::EpiB E{QB};
        pg8::gemm_phase<pg8::EpiB, pg8::StaticOrder, true, true>(L, g, S, E);
    }
    SEAM(3);
    if (IN(4)) {
        TIDS; GRIDV; WSP(QB, WS_QB); WSP(O1, WS_O1); WSP(O2, WS_O2);
        LAS float* btab = (LAS float*)(L + 116736);
        const float* rb = args.in[8];
        for (int i = tid; i < 8 * 640; i += 512) { const int hh = i / 640, d = i - hh * 640 - 255;
            btab[i] = d < 0 ? -INFINITY : (d < 128 ? (rb[t5_bucket(d) * 32 + 24 + hh] - rb[31 * 32 + 24 + hh]) * LOG2E : 0.f); }
        __syncthreads();
        const bf16* KB = QB + (size_t)M * 1024; const bf16* VB = KB + (size_t)M * 1024;
        for (int i = 0; i < 8; ++i) {
            const int sq = (vcu >> 3) * 2 + (i >> 2), k = i & 3, s = vcu & 7;
            const int qb = (k == 0) ? s : (k == 1) ? 15 - s : (k == 2) ? 16 + s : 31 - s;
            const int mp = sq & 1, hh = (sq >> 1) & 7, bb = sq >> 4;
            const size_t rb0 = (size_t)bb * SEQ * 1024;
            const size_t qk0 = (size_t)((bb * 16 + mp * 8 + hh) * SEQ) * 64, v0 = (size_t)((bb * 8 + hh) * SEQ) * 128;
            attn_b2::unit<8>(qb, QB + qk0, KB + qk0, VB + v0, (mp ? O2 : O1) + rb0 + hh * 128, (attn_body::lds_fptr)(btab + hh * 640), L);
        }
    }
    SEAM(4);
    if (IN(5)) {
        { TIDS; GRIDV; const int gw = vcu * 8 + wave, ngw = G * 8; WSP(O1, WS_O1); WSP(O2, WS_O2); WSP(OB, WS_OB);
          const float d1 = wave_sum(args.in[3][lane] * args.in[4][lane]), d2 = wave_sum(args.in[5][lane] * args.in[6][lane]);
          const float lam = expf(d1) - expf(d2) + 0.2f;
          const float* sg = args.in[7] + (lane & 7) * 16;
          float gsc[16];
#pragma unroll
          for (int e = 0; e < 16; ++e) gsc[e] = sg[e] * 0.8f;
          for (int m = gw; m < M; m += ngw) {
            { const v4u a0 = *(const v4u*)(O1 + (size_t)m * 1024 + lane * 16), a1 = *(const v4u*)(O1 + (size_t)m * 1024 + lane * 16 + 8);
              const v4u b0 = *(const v4u*)(O2 + (size_t)m * 1024 + lane * 16), b1 = *(const v4u*)(O2 + (size_t)m * 1024 + lane * 16 + 8);
              float d[16];
              d[0] = blo(a0.x) - lam * blo(b0.x); d[1] = bhi(a0.x) - lam * bhi(b0.x); d[2] = blo(a0.y) - lam * blo(b0.y); d[3] = bhi(a0.y) - lam * bhi(b0.y);
              d[4] = blo(a0.z) - lam * blo(b0.z); d[5] = bhi(a0.z) - lam * bhi(b0.z); d[6] = blo(a0.w) - lam * blo(b0.w); d[7] = bhi(a0.w) - lam * bhi(b0.w);
              d[8] = blo(a1.x) - lam * blo(b1.x); d[9] = bhi(a1.x) - lam * bhi(b1.x); d[10] = blo(a1.y) - lam * blo(b1.y); d[11] = bhi(a1.y) - lam * bhi(b1.y);
              d[12] = blo(a1.z) - lam * blo(b1.z); d[13] = bhi(a1.z) - lam * bhi(b1.z); d[14] = blo(a1.w) - lam * blo(b1.w); d[15] = bhi(a1.w) - lam * bhi(b1.w);
              float ss = 0.f;
#pragma unroll
              for (int e = 0; e < 16; ++e) ss += d[e] * d[e];
              ss += __shfl_xor(ss, 1); ss += __shfl_xor(ss, 2); ss += __shfl_xor(ss, 4);
              const float rn = 1.f / sqrtf(ss * (1.f / 128.f) + LN_EPS);
              v4u o0, o1;
              o0.x = pk2(d[0] * rn * gsc[0], d[1] * rn * gsc[1]); o0.y = pk2(d[2] * rn * gsc[2], d[3] * rn * gsc[3]); o0.z = pk2(d[4] * rn * gsc[4], d[5] * rn * gsc[5]); o0.w = pk2(d[6] * rn * gsc[6], d[7] * rn * gsc[7]);
              o1.x = pk2(d[8] * rn * gsc[8], d[9] * rn * gsc[9]); o1.y = pk2(d[10] * rn * gsc[10], d[11] * rn * gsc[11]); o1.z = pk2(d[12] * rn * gsc[12], d[13] * rn * gsc[13]); o1.w = pk2(d[14] * rn * gsc[14], d[15] * rn * gsc[15]);
              *(v4u*)(OB + (size_t)m * 1024 + lane * 16) = o0; *(v4u*)(OB + (size_t)m * 1024 + lane * 16 + 8) = o1; }
          } }
        GRIDV; WSP(XB, WS_XB); WSP(WinT, WS_WIN); WSP(GATES, WS_GATES);
        pg8::Gemm g{XB, WinT + (size_t)7680 * 1024, M, 2048, 1024}; pg8::StaticOrder S; S.init(M, 2048, G, bx);
        pg8::EpiSig E{GATES, args.in[2]};
        pg8::gemm_phase<pg8::EpiSig, pg8::StaticOrder, true, true>(L, g, S, E);
    }
    SEAM(5);
    if (IN(6)) {
        GRIDV; WSP(OA, WS_OA); WSP(OB, WS_OB); WSP(WpaT, WS_WPA); WSP(WpbT, WS_WPB); WSP(TMP, WS_TMP); WSP(MERGED, WS_MERGED); WSP(GATES, WS_GATES);
        { pg8::Gemm g{OA, WpaT, M, 1024, 512}; pg8::StaticOrder S; S.init(M, 1024, G, bx);
          pg8::EpiGate<false> E{GATES, nullptr, TMP};
          pg8::gemm_phase<pg8::EpiGate<false>, pg8::StaticOrder, true, true>(L, g, S, E); }
        { pg8::Gemm g{OB, WpbT, M, 1024, 1024}; pg8::StaticOrder S; S.init(M, 1024, G, bx);
          pg8::EpiGate<true> E{GATES + 1024, TMP, MERGED};
          pg8::gemm_phase<pg8::EpiGate<true>, pg8::StaticOrder, true, true>(L, g, S, E); }
    }
    SEAM(6);
    if (IN(7)) {
        GRIDV; WSP(MERGED, WS_MERGED); WSP(WoT, WS_WO); const float* x = args.in[0]; float* Z = (float*)(args.ws + WS_Z);
        pg8::Gemm g{MERGED, WoT, M, 1024, 1024}; pg8::StaticOrder S; S.init(M, 1024, G, bx);
        pg8::EpiZ E{x, Z, DN_ALPHA};
        pg8::gemm_phase<pg8::EpiZ, pg8::StaticOrder, true, true>(L, g, S, E);
    }
    SEAM(7);
    if (IN(8)) { TIDS; GRIDV; WSP(X1B, WS_X1B); float* Z = (float*)(args.ws + WS_Z); ln_rows(Z, Z, X1B, args.in[12], args.in[13], vcu * 8 + wave, G * 8, lane); }
    SEAM(8);
    if (IN(9)) {
        GRIDV; WSP(X1B, WS_X1B); WSP(W1T, WS_W1); WSP(HB, WS_H);
        pg8::Gemm g{X1B, W1T, M, FF, 1024}; pg8::StaticOrder S; S.init(M, FF, G, bx);
        pg8::EpiRelu2 E{HB};
        pg8::gemm_phase<pg8::EpiRelu2, pg8::StaticOrder, true, true>(L, g, S, E);
    }
    SEAM(9);
    if (IN(10)) {
        GRIDV; WSP(HB, WS_H); WSP(W2T, WS_W2);
        pg8::Gemm g{HB, W2T, M, 1024, FF}; pg8::StaticOrder S; S.init(M, 1024, G, bx);
        float* Z = (float*)(args.ws + WS_Z); pg8::EpiZ E{Z, Z, DN_ALPHA};
        pg8::gemm_phase<pg8::EpiZ, pg8::StaticOrder, true, true>(L, g, S, E);
    }
    SEAM(10);
    if (IN(11)) { TIDS; GRIDV; const float* Z = (const float*)(args.ws + WS_Z); ln_rows(Z, args.out, nullptr, args.in[14], args.in[15], vcu * 8 + wave, G * 8, lane); }
#undef IN
#undef SEAM
}

extern "C" void kernel_launch(void* const* d_in, const int* in_sizes, int n_in, void* d_out, int out_size, void* d_ws, size_t ws_size, hipStream_t stream) {
    static int grid = 0;
    if (grid == 0) {
        if (n_in != 18 || in_sizes[0] != M * DMODEL || out_size != M * DMODEL || ws_size < WS_END) { fprintf(stderr, "kernel_launch: unexpected shapes (n_in %d, x %d, out %d, ws %zu)\n", n_in, n_in > 0 ? in_sizes[0] : -1, out_size, ws_size); grid = -1; return; }
        int dev = 0, cus = 0, per_cu = 0;
        hipGetDevice(&dev); hipDeviceGetAttribute(&cus, hipDeviceAttributeMultiprocessorCount, dev);
        if (hipFuncSetAttribute((const void*)fwd_mega, hipFuncAttributeMaxDynamicSharedMemorySize, LDS_BYTES) != hipSuccess) { fprintf(stderr, "kernel_launch: hipFuncSetAttribute failed\n"); grid = -1; return; }
        if (hipOccupancyMaxActiveBlocksPerMultiprocessor(&per_cu, (const void*)fwd_mega, 512, LDS_BYTES) != hipSuccess || per_cu < 1) { fprintf(stderr, "kernel_launch: occupancy query says %d\n", per_cu); per_cu = 1; }
        (void)hipGetLastError();
        grid = cus * 1;
    }
    if (grid < 0) return;
    Args a{};
    for (int i = 0; i < 18; ++i) a.in[i] = (const float*)d_in[i];
    a.out = (float*)d_out; a.ws = (unsigned char*)d_ws;
    constexpr int NL = MK_N_LAUNCHES;
    for (int li = 0; li < NL; ++li) {
        a.ph_lo = (NL == 1) ? 0 : li; a.ph_hi = (NL == 1) ? NPHASE : li + 1;
        void* kargs[] = {&a};
        const hipError_t e = hipLaunchCooperativeKernel((const void*)fwd_mega, dim3(grid), dim3(512), kargs, LDS_BYTES, stream);
        if (e != hipSuccess) { fprintf(stderr, "kernel_launch: cooperative launch %d failed: %s (grid %d)\n", li, hipGetErrorString(e), grid); break; }
    }
}
```

```cpp
#include <hip/hip_runtime.h>
#include <hip/hip_cooperative_groups.h>
#include <cstdio>
#include <cstdint>
namespace cg = cooperative_groups;
namespace pg8 {
#define PG8_LAS __attribute__((address_space(3)))
typedef unsigned short bf16_t;
typedef short bf16x8 __attribute__((ext_vector_type(8)));
typedef float f32x4 __attribute__((ext_vector_type(4)));
typedef unsigned u32x4 __attribute__((ext_vector_type(4)));
constexpr int BM = 256, BK = 64, HALF = 128, HTB = HALF * BK * 2  , STAGE_BYTES = 8 * HTB, NXCD = 8, WGM = 8;

__host__ __device__ __forceinline__ int lds_byte(int r, int c) { const int st = (r >> 4) * 2 + (c >> 5), rr = r & 15, cc = c & 31, ob = rr * 64 + cc * 2; return st * 1024 + (ob ^ (((ob >> 9) & 1) << 5)); }
__host__ __device__ __forceinline__ void stage_rc(int b, int& R, int& C) { const int st = b / 1024, sb = b % 1024, swz = sb ^ (((sb >> 9) & 1) << 5); R = (st >> 1) * 16 + swz / 64; C = (st & 1) * 32 + (swz % 64) / 2; }
__host__ __device__ __forceinline__ int perm32(int rho) { const int n = rho >> 4, i = rho & 15; return 8 * (i >> 2) + 4 * n + (i & 3); }

struct Unit { int pm, pn; };
struct Gemm { const bf16_t* A; const bf16_t* Bt; int M, N, K; };

struct StaticOrder {
    int nM, nN, nwg, G, c;
    __host__ __device__ void init(int M, int N, int G_, int c_) { nM = M / BM; nN = N / BM; nwg = nM * nN; G = G_; c = c_; }
    __host__ __device__ bool next(int i, Unit& u) const {
        const long L = (long)i * G + c; if (L >= nwg) return false;
        int wgid = (int)L; { const int q = nwg / NXCD, r = nwg % NXCD, xcd = wgid % NXCD, off = wgid / NXCD; wgid = (xcd < r ? xcd * (q + 1) : r * (q + 1) + (xcd - r) * q) + off; }
        const int nig = WGM * nN, gid = wgid / nig, fm = gid * WGM, gsz = (nM - fm) < WGM ? (nM - fm) : WGM;
        u.pm = fm + ((wgid % nig) % gsz); u.pn = (wgid % nig) / gsz; return true;
    }
    __device__ __forceinline__ void a_ready(const Unit&) const {}
    __device__ __forceinline__ void done(const Unit&) const {}
};

__device__ __forceinline__ unsigned cvt_pk_bf16(float lo, float hi) { unsigned r; asm volatile("v_cvt_pk_bf16_f32 %0, %1, %2" : "=v"(r) : "v"(lo), "v"(hi)); return r; }
typedef float f32x2 __attribute__((ext_vector_type(2)));
constexpr float QK_C2 = 0.125f * 1.4426950408889634f;
constexpr int MROWS = 32768;
__device__ __forceinline__ float bf_lo(unsigned w) { return __uint_as_float(w << 16); }
__device__ __forceinline__ float bf_hi(unsigned w) { return __uint_as_float(w & 0xffff0000u); }
typedef float f32x2c_t __attribute__((ext_vector_type(2))); typedef __bf16 bf16x2c_t __attribute__((ext_vector_type(2)));
__device__ __forceinline__ unsigned cvt_pk_bf16_c(float lo, float hi) { f32x2c_t v = {lo, hi}; bf16x2c_t b = __builtin_convertvector(v, bf16x2c_t); return __builtin_bit_cast(unsigned, b); }
__device__ __forceinline__ u32x4 pack8c(const f32x4 v0, const f32x4 v1) { u32x4 w; w.x = cvt_pk_bf16_c(v0[0], v0[1]); w.y = cvt_pk_bf16_c(v0[2], v0[3]); w.z = cvt_pk_bf16_c(v1[0], v1[1]); w.w = cvt_pk_bf16_c(v1[2], v1[3]); return w; }
__device__ __forceinline__ u32x4 pack8(const f32x4 v0, const f32x4 v1) { u32x4 w; w.x = cvt_pk_bf16(v0[0], v0[1]); w.y = cvt_pk_bf16(v0[2], v0[3]); w.z = cvt_pk_bf16(v1[0], v1[1]); w.w = cvt_pk_bf16(v1[2], v1[3]); return w; }
struct EpiA {
    static constexpr bool PERM = true, AFTER_DRAIN = false;
    bf16_t* base;
    __device__ __forceinline__ void operator()(const f32x4 (&acc)[2][2][4][2], const Unit& u, int wr, int wc, int fr, int fq) const {
        const int which = u.pn / 6, rem = u.pn - which * 6, g = rem >> 1, half = rem & 1, sh = 2 * g;
        const float sc = which == 0 ? QK_C2 : 1.f;
        bf16_t* b0 = base + (size_t)(which * 3 + g) * ((size_t)MROWS * 512) + half * 256 + wc * 32 + 8 * fq;
#pragma unroll
        for (int ai = 0; ai < 2; ++ai)
#pragma unroll
            for (int m = 0; m < 4; ++m) { const int row = u.pm * BM + ai * HALF + wr * 64 + m * 16 + fr; const int bb = row >> 13, t = row & 8191;
                const int pos = (bb << 13) + ((t & ((1 << sh) - 1)) << (13 - sh)) + (t >> sh);
                bf16_t* rowp = b0 + (size_t)pos * 512;
#pragma unroll
                for (int bj = 0; bj < 2; ++bj) *(u32x4*)(rowp + bj * HALF) = pack8(acc[ai][bj][m][0] * sc, acc[ai][bj][m][1] * sc); }
    }
};
struct EpiB {
    static constexpr bool PERM = true, AFTER_DRAIN = false;
    bf16_t* qkv;
    __device__ __forceinline__ void operator()(const f32x4 (&acc)[2][2][4][2], const Unit& u, int wr, int wc, int fr, int fq) const {
        const int row0 = u.pm * BM + wr * 64 + fr;
        const int which = u.pn >> 2; const float sc = which == 0 ? QK_C2 : 1.f;
        bf16_t* b0 = qkv + (size_t)which * ((size_t)MROWS * 1024);
        const int c0 = (u.pn & 3) * 256 + wc * 32 + 8 * fq;
#pragma unroll
        for (int ai = 0; ai < 2; ++ai)
#pragma unroll
            for (int m = 0; m < 4; ++m) { const int row = row0 + ai * HALF + m * 16, bb = row >> 13, t = row & 8191;
#pragma unroll
                for (int bj = 0; bj < 2; ++bj) { const int c = c0 + bj * HALF;
                    const size_t off = (which == 2) ? ((size_t)((bb * 8 + (c >> 7)) * 8192 + t) * 128 + (c & 127)) : ((size_t)((bb * 16 + (c >> 6)) * 8192 + t) * 64 + (c & 63));
                    *(u32x4*)(b0 + off) = pack8(acc[ai][bj][m][0] * sc, acc[ai][bj][m][1] * sc); } }
    }
};
struct EpiSig {
    static constexpr bool PERM = true, AFTER_DRAIN = false;
    bf16_t* gates; const float* bgate;
    __device__ __forceinline__ void operator()(const f32x4 (&acc)[2][2][4][2], const Unit& u, int wr, int wc, int fr, int fq) const {
        const int row0 = u.pm * BM + wr * 64 + fr;
        const int gc = u.pn * 256 + wc * 32 + 8 * fq;
        f32x4 bv[2][2];
#pragma unroll
        for (int bj = 0; bj < 2; ++bj)
#pragma unroll
            for (int n = 0; n < 2; ++n) bv[bj][n] = *(const f32x4*)(bgate + gc + bj * HALF + 4 * n);
#pragma unroll
        for (int ai = 0; ai < 2; ++ai)
#pragma unroll
            for (int m = 0; m < 4; ++m) { bf16_t* rowp = gates + (size_t)(row0 + ai * HALF + m * 16) * 2048 + gc;
#pragma unroll
                for (int bj = 0; bj < 2; ++bj) { f32x4 v[2];
#pragma unroll
                    for (int n = 0; n < 2; ++n) { const f32x4 x = acc[ai][bj][m][n] + bv[bj][n];
#pragma unroll
                        for (int e = 0; e < 4; ++e) v[n][e] = __builtin_amdgcn_rcpf(1.f + __builtin_amdgcn_exp2f(-1.4426950408889634f * x[e])); }
                    *(u32x4*)(rowp + bj * HALF) = pack8c(v[0], v[1]); } }
    }
};
template <bool ADD> struct EpiGate {
    static constexpr bool PERM = true, AFTER_DRAIN = false;
    const bf16_t* gates; const bf16_t* tin; bf16_t* out;
    __device__ __forceinline__ void operator()(const f32x4 (&acc)[2][2][4][2], const Unit& u, int wr, int wc, int fr, int fq) const {
        const int row0 = u.pm * BM + wr * 64 + fr, col0 = u.pn * BM + wc * 32 + 8 * fq;
#pragma unroll
        for (int ai = 0; ai < 2; ++ai) {
            u32x4 gw[4][2], tw[4][2];
#pragma unroll
            for (int m = 0; m < 4; ++m)
#pragma unroll
                for (int bj = 0; bj < 2; ++bj) { const size_t row = (size_t)(row0 + ai * HALF + m * 16);
                    gw[m][bj] = *(const u32x4*)(gates + row * 2048 + col0 + bj * HALF);
                    if (ADD) tw[m][bj] = *(const u32x4*)(tin + row * 1024 + col0 + bj * HALF); }
#pragma unroll
            for (int m = 0; m < 4; ++m)
#pragma unroll
                for (int bj = 0; bj < 2; ++bj) { const size_t row = (size_t)(row0 + ai * HALF + m * 16); const u32x4 g = gw[m][bj];
                    f32x4 v0 = acc[ai][bj][m][0], v1 = acc[ai][bj][m][1];
                    v0[0] *= bf_lo(g.x); v0[1] *= bf_hi(g.x); v0[2] *= bf_lo(g.y); v0[3] *= bf_hi(g.y);
                    v1[0] *= bf_lo(g.z); v1[1] *= bf_hi(g.z); v1[2] *= bf_lo(g.w); v1[3] *= bf_hi(g.w);
                    if (ADD) { const u32x4 t = tw[m][bj];
                        v0[0] += bf_lo(t.x); v0[1] += bf_hi(t.x); v0[2] += bf_lo(t.y); v0[3] += bf_hi(t.y);
                        v1[0] += bf_lo(t.z); v1[1] += bf_hi(t.z); v1[2] += bf_lo(t.w); v1[3] += bf_hi(t.w); }
                    *(u32x4*)(out + row * 1024 + col0 + bj * HALF) = pack8(v0, v1); }
        }
    }
};
struct EpiZ {
    static constexpr bool PERM = false, AFTER_DRAIN = false;
    const float* res; float* out; float alpha;
    __device__ __forceinline__ void operator()(const f32x4 (&acc)[2][2][4][2], const Unit& u, int wr, int wc, int fr, int fq) const {
        const int row0 = u.pm * BM + wr * 64 + fr, col0 = u.pn * BM + wc * 32 + 4 * fq;
#pragma unroll
        for (int ai = 0; ai < 2; ++ai) {
            f32x4 r[4][2][2];
#pragma unroll
            for (int m = 0; m < 4; ++m) { const size_t off = (size_t)(row0 + ai * HALF + m * 16) * 1024 + col0;
#pragma unroll
                for (int bj = 0; bj < 2; ++bj)
#pragma unroll
                    for (int n = 0; n < 2; ++n) r[m][bj][n] = *(const f32x4*)(res + off + bj * HALF + n * 16); }
#pragma unroll
            for (int m = 0; m < 4; ++m) { const size_t off = (size_t)(row0 + ai * HALF + m * 16) * 1024 + col0;
#pragma unroll
                for (int bj = 0; bj < 2; ++bj)
#pragma unroll
                    for (int n = 0; n < 2; ++n) *(f32x4*)(out + off + bj * HALF + n * 16) = r[m][bj][n] * alpha + acc[ai][bj][m][n]; }
        }
    }
};
struct EpiRelu2 {
    static constexpr bool PERM = true, AFTER_DRAIN = false;
    bf16_t* out;
    __device__ __forceinline__ void operator()(const f32x4 (&acc)[2][2][4][2], const Unit& u, int wr, int wc, int fr, int fq) const {
        const int row0 = u.pm * BM + wr * 64 + fr, col0 = u.pn * BM + wc * 32 + 8 * fq;
#pragma unroll
        for (int ai = 0; ai < 2; ++ai)
#pragma unroll
            for (int m = 0; m < 4; ++m) { bf16_t* rowp = out + (size_t)(row0 + ai * HALF + m * 16) * 4096 + col0;
#pragma unroll
                for (int bj = 0; bj < 2; ++bj) { f32x4 v0 = acc[ai][bj][m][0], v1 = acc[ai][bj][m][1];
#pragma unroll
                    for (int e = 0; e < 4; ++e) { const float a = fmaxf(v0[e], 0.f), b = fmaxf(v1[e], 0.f); v0[e] = a * a; v1[e] = b * b; }
                    *(u32x4*)(rowp + bj * HALF) = pack8(v0, v1); } }
    }
};

template <class Epi, class Sched, bool ALIGN_EPI = false, bool SP2 = false>
__device__ __forceinline__ void gemm_phase(PG8_LAS unsigned char* lds, const Gemm g, const Sched& S, const Epi& E) {
    const int tid = threadIdx.x, wid = __builtin_amdgcn_readfirstlane(tid >> 6), lane = tid & 63, wr = wid >> 2, wc = wid & 3, fr = lane & 15, fq = lane >> 4;
    const int K = g.K, nt = K / BK;
    unsigned voffA[2], voffB[2];
#pragma unroll
    for (int i = 0; i < 2; ++i) { int R, C; stage_rc(tid * 16 + i * 8192, R, C); const int Rb = Epi::PERM ? ((R & ~31) + perm32(R & 31)) : R;
        voffA[i] = (unsigned)(R * K + C) * 2u; voffB[i] = (unsigned)(Rb * K + C) * 2u; }
    const size_t kstep = (size_t)(BK * 2);
    const size_t hstep = (size_t)HALF * K * 2;
    const size_t tstep = 2 * hstep;
    const unsigned ldsw = (unsigned)wid * 1024u;
    const int aoff = lds_byte(wr * 64 + fr, fq * 8), boff = lds_byte(wc * 32 + fr, fq * 8);
#define PG8_SA(b, h) (((b) * 2 + (h)) * HTB)
#define PG8_SB(b, h) ((4 + (b) * 2 + (h)) * HTB)
#define PG8_STAGE(bufoff, gbase, voff) do { _Pragma("unroll") for (int _i = 0; _i < 2; ++_i) \
        __builtin_amdgcn_global_load_lds((const unsigned*)((const char*)(gbase) + (voff)[_i]), (PG8_LAS unsigned*)(lds + (bufoff) + ldsw + _i * 8192), 16, 0, 0); } while (0)
#define PG8_LDA(dst, b, h) do { _Pragma("unroll") for (int m = 0; m < 4; ++m) _Pragma("unroll") for (int k = 0; k < 2; ++k) dst[m][k] = *(const PG8_LAS bf16x8*)(lds + PG8_SA(b, h) + aoff + m * 2048 + k * 1024); } while (0)
#define PG8_LDB(dst, b, h) do { _Pragma("unroll") for (int n = 0; n < 2; ++n) _Pragma("unroll") for (int k = 0; k < 2; ++k) dst[n][k] = *(const PG8_LAS bf16x8*)(lds + PG8_SB(b, h) + boff + n * 2048 + k * 1024); } while (0)
#define PG8_MMA(ai, bj, At, Bt) do { __builtin_amdgcn_s_setprio(1); _Pragma("unroll") for (int m = 0; m < 4; ++m) _Pragma("unroll") for (int n = 0; n < 2; ++n) _Pragma("unroll") for (int k = 0; k < 2; ++k) \
        acc[ai][bj][m][n] = __builtin_amdgcn_mfma_f32_16x16x32_bf16(Bt[n][k], At[m][k], acc[ai][bj][m][n], 0, 0, 0); __builtin_amdgcn_s_setprio(0); } while (0)
#define PG8_WAIT_V(n) asm volatile("s_waitcnt vmcnt(" #n ")" ::: "memory")
#define PG8_WAIT_L(n) asm volatile("s_waitcnt lgkmcnt(" #n ")" ::: "memory")
#define PG8_BAR __builtin_amdgcn_s_barrier()
#define PG8_SCHED __builtin_amdgcn_sched_barrier(0)
    Unit cur, nxt; int ui = 0;
    if (!S.next(0, cur)) return;
    f32x4 acc[2][2][4][2];
#pragma unroll
    for (int a = 0; a < 2; ++a)
#pragma unroll
        for (int b = 0; b < 2; ++b)
#pragma unroll
            for (int m = 0; m < 4; ++m)
#pragma unroll
                for (int n = 0; n < 2; ++n) acc[a][b][m][n] = (f32x4){0.f, 0.f, 0.f, 0.f};
    bf16x8 At[4][2], B0[2][2], B1[2][2];
    const char* cA = (const char*)g.A + (size_t)cur.pm * tstep; const char* cB = (const char*)g.Bt + (size_t)cur.pn * tstep;
    S.a_ready(cur);
    if constexpr (SP2) {
        PG8_STAGE(PG8_SB(0, 0), cB, voffB); PG8_STAGE(PG8_SB(0, 1), cB + hstep, voffB); PG8_STAGE(PG8_SA(0, 0), cA, voffA); PG8_STAGE(PG8_SA(0, 1), cA + hstep, voffA);
        if (wr == 1) PG8_BAR;
        PG8_WAIT_V(2); PG8_BAR;
        PG8_STAGE(PG8_SB(1, 0), cB + kstep, voffB); PG8_STAGE(PG8_SA(1, 0), cA + kstep, voffA); PG8_STAGE(PG8_SB(1, 1), cB + hstep + kstep, voffB);
        PG8_WAIT_V(6); PG8_BAR;
    } else {
        PG8_STAGE(PG8_SB(0, 0), cB, voffB); PG8_STAGE(PG8_SA(0, 0), cA, voffA); PG8_STAGE(PG8_SB(0, 1), cB + hstep, voffB); PG8_STAGE(PG8_SA(0, 1), cA + hstep, voffA);
        if (wr == 1) PG8_BAR;
        PG8_WAIT_V(4); PG8_BAR;
        PG8_STAGE(PG8_SB(1, 0), cB + kstep, voffB); PG8_STAGE(PG8_SA(1, 0), cA + kstep, voffA); PG8_STAGE(PG8_SB(1, 1), cB + hstep + kstep, voffB);
        PG8_WAIT_V(6); PG8_BAR;
    }
    for (;;) {
        const bool has_next = S.next(ui + 1, nxt);
        const char* nA = has_next ? (const char*)g.A + (size_t)nxt.pm * tstep : cA; const char* nB = has_next ? (const char*)g.Bt + (size_t)nxt.pn * tstep : cB;
        for (int t = 0; t < nt; t += 2) {
            const bool last = (t == nt - 2);
            const char* a1 = cA + (size_t)(t + 1) * kstep;
            const char* a2 = last ? nA : cA + (size_t)(t + 2) * kstep; const char* b2 = last ? nB : cB + (size_t)(t + 2) * kstep;
            const char* a3 = a2 + kstep; const char* b3 = b2 + kstep;
            if (last && has_next) S.a_ready(nxt);
            if constexpr (SP2) {
            PG8_LDB(B0, 0, 0); PG8_LDB(B1, 0, 1); PG8_SCHED; PG8_LDA(At, 0, 0); PG8_STAGE(PG8_SA(1, 1), a1 + hstep, voffA);
            PG8_WAIT_V(8); PG8_WAIT_L(0); PG8_BAR; PG8_MMA(0, 0, At, B0); PG8_MMA(0, 1, At, B1); PG8_BAR; PG8_SCHED;
            PG8_LDA(At, 0, 1); PG8_STAGE(PG8_SB(0, 0), b2, voffB); PG8_STAGE(PG8_SB(0, 1), b2 + hstep, voffB); PG8_STAGE(PG8_SA(0, 0), a2, voffA);
            PG8_WAIT_V(8); PG8_WAIT_L(0); PG8_BAR; PG8_MMA(1, 0, At, B0); PG8_MMA(1, 1, At, B1); PG8_BAR; PG8_SCHED;
            PG8_LDB(B0, 1, 0); PG8_LDB(B1, 1, 1); PG8_SCHED; PG8_LDA(At, 1, 0); PG8_STAGE(PG8_SA(0, 1), a2 + hstep, voffA);
            PG8_WAIT_V(8); PG8_WAIT_L(0); PG8_BAR; PG8_MMA(0, 0, At, B0); PG8_MMA(0, 1, At, B1); PG8_BAR; PG8_SCHED;
            PG8_LDA(At, 1, 1); PG8_STAGE(PG8_SB(1, 0), b3, voffB); PG8_STAGE(PG8_SB(1, 1), b3 + hstep, voffB); PG8_STAGE(PG8_SA(1, 0), a3, voffA);
            PG8_WAIT_V(8); PG8_WAIT_L(0); PG8_BAR; PG8_MMA(1, 0, At, B0); PG8_MMA(1, 1, At, B1); PG8_BAR; PG8_SCHED;
            } else {
            PG8_LDB(B0, 0, 0); PG8_SCHED; PG8_LDA(At, 0, 0); PG8_STAGE(PG8_SA(1, 1), a1 + hstep, voffA);
            PG8_WAIT_L(8); PG8_BAR; PG8_WAIT_L(0); PG8_MMA(0, 0, At, B0); PG8_BAR; PG8_SCHED;
            PG8_LDB(B1, 0, 1); PG8_STAGE(PG8_SB(0, 0), b2, voffB);
            PG8_BAR; PG8_WAIT_L(0); PG8_MMA(0, 1, At, B1); PG8_BAR;
            PG8_LDA(At, 0, 1); PG8_STAGE(PG8_SA(0, 0), a2, voffA);
            PG8_BAR; PG8_WAIT_L(0); PG8_MMA(1, 0, At, B0); PG8_BAR; PG8_SCHED;
            PG8_STAGE(PG8_SB(0, 1), b2 + hstep, voffB);
            PG8_WAIT_V(6); PG8_BAR; PG8_MMA(1, 1, At, B1); PG8_BAR;
            PG8_LDB(B0, 1, 0); PG8_SCHED; PG8_LDA(At, 1, 0); PG8_STAGE(PG8_SA(0, 1), a2 + hstep, voffA);
            PG8_WAIT_L(8); PG8_BAR; PG8_WAIT_L(0); PG8_MMA(0, 0, At, B0); PG8_BAR; PG8_SCHED;
            PG8_LDB(B1, 1, 1); PG8_STAGE(PG8_SB(1, 0), b3, voffB);
            PG8_BAR; PG8_WAIT_L(0); PG8_MMA(0, 1, At, B1); PG8_BAR;
            PG8_LDA(At, 1, 1); PG8_STAGE(PG8_SA(1, 0), a3, voffA);
            PG8_BAR; PG8_WAIT_L(0); PG8_MMA(1, 0, At, B0); PG8_BAR; PG8_SCHED;
            PG8_STAGE(PG8_SB(1, 1), b3 + hstep, voffB);
            PG8_WAIT_V(6); PG8_BAR; PG8_MMA(1, 1, At, B1); PG8_BAR;
            }
        }
        if constexpr (ALIGN_EPI) { if (wr == 0) PG8_BAR; }
        if constexpr (!Epi::AFTER_DRAIN) { E(acc, cur, wr, wc, fr, fq); S.done(cur); }
        if (!has_next) break;
#pragma unroll
        for (int a = 0; a < 2; ++a)
#pragma unroll
            for (int b = 0; b < 2; ++b)
#pragma unroll
                for (int m = 0; m < 4; ++m)
#pragma unroll
                    for (int n = 0; n < 2; ++n) acc[a][b][m][n] = (f32x4){0.f, 0.f, 0.f, 0.f};
        cur = nxt; cA = nA; cB = nB; ++ui;
        if constexpr (ALIGN_EPI) { if (wr == 1) PG8_BAR; }
    }
    PG8_WAIT_V(0);
    if constexpr (!ALIGN_EPI) { if (wr == 0) PG8_BAR; }
    PG8_BAR;
    if constexpr (Epi::AFTER_DRAIN) { E.fused(acc, cur, wr, wc, fr, fq, lds, wid, lane); S.done(cur); }
#undef PG8_SA
#undef PG8_SB
#undef PG8_STAGE
#undef PG8_LDA
#undef PG8_LDB
#undef PG8_MMA
#undef PG8_WAIT_V
#undef PG8_WAIT_L
#undef PG8_BAR
#undef PG8_SCHED
}
}
#include <hip/hip_bf16.h>
#include <cmath>
namespace attn_body {
using bf16=__hip_bfloat16;
using bf16x8=__attribute__((ext_vector_type(8)))short;
using s16x4=__attribute__((ext_vector_type(4)))short;
using f32x16=__attribute__((ext_vector_type(16)))float;
using u32x4=__attribute__((ext_vector_type(4)))unsigned;
constexpr int SEQ=8192,D=64,DM=1024;
constexpr int NW=8,QBLK=32,QB=QBLK*NW,KVBLK=64,NQB=SEQ/QB;
constexpr int ATTN_PITCH=DM, ATTN_UNIT_ROWS=QB;
__device__ __forceinline__ int crow(int r,int hi){return (r&3)+8*(r>>2)+4*hi;}
#define SBAR() __builtin_amdgcn_sched_barrier(0)
__device__ __forceinline__ void cmask(f32x16&p0,f32x16&p1,int jb,int qrel,int hi){
  const float NEG=-INFINITY; int kb=64*jb+4*hi;
  #pragma unroll
  for(int r=0;r<16;++r){int kv=kb+(r&3)+8*(r>>2); if(kv>qrel)p0[r]=NEG; if(kv+32>qrel)p1[r]=NEG;}
}

typedef __attribute__((address_space(3))) const float* lds_fptr;
__device__ __forceinline__ void bmask(f32x16&p0,f32x16&p1,int jb,int qrel,int hi,lds_fptr tab){
  lds_fptr tp=tab+(qrel-64*jb-4*hi+196);
  #pragma unroll
  for(int r=0;r<16;++r){const int off=(r&3)+8*(r>>2); p0[r]+=tp[59-off]; p1[r]+=tp[27-off];}
}
constexpr int NSLOT=3, SLOTB=8192;
constexpr int LDS_K=0, LDS_V=NSLOT*SLOTB, LDS_WS=2*NSLOT*SLOTB, LDS_OST=LDS_WS+NW*64*4, LDS_BYTES=LDS_OST+NW*4096;
constexpr float C2=0.125f*1.4426950408889634f;
__device__ __forceinline__ void glds16(const void*gsrc,unsigned lds_dst){unsigned keep;
  asm volatile("s_mov_b32 %0, m0\n\ts_mov_b32 m0, %2\n\ts_nop 0\n\tglobal_load_lds_dwordx4 %1, off\n\ts_mov_b32 m0, %0":"=&s"(keep):"v"(gsrc),"s"(lds_dst):"memory");}
__device__ __forceinline__ float max3f(float a,float b,float c){float r;asm("v_max3_f32 %0, %1, %2, %3":"=v"(r):"v"(a),"v"(b),"v"(c));return r;}
__device__ __forceinline__ float max2f(float a,float b){float r;asm("v_max_f32_e32 %0, %1, %2":"=v"(r):"v"(a),"v"(b));return r;}
__device__ __forceinline__ float fadd_s(float a,float b){float r;asm("v_add_f32_e32 %0, %1, %2":"=v"(r):"v"(a),"v"(b));return r;}
__device__ __forceinline__ float fsub_s(float a,float b){float r;asm("v_sub_f32_e32 %0, %1, %2":"=v"(r):"v"(a),"v"(b));return r;}
typedef float f32x2_t __attribute__((ext_vector_type(2))); typedef __bf16 bf16x2_t __attribute__((ext_vector_type(2)));
__device__ __forceinline__ unsigned cvtpk_s(float lo,float hi){f32x2_t v={lo,hi};bf16x2_t b=__builtin_convertvector(v,bf16x2_t);return __builtin_bit_cast(unsigned,b);}
#define WAIT_BAR(N) asm volatile("s_waitcnt vmcnt(" #N ") lgkmcnt(0)\n\ts_barrier":::"memory")

__device__ __forceinline__ void qkt(f32x16&p0,f32x16&p1,const char*Kslot,const bf16x8*qr,const f32x16&negm,int r32,int hi){
  const char*kb=Kslot+hi*1024+r32*16;
  #pragma unroll
  for(int d0=0;d0<4;++d0){
    const bf16x8 b0=*reinterpret_cast<const bf16x8*>(kb+d0*2048);
    const bf16x8 b1=*reinterpret_cast<const bf16x8*>(kb+d0*2048+512);
    if(d0==0){p0=__builtin_amdgcn_mfma_f32_32x32x16_bf16(b0,qr[0],negm,0,0,0);p1=__builtin_amdgcn_mfma_f32_32x32x16_bf16(b1,qr[0],negm,0,0,0);}
    else{p0=__builtin_amdgcn_mfma_f32_32x32x16_bf16(b0,qr[d0],p0,0,0,0);p1=__builtin_amdgcn_mfma_f32_32x32x16_bf16(b1,qr[d0],p1,0,0,0);}}
}
typedef __attribute__((address_space(3))) const char* lds_cptr;
typedef short v4i16_t __attribute__((ext_vector_type(4)));
__device__ __forceinline__ void kload8(bf16x8*kf,lds_cptr kp){
  kf[0]=*(const __attribute__((address_space(3))) bf16x8*)(kp);      kf[1]=*(const __attribute__((address_space(3))) bf16x8*)(kp+512);
  kf[2]=*(const __attribute__((address_space(3))) bf16x8*)(kp+2048); kf[3]=*(const __attribute__((address_space(3))) bf16x8*)(kp+2560);
  kf[4]=*(const __attribute__((address_space(3))) bf16x8*)(kp+4096); kf[5]=*(const __attribute__((address_space(3))) bf16x8*)(kp+4608);
  kf[6]=*(const __attribute__((address_space(3))) bf16x8*)(kp+6144); kf[7]=*(const __attribute__((address_space(3))) bf16x8*)(kp+6656);
}
__device__ __forceinline__ void kload2(bf16x8*kf,lds_cptr kp,int j){ kf[2*j]=*(const __attribute__((address_space(3))) bf16x8*)(kp+j*2048); kf[2*j+1]=*(const __attribute__((address_space(3))) bf16x8*)(kp+j*2048+512); }
__device__ __forceinline__ s16x4 vtr(lds_cptr p){ return __builtin_bit_cast(s16x4,__builtin_amdgcn_ds_read_tr16_b64_v4i16((__attribute__((address_space(3))) v4i16_t*)p)); }
__device__ __forceinline__ float rowmax(const f32x16&p0,const f32x16&p1){
  float a=max3f(p0[0],p0[1],p1[0]),b=max3f(p0[2],p0[3],p1[1]);a=max3f(a,p1[2],p1[3]);
  #pragma unroll
  for(int r=4;r<16;r+=4){a=max3f(a,p0[r],p0[r+1]);b=max3f(b,p0[r+2],p0[r+3]);a=max3f(a,p1[r],p1[r+1]);b=max3f(b,p1[r+2],p1[r+3]);}
  const float m=max2f(a,b);
  auto rr=__builtin_amdgcn_permlane32_swap(__float_as_uint(m),__float_as_uint(m),false,false);
  return max2f(__uint_as_float(rr[0]),__uint_as_float(rr[1]));
}
__device__ __forceinline__ void pv(f32x16*o,int vb,bf16x8 pa0,bf16x8 pa1,bf16x8 pa2,bf16x8 pa3){
  #pragma unroll
  for(int d0=0;d0<2;++d0){s16x4 lo[4],hi[4];
    #pragma unroll
    for(int ks=0;ks<4;++ks){
      asm volatile("ds_read_b64_tr_b16 %0,%1 offset:%c2":"=&v"(lo[ks]):"v"(vb),"i"(d0*4096+ks*1024):"memory");
      asm volatile("ds_read_b64_tr_b16 %0,%1 offset:%c2":"=&v"(hi[ks]):"v"(vb),"i"(d0*4096+ks*1024+512):"memory");}
    asm volatile("s_waitcnt lgkmcnt(0)":::"memory");SBAR();
    #define PK(k) (bf16x8){lo[k][0],lo[k][1],lo[k][2],lo[k][3],hi[k][0],hi[k][1],hi[k][2],hi[k][3]}
    o[d0]=__builtin_amdgcn_mfma_f32_32x32x16_bf16(pa0,PK(0),o[d0],0,0,0);
    o[d0]=__builtin_amdgcn_mfma_f32_32x32x16_bf16(pa1,PK(1),o[d0],0,0,0);
    o[d0]=__builtin_amdgcn_mfma_f32_32x32x16_bf16(pa2,PK(2),o[d0],0,0,0);
    o[d0]=__builtin_amdgcn_mfma_f32_32x32x16_bf16(pa3,PK(3),o[d0],0,0,0);
    #undef PK
  }
}

#ifndef ATTN_STORE16
#define ATTN_STORE16(p,v) (*(u32x4*)(p)=(v))
#endif
template<int THRL> __device__ __forceinline__ void attn_unit(int qb,const bf16*Q,const bf16*__restrict__ K,const bf16*__restrict__ V,bf16*O,lds_fptr tab,char*shm){
  __builtin_amdgcn_sched_barrier(0); int tid_=threadIdx.x; asm volatile("":"+v"(tid_));
  const int tid=tid_,lane=tid&63,r32=lane&31,hi=lane>>5; const int wid=__builtin_amdgcn_readfirstlane(tid>>6);
  const int q0=qb*QB;
  const bf16*Qw=Q+(long)(q0+wid*QBLK)*DM;
  const bf16*Kh=K,*Vh=V;
  const unsigned lds0=(unsigned)(uintptr_t)shm;
  float*wsf=(float*)(shm+LDS_WS)+wid*64;
  const bf16*ksrc=Kh+(long)lane*DM+wid*8;
  const bf16*vsrc=Vh+(long)(16*(wid&3)+(lane>>2))*DM+(wid>>2)*32+(lane&3)*8;
  const unsigned kdst=lds0+LDS_K+wid*1024, vdst=lds0+LDS_V+wid*1024;
  #define DMA_K(t,slot) glds16(ksrc+(long)(t)*KVBLK*DM,(unsigned)__builtin_amdgcn_readfirstlane(kdst+(slot)))
  #define DMA_V(t,slot) glds16(vsrc+(long)(t)*KVBLK*DM,(unsigned)__builtin_amdgcn_readfirstlane(vdst+(slot)))
  const int vb0=(int)(lds0+LDS_V)+((lane>>4)&1)*32+(lane&3)*8+(4*hi+((lane&15)>>2))*64;
  const char*Kbase=shm+LDS_K; bf16x8 kf[8];
  const lds_cptr shm3=(lds_cptr)shm; const lds_cptr kp0=shm3+LDS_K+hi*1024+r32*16; const lds_cptr vp0=shm3+LDS_V+((lane>>4)&1)*32+(lane&3)*8+(4*hi+((lane&15)>>2))*64;
  const int NT=(q0+QB)/KVBLK;
  DMA_K(0,0);DMA_V(0,0);DMA_K(1,SLOTB);
  bf16x8 qr[4];
  #pragma unroll
  for(int d0=0;d0<4;++d0)qr[d0]=*reinterpret_cast<const bf16x8*>(&Qw[(long)r32*DM+d0*16+hi*8]);
  float mhat=0.f,l_reg=0.f;f32x16 o[2];o[0]=f32x16{};o[1]=f32x16{};f32x16 negm=f32x16{};asm volatile("":"+v"(negm));
  const int qrel=wid*QBLK+r32;
  #define CMASK(P0,P1,t) do{int jb_=(t)-(NT-4); if(jb_>=-2)bmask(P0,P1,jb_,qrel,hi,tab);}while(0)
  bool resc=false;
  #define START(P0,P1) do{ const float rm=rowmax(P0,P1); resc=false; \
    { const float dl=rm; mhat=fadd_s(mhat,dl); \
      _Pragma("unroll") for(int r=0;r<16;++r){P0[r]=fsub_s(P0[r],dl);P1[r]=fsub_s(P1[r],dl);} \
      _Pragma("unroll") for(int r=0;r<16;++r)negm[r]=-mhat; asm volatile("":"+v"(negm)); } \
    _Pragma("unroll") for(int r=0;r<16;++r)P0[r]=__builtin_amdgcn_exp2f(P0[r]); }while(0)
  #define RESC() do{ if(resc){ asm volatile("s_waitcnt lgkmcnt(0)":::"memory"); \
      _Pragma("unroll") for(int d_=0;d_<2;++d_) _Pragma("unroll") for(int r=0;r<16;++r)o[d_][r]*=wsf[crow(r,hi)]; } }while(0)
  f32x16 pA0,pA1,pB0,pB1;
  int sl_prev=0,sl_cur=0,sl_next=SLOTB;
  #define ROT() do{sl_prev=sl_cur;sl_cur=sl_next;sl_next=(sl_next==(NSLOT-1)*SLOTB)?0:sl_next+SLOTB;}while(0)
  DMA_K(2,2*SLOTB);
  WAIT_BAR(3);
  qkt(pA0,pA1,Kbase,qr,negm,r32,hi);asm volatile("s_nop 15\n\ts_nop 7":"+v"(pA0),"+v"(pA1));CMASK(pA0,pA1,0);
  START(pA0,pA1);
  _Pragma("unroll") for(int r=0;r<16;++r)pA1[r]=__builtin_amdgcn_exp2f(pA1[r]);
  WAIT_BAR(0);
  DMA_K(3,0);DMA_V(1,SLOTB);
  ROT();
  kload8(kf,kp0+sl_cur);
  WAIT_BAR(2);
  s16x4 vlo[8],vhi[8]; u32x4 pw0,pw1,pw2,pw3;
  #define PKW(P,B) cvtpk_s(P[B],P[B+1])
  #define PAF(k) __builtin_bit_cast(bf16x8,pw##k)
  #define VFR(i) (bf16x8){vlo[i][0],vlo[i][1],vlo[i][2],vlo[i][3],vhi[i][0],vhi[i][1],vhi[i][2],vhi[i][3]}
  #define PIN(x) asm volatile("":"+v"(x))
  #define MX3(a,b,c) __builtin_fmaxf(__builtin_fmaxf((a),(b)),(c))
  #define GAPA(MF,A0,A1,A2,A3,W0,W1,PW) do{ MF; sacc+=A0; sacc+=A1; sacc+=A2; sacc+=A3; PIN(sacc); W0; W1; PIN(PW); SBAR(); }while(0)
  #define EX(v) __builtin_amdgcn_exp2f(v)
  #define GAPB(MF,X,B) do{ MF; X[B]=EX(X[B]); X[B+1]=EX(X[B+1]); X[B+2]=EX(X[B+2]); X[B+3]=EX(X[B+3]); PIN(X); SBAR(); }while(0)
  #define VRD(i) do{ vlo[i]=vtr(vp_+(((i)>>2)*4096+((i)&3)*1024)); vhi[i]=vtr(vp_+(((i)>>2)*4096+((i)&3)*1024+512)); }while(0)
  #define KRD(G,j) do{ if(G){ kload2(kf,kp0+sl_next,j); SBAR(); } }while(0)
  #define STEP(C0,C1,P0,P1,t,GK,GV,GL) do{ SBAR(); \
    const lds_cptr vp_=vp0+sl_prev; \
    VRD(0); SBAR(); float sacc=(P0[0]+P0[1]); \
    GAPA(C0=__builtin_amdgcn_mfma_f32_32x32x16_bf16(kf[0],qr[0],negm,0,0,0), P0[2],P0[3],P0[4],P0[5],     pw0[0]=PKW(P0,0), pw0[1]=PKW(P0,2), pw0); \
    VRD(4); SBAR(); GAPA(C1=__builtin_amdgcn_mfma_f32_32x32x16_bf16(kf[1],qr[0],negm,0,0,0), P0[6],P0[7],P0[8],P0[9],     pw0[2]=PKW(P0,4), pw0[3]=PKW(P0,6), pw0); \
    VRD(1); SBAR(); GAPA(C0=__builtin_amdgcn_mfma_f32_32x32x16_bf16(kf[2],qr[1],C0,0,0,0),   P0[10],P0[11],P0[12],P0[13], pw1[0]=PKW(P0,8), pw1[1]=PKW(P0,10), pw1); \
    VRD(5); SBAR(); GAPA(C1=__builtin_amdgcn_mfma_f32_32x32x16_bf16(kf[3],qr[1],C1,0,0,0),   P0[14],P0[15],P1[0],P1[1],   pw1[2]=PKW(P0,12),pw1[3]=PKW(P0,14), pw1); \
    VRD(2); SBAR(); GAPA(C0=__builtin_amdgcn_mfma_f32_32x32x16_bf16(kf[4],qr[2],C0,0,0,0),   P1[2],P1[3],P1[4],P1[5],     pw2[0]=PKW(P1,0), pw2[1]=PKW(P1,2), pw2); \
    VRD(6); SBAR(); GAPA(C1=__builtin_amdgcn_mfma_f32_32x32x16_bf16(kf[5],qr[2],C1,0,0,0),   P1[6],P1[7],P1[8],P1[9],     pw2[2]=PKW(P1,4), pw2[3]=PKW(P1,6), pw2); \
    VRD(3); SBAR(); GAPA(C0=__builtin_amdgcn_mfma_f32_32x32x16_bf16(kf[6],qr[3],C0,0,0,0),   P1[10],P1[11],P1[12],P1[13], pw3[0]=PKW(P1,8), pw3[1]=PKW(P1,10), pw3); \
    VRD(7); SBAR(); GAPA(C1=__builtin_amdgcn_mfma_f32_32x32x16_bf16(kf[7],qr[3],C1,0,0,0),   P1[14],P1[15],0.f,0.f,       pw3[2]=PKW(P1,12),pw3[3]=PKW(P1,14), pw3); \
    l_reg+=sacc; \
    if(GK){DMA_K((t)+3,sl_cur);} if(GV){DMA_V((t)+1,sl_next);} \
    CMASK(C0,C1,t); \
    { float a=MX3(C0[0],C0[1],C1[0]),b=MX3(C0[2],C0[3],C1[1]); a=MX3(a,C1[2],C1[3]); \
      _Pragma("unroll") for(int r=4;r<16;r+=4){a=MX3(a,C0[r],C0[r+1]);b=MX3(b,C0[r+2],C0[r+3]);a=MX3(a,C1[r],C1[r+1]);b=MX3(b,C1[r+2],C1[r+3]);} \
      float rm=__builtin_fmaxf(a,b); { auto rr=__builtin_amdgcn_permlane32_swap(__float_as_uint(rm),__float_as_uint(rm),false,false); rm=__builtin_fmaxf(__uint_as_float(rr[0]),__uint_as_float(rr[1])); } \
      resc=false; \
      if(__builtin_expect(__any(rm>(float)THRL),0)){ const float dl=__builtin_fmaxf(rm,0.f); mhat+=dl; \
        _Pragma("unroll") for(int r=0;r<16;++r){C0[r]-=dl;C1[r]-=dl;} \
        _Pragma("unroll") for(int r=0;r<16;++r)negm[r]=-mhat; asm volatile("":"+v"(negm)); \
        const float f=__builtin_amdgcn_exp2f(-dl); l_reg*=f; if(hi==0)wsf[r32]=f; resc=true; } } \
    SBAR(); \
    GAPB(o[0]=__builtin_amdgcn_mfma_f32_32x32x16_bf16(PAF(0),VFR(0),o[0],0,0,0), C0,0); \
    GAPB(o[1]=__builtin_amdgcn_mfma_f32_32x32x16_bf16(PAF(0),VFR(4),o[1],0,0,0), C0,4); \
    KRD(GL,0); GAPB(o[0]=__builtin_amdgcn_mfma_f32_32x32x16_bf16(PAF(1),VFR(1),o[0],0,0,0), C0,8); \
    KRD(GL,1); GAPB(o[1]=__builtin_amdgcn_mfma_f32_32x32x16_bf16(PAF(1),VFR(5),o[1],0,0,0), C0,12); \
    KRD(GL,2); GAPB(o[0]=__builtin_amdgcn_mfma_f32_32x32x16_bf16(PAF(2),VFR(2),o[0],0,0,0), C1,0); \
    KRD(GL,3); GAPB(o[1]=__builtin_amdgcn_mfma_f32_32x32x16_bf16(PAF(2),VFR(6),o[1],0,0,0), C1,4); \
    GAPB(o[0]=__builtin_amdgcn_mfma_f32_32x32x16_bf16(PAF(3),VFR(3),o[0],0,0,0), C1,8); \
    GAPB(o[1]=__builtin_amdgcn_mfma_f32_32x32x16_bf16(PAF(3),VFR(7),o[1],0,0,0), C1,12); \
    }while(0)
  int t=1;
  #undef CMASK
  #define CMASK(P0,P1,t) do{}while(0)
  for(;t+7<NT;t+=2){
    STEP(pB0,pB1,pA0,pA1,t,true,true,true);     WAIT_BAR(2); RESC(); ROT();
    STEP(pA0,pA1,pB0,pB1,t+1,true,true,true);   WAIT_BAR(2); RESC(); ROT();
  }
  #undef CMASK
  #define CMASK(P0,P1,t) do{int jb_=(t)-(NT-4); if(jb_>=-2)bmask(P0,P1,jb_,qrel,hi,tab);}while(0)
  #define ENDW(tt) do{ if((tt)+3<NT){WAIT_BAR(2);} else if((tt)+2<NT){WAIT_BAR(1);} else {WAIT_BAR(0);} }while(0)
  for(;t+1<NT;t+=2){
    STEP(pB0,pB1,pA0,pA1,t,(t+3<NT),(t+1<NT),(t+1<NT));       ENDW(t);   RESC(); ROT();
    STEP(pA0,pA1,pB0,pB1,t+1,(t+4<NT),(t+2<NT),(t+2<NT));     ENDW(t+1); RESC(); ROT();
  }
  STEP(pB0,pB1,pA0,pA1,NT-1,false,false,false); RESC();
  { float sacc=pB0[0]+pB0[1]; _Pragma("unroll") for(int r=2;r<16;++r)sacc+=pB0[r]; _Pragma("unroll") for(int r=0;r<16;++r)sacc+=pB1[r]; l_reg+=sacc;
    pw0=(u32x4){PKW(pB0,0),PKW(pB0,2),PKW(pB0,4),PKW(pB0,6)};pw1=(u32x4){PKW(pB0,8),PKW(pB0,10),PKW(pB0,12),PKW(pB0,14)};pw2=(u32x4){PKW(pB1,0),PKW(pB1,2),PKW(pB1,4),PKW(pB1,6)};pw3=(u32x4){PKW(pB1,8),PKW(pB1,10),PKW(pB1,12),PKW(pB1,14)};
    SBAR(); pv(o,vb0+sl_cur,PAF(0),PAF(1),PAF(2),PAF(3)); }
  #undef PKW
  #undef PAF
  #undef VFR
  #undef PIN
  #undef MX3
  #undef GAPA
  #undef GAPB
  #undef EX
  #undef VRD
  #undef KRD
  #undef STEP
  #undef ENDW
  {auto rr=__builtin_amdgcn_permlane32_swap(__float_as_uint(l_reg),__float_as_uint(l_reg),false,false);l_reg=__uint_as_float(rr[0])+__uint_as_float(rr[1]);}
  if(hi==0)wsf[32+r32]=l_reg;asm volatile("s_waitcnt lgkmcnt(0)":::"memory");
  float rli[16];
  #pragma unroll
  for(int r=0;r<16;++r)rli[r]=__builtin_amdgcn_rcpf(wsf[32+crow(r,hi)]);
  bf16*Ow=O+(long)(q0+wid*QBLK)*DM;
  { bf16*stg=(bf16*)(shm+LDS_OST)+wid*2048;
    #pragma unroll
    for(int r=0;r<16;++r){const int orow=crow(r,hi);
      #pragma unroll
      for(int d0=0;d0<2;++d0)stg[orow*64+d0*32+r32]=__float2bfloat16(o[d0][r]*rli[r]);}
    asm volatile("s_waitcnt lgkmcnt(0)":::"memory");
    #pragma unroll
    for(int i=0;i<4;++i){const int row=i*8+(lane>>3),ch=lane&7; const u32x4 v=*(const u32x4*)(stg+row*64+ch*8); ATTN_STORE16(Ow+(long)row*DM+ch*8,v);} }
  asm volatile("s_waitcnt lgkmcnt(0)\n\ts_barrier":::"memory");
  __builtin_amdgcn_sched_barrier(0);
  #undef DMA_K
  #undef DMA_V
  #undef CMASK
  #undef START
  #undef RESC
  #undef ROT
}
constexpr int ATTN_LDS_BYTES=LDS_BYTES;
#undef SBAR
#undef WAIT_BAR
}
constexpr int SEQ = 8192, DMODEL = 1024, M = 4 * SEQ, FF = 4096, COLS_A = 4608, COLS_B2 = 5120;
constexpr float LN_EPS = 1e-5f, LOG2E = 1.4426950408889634f;
constexpr float DN_ALPHA = 1.189207115002721f;
constexpr size_t MiB = 1u << 20;
constexpr size_t WS_WIN = 0, WS_WPA = 19 * MiB, WS_WPB = 20 * MiB, WS_WO = 22 * MiB, WS_W1 = 24 * MiB, WS_W2 = 32 * MiB;
constexpr size_t WS_R1 = 40 * MiB;
constexpr size_t WS_R2 = 328 * MiB;
constexpr size_t WS_OG = WS_R2, WS_LSE = WS_R2 + 96 * MiB;
constexpr size_t WS_XB = 427 * MiB;
constexpr size_t WS_OA = WS_R1, WS_QB = WS_R1 + 32 * MiB, WS_O1 = WS_R1 + 224 * MiB, WS_O2 = WS_R2;
constexpr size_t WS_OB = WS_R1 + 32 * MiB, WS_GATES = WS_R1 + 96 * MiB, WS_TMP = WS_R1 + 224 * MiB, WS_MERGED = WS_XB;
constexpr size_t WS_Z = WS_R1, WS_X1B = WS_XB, WS_H = WS_R1 + 128 * MiB, WS_CTL = 496 * MiB, CTL_BYTES = 16384, WS_END = 497 * MiB;
constexpr int RING_BYTES = 131072, LDS_BYTES = 147456;

#define GAS __attribute__((address_space(1)))
#define LAS __attribute__((address_space(3)))
typedef unsigned short bf16;
typedef unsigned v4u __attribute__((ext_vector_type(4)));
typedef unsigned v2u __attribute__((ext_vector_type(2)));
typedef float f32x4 __attribute__((ext_vector_type(4)));
typedef float f32x16 __attribute__((ext_vector_type(16)));
typedef short bf16x8 __attribute__((ext_vector_type(8)));
typedef short s16x4 __attribute__((ext_vector_type(4)));
#define LDS_WAIT() asm volatile("s_waitcnt lgkmcnt(0)" ::: "memory")
__device__ __forceinline__ unsigned f2bf(float f) { unsigned u = __builtin_bit_cast(unsigned, f); return (u + 0x7fffu + ((u >> 16) & 1u)) >> 16; }
__device__ __forceinline__ unsigned pk2(float lo, float hi) { return f2bf(lo) | (f2bf(hi) << 16); }
__device__ __forceinline__ float blo(unsigned w) { return __uint_as_float(w << 16); }
__device__ __forceinline__ float bhi(unsigned w) { return __uint_as_float(w & 0xffff0000u); }
__device__ __forceinline__ float wave_sum(float v) {
#pragma unroll
    for (int o = 1; o < 64; o <<= 1) v += __shfl_xor(v, o);
    return v;
}
__device__ __forceinline__ int t5_bucket(int n) {
    if (n < 16) return n;
    const float v = logf((float)n / 16.0f) / 2.0794415416798357f * 16.0f;
    int l = 16 + (int)v; return l > 31 ? 31 : l;
}
__device__ __forceinline__ void p0_transpose_item(const float* W, int K, int N, bf16* WT, LAS float* scr, int item, int lane) {
    const int nblk = N / 32, kb = item / nblk, nb = item % nblk, k0 = 64 * kb, n0 = 32 * nb;
#pragma unroll 8
    for (int i = 0; i < 32; ++i) { const int kk = 2 * i + (lane >> 5); scr[kk * 33 + (lane & 31)] = W[(size_t)(k0 + kk) * N + n0 + (lane & 31)]; }
    LDS_WAIT(); asm volatile("" ::: "memory");
    const int c = lane & 7;
#pragma unroll
    for (int j = 0; j < 4; ++j) { const int n = (lane >> 3) + 8 * j; const LAS float* s = scr + (8 * c) * 33 + n;
        v4u o; o.x = pk2(s[0 * 33], s[1 * 33]); o.y = pk2(s[2 * 33], s[3 * 33]); o.z = pk2(s[4 * 33], s[5 * 33]); o.w = pk2(s[6 * 33], s[7 * 33]);
        *(v4u*)(WT + (size_t)(n0 + n) * K + k0 + 8 * c) = o; }
    LDS_WAIT(); asm volatile("" ::: "memory");
}

namespace attn_a {
constexpr int KP = 144, VP = 192, LDS_KS = 0, LDS_VS = 384 * KP, LDS_TAB = 384 * KP + 384 * VP;
typedef __attribute__((address_space(3))) const char* lds_cptr;
typedef short v4i16_t __attribute__((ext_vector_type(4)));
__device__ __forceinline__ s16x4 vtr(lds_cptr p) { return __builtin_bit_cast(s16x4, __builtin_amdgcn_ds_read_tr16_b64_v4i16((__attribute__((address_space(3))) v4i16_t*)p)); }
typedef float f32x2_t __attribute__((ext_vector_type(2))); typedef __bf16 bf16x2_t __attribute__((ext_vector_type(2)));
__device__ __forceinline__ unsigned cvtpk(float lo, float hi) { f32x2_t v = {lo, hi}; bf16x2_t b = __builtin_convertvector(v, bf16x2_t); return __builtin_bit_cast(unsigned, b); }
__device__ __forceinline__ void unit(int g, int h, int blk, const bf16* qa, const bf16* ka, const bf16* va, bf16* og, float* lse, const float* rel_bias, LAS unsigned char* lds) {
    const int tid = threadIdx.x, lane = tid & 63, r32 = lane & 31, hi = lane >> 5; const int wid = __builtin_amdgcn_readfirstlane(tid >> 6);
    const int sh = 2 * g, Lm1 = (SEQ >> sh) - 1, p0 = blk * 256;
    const bool first = ((p0 & Lm1) == 0);
    const size_t gofs = (size_t)g * ((size_t)M * 512);
    const bf16* kg = ka + gofs + h * 64; const bf16* vg = va + gofs + h * 64;
#pragma unroll
    for (int it = 0; it < 6; ++it) { const int idx = it * 512 + tid, row = idx >> 3, ch = idx & 7; const long prow = (long)p0 - 128 + row;
        v4u kv4 = {0u, 0u, 0u, 0u}, vv4 = {0u, 0u, 0u, 0u};
        if (!(first && row < 128)) { kv4 = *(const v4u*)(kg + prow * 512 + ch * 8); vv4 = *(const v4u*)(vg + prow * 512 + ch * 8); }
        *(LAS v4u*)(lds + LDS_KS + row * KP + ch * 16) = kv4; *(LAS v4u*)(lds + LDS_VS + row * VP + ch * 16) = vv4; }
    LAS float* tab = (LAS float*)(lds + LDS_TAB);
    if (tid < 129) tab[tid] = rel_bias[t5_bucket(tid << sh) * 32 + g * 8 + h] * LOG2E;
    bf16x8 qr[4];
    { const bf16* qrow = qa + gofs + (size_t)(p0 + wid * 32 + r32) * 512 + h * 64 + hi * 8;
#pragma unroll
      for (int d0 = 0; d0 < 4; ++d0) qr[d0] = *(const bf16x8*)(qrow + d0 * 16); }
    __syncthreads();
    f32x16 S[5];
    { const LAS unsigned char* kb = lds + LDS_KS + (wid * 32 + r32) * KP + hi * 16;
#pragma unroll
      for (int c = 0; c < 5; ++c) { f32x16 a = {};
#pragma unroll
          for (int d0 = 0; d0 < 4; ++d0) { const bf16x8 kf = *(const LAS bf16x8*)(kb + c * 32 * KP + d0 * 32); a = __builtin_amdgcn_mfma_f32_32x32x16_bf16(kf, qr[d0], a, 0, 0, 0); }
          S[c] = a; } }
    float mx = -1e30f;
#pragma unroll
    for (int c = 0; c < 5; ++c)
#pragma unroll
        for (int i = 0; i < 16; ++i) { const int cr = (i & 3) + 8 * (i >> 2) + 4 * hi; const int steps = r32 + 128 - 32 * c - cr;
            bool valid = (steps >= 0) && (steps <= 128); if (first) valid = valid && (wid * 32 + 32 * c + cr >= 128);
            const int si = steps < 0 ? 0 : (steps > 128 ? 128 : steps);
            const float v = valid ? S[c][i] + tab[si] : -1e30f; S[c][i] = v; mx = fmaxf(mx, v); }
    mx = fmaxf(mx, __shfl_xor(mx, 32));
    float l = 0.f;
#pragma unroll
    for (int c = 0; c < 5; ++c)
#pragma unroll
        for (int i = 0; i < 16; ++i) { const float p = __builtin_amdgcn_exp2f(S[c][i] - mx); S[c][i] = p; l += p; }
    l += __shfl_xor(l, 32);
    f32x16 O[2]; O[0] = f32x16{}; O[1] = f32x16{};
    { const lds_cptr vb = (lds_cptr)(lds + LDS_VS) + (wid * 32 + 4 * hi + ((lane & 15) >> 2)) * VP + ((lane >> 4) & 1) * 32 + (lane & 3) * 8;
#pragma unroll
      for (int c = 0; c < 5; ++c)
#pragma unroll
          for (int s = 0; s < 2; ++s) { v4u pw; pw.x = cvtpk(S[c][8 * s], S[c][8 * s + 1]); pw.y = cvtpk(S[c][8 * s + 2], S[c][8 * s + 3]); pw.z = cvtpk(S[c][8 * s + 4], S[c][8 * s + 5]); pw.w = cvtpk(S[c][8 * s + 6], S[c][8 * s + 7]);
              const bf16x8 pk = __builtin_bit_cast(bf16x8, pw);
#pragma unroll
              for (int db = 0; db < 2; ++db) { const s16x4 lo = vtr(vb + (c * 32 + 16 * s) * VP + db * 64), h4 = vtr(vb + (c * 32 + 16 * s + 8) * VP + db * 64);
                  const bf16x8 vf = (bf16x8){lo[0], lo[1], lo[2], lo[3], h4[0], h4[1], h4[2], h4[3]};
                  O[db] = __builtin_amdgcn_mfma_f32_32x32x16_bf16(vf, pk, O[db], 0, 0, 0); } } }
    const float rl = 1.0f / l;
    const int p = p0 + wid * 32 + r32, bb = p >> 13, pp = p & 8191, rr = pp >> (13 - sh), ii = pp & Lm1; const int tok = (bb << 13) + (ii << sh) + rr;
    bf16* orow = og + gofs + (size_t)tok * 512 + h * 64 + 4 * hi;
#pragma unroll
    for (int db = 0; db < 2; ++db)
#pragma unroll
        for (int k4 = 0; k4 < 4; ++k4) { v2u w; w.x = cvtpk(O[db][4 * k4] * rl, O[db][4 * k4 + 1] * rl); w.y = cvtpk(O[db][4 * k4 + 2] * rl, O[db][4 * k4 + 3] * rl);
            *(v2u*)(orow + 32 * db + 8 * k4) = w; }
    if (hi == 0) lse[(size_t)g * ((size_t)M * 8) + (size_t)tok * 8 + h] = mx + __builtin_amdgcn_logf(l);
    __syncthreads();
}
}
namespace attn_b2 {
constexpr int KBUF = 8192, VBUF = 16384, NKS = 4, NVS = 5, L_K = 0, L_V = NKS * KBUF, L_END = NKS * KBUF + NVS * VBUF;
typedef __attribute__((address_space(3))) const char* lds_cptr;
using attn_a::vtr; using attn_a::cvtpk;
__device__ __forceinline__ void glds16(const void* gsrc, unsigned lds_dst) { unsigned keep;
    asm volatile("s_mov_b32 %0, m0\n\ts_mov_b32 m0, %2\n\ts_nop 0\n\tglobal_load_lds_dwordx4 %1, off\n\ts_mov_b32 m0, %0" : "=&s"(keep) : "v"(gsrc), "s"(lds_dst) : "memory"); }
template <int THR> __device__ __forceinline__ void unit(int qb, const bf16* Q, const bf16* K, const bf16* V, bf16* O, attn_body::lds_fptr tab, LAS unsigned char* lds) {
    const int tid = threadIdx.x, lane = tid & 63, r32 = lane & 31, hi = lane >> 5; const int wid = __builtin_amdgcn_readfirstlane(tid >> 6);
    const int q0 = qb * 256, NT = 4 * qb + 4, qrel = wid * 32 + r32;
    const unsigned lds0 = (unsigned)(uintptr_t)lds;
    const int krow = 8 * wid + (lane >> 3), kc = (lane & 7) ^ ((krow >> 1) & 7);
    const bf16* ksrc = K + krow * 64 + kc * 8;
    const int vrow0 = 8 * wid + (lane >> 4), vrow1 = vrow0 + 4, vc0 = (lane & 15) ^ ((vrow0 & 3) << 2), vc1 = (lane & 15) ^ ((vrow1 & 3) << 2);
    const bf16* vsrc0 = V + vrow0 * 128 + vc0 * 8; const bf16* vsrc1 = V + vrow1 * 128 + vc1 * 8;
    const unsigned kdst = lds0 + L_K + wid * 1024, vdst = lds0 + L_V + wid * 2048;
#define B2_DMA(tile, ks, vs) do { const int tt_ = (tile) < NT ? (tile) : NT - 1; \
        glds16(ksrc + (size_t)tt_ * 4096, (unsigned)__builtin_amdgcn_readfirstlane(kdst + (ks) * KBUF)); \
        glds16(vsrc0 + (size_t)tt_ * 8192, (unsigned)__builtin_amdgcn_readfirstlane(vdst + (vs) * VBUF)); \
        glds16(vsrc1 + (size_t)tt_ * 8192, (unsigned)__builtin_amdgcn_readfirstlane(vdst + (vs) * VBUF + 1024)); } while (0)
#define B2_WAITBAR(n) asm volatile("s_waitcnt vmcnt(" #n ") lgkmcnt(0)\n\ts_barrier" ::: "memory")
    B2_DMA(0, 0, 0); B2_DMA(1, 1, 1); B2_DMA(2, 2, 2);
    bf16x8 qr[4];
    { const bf16* qrow = Q + (size_t)(q0 + qrel) * 64 + hi * 8;
#pragma unroll
      for (int d0 = 0; d0 < 4; ++d0) qr[d0] = *(const bf16x8*)(qrow + d0 * 16); }
    asm volatile("s_waitcnt vmcnt(0)" ::: "memory");
    B2_WAITBAR(0);
    float m = 0.f, l = 0.f;
    f32x16 negm = f32x16{};
    f32x16 Oa[4]; Oa[0] = f32x16{}; Oa[1] = f32x16{}; Oa[2] = f32x16{}; Oa[3] = f32x16{};
    bf16x8 pk[4];
    const int sw = (r32 >> 1) & 7;
    int aK[4];
#pragma unroll
    for (int d0 = 0; d0 < 4; ++d0) aK[d0] = L_K + r32 * 128 + (((2 * d0 + hi) ^ sw) << 4);
    const int q4 = (lane & 15) >> 2, blk = (lane >> 4) & 1, p = lane & 3;
    int aV[4];
#pragma unroll
    for (int db = 0; db < 4; ++db) aV[db] = L_V + (4 * hi + q4) * 256 + ((((db ^ q4) << 2) + blk * 2 + (p >> 1)) << 4) + (p & 1) * 8;
    const lds_cptr L3 = (lds_cptr)lds;
    int ks = 0, vs = 0;
#define B2_PV(vslot) do { const int vo_ = (vslot) * VBUF; \
_Pragma("unroll") \
        for (int s = 0; s < 4; ++s) \
_Pragma("unroll") \
            for (int db = 0; db < 4; ++db) { const s16x4 lo = vtr(L3 + aV[db] + vo_ + s * 4096), h4 = vtr(L3 + aV[db] + vo_ + s * 4096 + 2048); \
                const bf16x8 vf = (bf16x8){lo[0], lo[1], lo[2], lo[3], h4[0], h4[1], h4[2], h4[3]}; \
                Oa[db] = __builtin_amdgcn_mfma_f32_32x32x16_bf16(vf, pk[s], Oa[db], 0, 0, 0); } } while (0)
#define MX3(a, b, c) __builtin_fmaxf(__builtin_fmaxf((a), (b)), (c))
#define B2_STEP(t, HASPREV) do { \
        { const int k3 = (ks + 3) & 3; int v3 = vs + 3; v3 = v3 >= NVS ? v3 - NVS : v3; B2_DMA((t) + 3, k3, v3); } \
        f32x16 p0 = negm, p1 = negm; \
_Pragma("unroll") \
        for (int d0 = 0; d0 < 4; ++d0) { const bf16x8 kf0 = *(const LAS bf16x8*)(lds + aK[d0] + ks * KBUF), kf1 = *(const LAS bf16x8*)(lds + aK[d0] + ks * KBUF + 4096); \
            p0 = __builtin_amdgcn_mfma_f32_32x32x16_bf16(kf0, qr[d0], p0, 0, 0, 0); p1 = __builtin_amdgcn_mfma_f32_32x32x16_bf16(kf1, qr[d0], p1, 0, 0, 0); } \
        if ((t) >= NT - 6) attn_body::bmask(p0, p1, (t) - (NT - 4), qrel, hi, tab); \
        float ra = MX3(p0[0], p0[1], p1[0]), rb = MX3(p0[2], p0[3], p1[1]); ra = MX3(ra, p1[2], p1[3]); \
_Pragma("unroll") \
        for (int i = 4; i < 16; i += 4) { ra = MX3(ra, p0[i], p0[i + 1]); rb = MX3(rb, p0[i + 2], p0[i + 3]); ra = MX3(ra, p1[i], p1[i + 1]); rb = MX3(rb, p1[i + 2], p1[i + 3]); } \
        float rm = fmaxf(ra, rb); rm = fmaxf(rm, __shfl_xor(rm, 32)); \
        const bool resc = !(HASPREV) || __any(rm > (float)THR); \
        float al = 1.f; \
        if (resc) { const float dl = (HASPREV) ? fmaxf(rm, 0.f) : rm; m += dl; if (HASPREV) { al = __builtin_amdgcn_exp2f(-dl); l *= al; } \
_Pragma("unroll") \
            for (int i = 0; i < 16; ++i) { p0[i] -= dl; p1[i] -= dl; negm[i] = -m; } } \
        float sum = 0.f; \
_Pragma("unroll") \
        for (int i = 0; i < 16; ++i) { p0[i] = __builtin_amdgcn_exp2f(p0[i]); p1[i] = __builtin_amdgcn_exp2f(p1[i]); sum += p0[i] + p1[i]; } \
        l += sum; \
        if (HASPREV) { const int vp_ = vs == 0 ? NVS - 1 : vs - 1; B2_PV(vp_); } \
        if (resc) { \
_Pragma("unroll") \
            for (int db = 0; db < 4; ++db) \
_Pragma("unroll") \
                for (int i = 0; i < 16; ++i) Oa[db][i] *= al; } \
_Pragma("unroll") \
        for (int s = 0; s < 2; ++s) { v4u w0, w1; \
            w0.x = cvtpk(p0[8 * s], p0[8 * s + 1]); w0.y = cvtpk(p0[8 * s + 2], p0[8 * s + 3]); w0.z = cvtpk(p0[8 * s + 4], p0[8 * s + 5]); w0.w = cvtpk(p0[8 * s + 6], p0[8 * s + 7]); \
            w1.x = cvtpk(p1[8 * s], p1[8 * s + 1]); w1.y = cvtpk(p1[8 * s + 2], p1[8 * s + 3]); w1.z = cvtpk(p1[8 * s + 4], p1[8 * s + 5]); w1.w = cvtpk(p1[8 * s + 6], p1[8 * s + 7]); \
            pk[s] = __builtin_bit_cast(bf16x8, w0); pk[2 + s] = __builtin_bit_cast(bf16x8, w1); } \
        ks = (ks + 1) & 3; vs = vs + 1 == NVS ? 0 : vs + 1; \
        B2_WAITBAR(6); \
    } while (0)
    B2_STEP(0, false);
    for (int t = 1; t < NT; ++t) B2_STEP(t, true);
    { const int vp_ = vs == 0 ? NVS - 1 : vs - 1; B2_PV(vp_); }
#undef B2_STEP
#undef MX3
#undef B2_PV
#undef B2_DMA
    l += __shfl_xor(l, 32);
    const float rl = 1.0f / l;
    bf16* orow = O + (size_t)(q0 + qrel) * 1024 + 4 * hi;
#pragma unroll
    for (int db = 0; db < 4; ++db)
#pragma unroll
        for (int k4 = 0; k4 < 4; ++k4) { v2u w; w.x = cvtpk(Oa[db][4 * k4] * rl, Oa[db][4 * k4 + 1] * rl); w.y = cvtpk(Oa[db][4 * k4 + 2] * rl, Oa[db][4 * k4 + 3] * rl);
            *(v2u*)(orow + 32 * db + 8 * k4) = w; }
    B2_WAITBAR(0);
#undef B2_WAITBAR
}
}

#define XB_TMO      128
#define XB_XCNT(j)  (256  + 64 * (j))
#define XB_XSUB(j)  (1280 + 64 * (j))
#define XB_XGEN(j)  (2304 + 64 * (j))
#define XB_TOP      3328
#define XB_TOPGEN   3392
#define XCD_BAR_WORDS 3456
#define XB_SPIN_CAP (1u << 18)

__device__ __forceinline__ unsigned xb_ld(unsigned* p)              { return __hip_atomic_load(p, __ATOMIC_RELAXED, __HIP_MEMORY_SCOPE_AGENT); }
__device__ __forceinline__ unsigned xb_add(unsigned* p, unsigned v) { return __hip_atomic_fetch_add(p, v, __ATOMIC_RELAXED, __HIP_MEMORY_SCOPE_AGENT); }
__device__ __forceinline__ unsigned xb_xcc_id() { return (unsigned)__builtin_amdgcn_s_getreg((3 << 11) | 20) & 0xFu; }
#define XB_SPIN(cond, bar) do { unsigned _sp = 0; while (cond) { __builtin_amdgcn_s_sleep(1); \
    if ((++_sp & 255u) == 0u) { if (xb_ld(&(bar)[XB_TMO])) break; if (_sp > XB_SPIN_CAP) { atomicAdd(&(bar)[XB_TMO], 1u); break; } } } } while (0)

struct XcdBarrier {
    unsigned* bar; unsigned x;
    volatile LAS unsigned* st;
};

__device__ __forceinline__ XcdBarrier xcd_barrier_post(unsigned* bar, volatile LAS unsigned* st) {
    XcdBarrier b; b.bar = bar; b.x = xb_xcc_id(); b.st = st;
    if (threadIdx.x == 0) (void)xb_add(&bar[XB_XCNT(b.x)], 1u);
    return b;
}
__device__ __forceinline__ void xcd_barrier_complete(unsigned* bar, unsigned x, unsigned& nloc, unsigned& nx) {
    const unsigned G = gridDim.x * gridDim.y * gridDim.z;
    unsigned sum, cnt, mine, sp = 0u;
    for (;;) {
        sum = 0u; cnt = 0u; mine = 0u;
#pragma unroll
        for (unsigned j = 0; j < 16; ++j) { const unsigned c = xb_ld(&bar[XB_XCNT(j)]); sum += c; cnt += (c > 0u) ? 1u : 0u; mine = (j == x) ? c : mine; }
        if (sum == G) break;
        __builtin_amdgcn_s_sleep(1);
        if ((++sp & 255u) == 0u) { if (xb_ld(&bar[XB_TMO])) break; if (sp > XB_SPIN_CAP) { atomicAdd(&bar[XB_TMO], 1u); break; } }
    }
    nloc = mine > 0u ? mine : 1u; nx = cnt > 0u ? cnt : 1u;
}

__device__ __forceinline__ void xcd_barrier(const XcdBarrier& b) {
    asm volatile("s_waitcnt vmcnt(0)" ::: "memory");
    __syncthreads();
    if (threadIdx.x == 0) {
        unsigned* bar = b.bar;
        __builtin_amdgcn_s_waitcnt(0);
        unsigned nloc = b.st[0], nx = b.st[1];
        if (nloc == 0u) { xcd_barrier_complete(bar, b.x, nloc, nx); b.st[0] = nloc; b.st[1] = nx; }
        const unsigned old = xb_add(&bar[XB_XSUB(b.x)], 1u);
        const unsigned gen = old / nloc;
        if (old + 1u == (gen + 1u) * nloc) {
            __builtin_amdgcn_fence(__ATOMIC_RELEASE, "agent");
            asm volatile("s_waitcnt vmcnt(0)" ::: "memory");
            const unsigned og = xb_add(&bar[XB_TOP], 1u);
            const unsigned tg = og / nx;
            if (og + 1u == (tg + 1u) * nx) xb_add(&bar[XB_TOPGEN], 1u);
            else XB_SPIN(xb_ld(&bar[XB_TOPGEN]) == tg, bar);
            __builtin_amdgcn_fence(__ATOMIC_ACQUIRE, "agent");
            xb_add(&bar[XB_XGEN(b.x)], 1u);
            asm volatile("s_waitcnt vmcnt(0)" ::: "memory");
        } else {
            XB_SPIN(xb_ld(&bar[XB_XGEN(b.x)]) == gen, bar);
            __builtin_amdgcn_fence(__ATOMIC_ACQUIRE, "agent");
            asm volatile("s_waitcnt vmcnt(0)" ::: "memory");
        }
    }
    __syncthreads();
}

constexpr int NPHASE = 12;
#ifndef MK_N_LAUNCHES
#define MK_N_LAUNCHES 1
#endif
struct Args { const float* in[18]; float* out; unsigned char* ws; int ph_lo, ph_hi; };
__device__ __forceinline__ void ln_rows(const float* zin, float* fout, bf16* bout, const float* gam, const float* bet, int gw, int ngw, int lane) {
    f32x4 gv[4], bv[4];
#pragma unroll
    for (int j = 0; j < 4; ++j) { gv[j] = *(const f32x4*)(gam + 4 * (64 * j + lane)); bv[j] = *(const f32x4*)(bet + 4 * (64 * j + lane)); }
    for (int m0 = gw; m0 < M; m0 += 2 * ngw) {
        f32x4 v[2][4]; float s1[2] = {0.f, 0.f};
#pragma unroll
        for (int r = 0; r < 2; ++r) { const f32x4* xr = (const f32x4*)(zin + (size_t)(m0 + r * ngw) * 1024) + lane;
#pragma unroll
            for (int j = 0; j < 4; ++j) v[r][j] = xr[64 * j]; }
#pragma unroll
        for (int r = 0; r < 2; ++r)
#pragma unroll
            for (int j = 0; j < 4; ++j) s1[r] += (v[r][j].x + v[r][j].y) + (v[r][j].z + v[r][j].w);
        float rstd[2];
#pragma unroll
        for (int r = 0; r < 2; ++r) { const float mean = wave_sum(s1[r]) * (1.f / 1024.f); float s2 = 0.f;
#pragma unroll
            for (int j = 0; j < 4; ++j) { v[r][j] = v[r][j] - mean; s2 += (v[r][j].x * v[r][j].x + v[r][j].y * v[r][j].y) + (v[r][j].z * v[r][j].z + v[r][j].w * v[r][j].w); }
            rstd[r] = 1.f / sqrtf(wave_sum(s2) * (1.f / 1024.f) + LN_EPS); }
#pragma unroll
        for (int r = 0; r < 2; ++r) { const size_t m = (size_t)(m0 + r * ngw); f32x4* fo = (f32x4*)(fout + m * 1024) + lane;
#pragma unroll
            for (int j = 0; j < 4; ++j) { v[r][j] = v[r][j] * rstd[r] * gv[j] + bv[j]; fo[64 * j] = v[r][j]; }
            if (bout) { v2u* bo = (v2u*)(bout + m * 1024) + lane;
#pragma unroll
                for (int j = 0; j < 4; ++j) { v2u w; w.x = pk2(v[r][j].x, v[r][j].y); w.y = pk2(v[r][j].z, v[r][j].w); bo[64 * j] = w; } } }
    }
}

__global__ void __launch_bounds__(512, 2) fwd_mega(Args args) {
    extern __shared__ __attribute__((aligned(16))) unsigned char lds[];
    cg::grid_group grid = cg::this_grid();
    LAS unsigned char* L = (LAS unsigned char*)lds;
    volatile LAS unsigned* bst = (volatile LAS unsigned*)(L + LDS_BYTES - 16);
    if (threadIdx.x < 2) bst[threadIdx.x] = 0u;
    __syncthreads();
    const XcdBarrier xbar = xcd_barrier_post((unsigned*)(args.ws + WS_CTL), bst);
#define TIDS const int tid = threadIdx.x, lane = tid & 63, wave = __builtin_amdgcn_readfirstlane(tid >> 6); (void)tid; (void)lane; (void)wave
#define GRIDV const int G = gridDim.x, bx = blockIdx.x, vcu = (bx & 7) * (G >> 3) + (bx >> 3); (void)vcu
#define WSP(name, off) bf16* name = (bf16*)(args.ws + (off))
#define IN(k) (args.ph_lo <= (k) && (k) < args.ph_hi)
#define SEAM(k) do { if (IN(k) && IN((k) + 1)) { if ((k) == 0) { asm volatile("s_waitcnt vmcnt(0) lgkmcnt(0)" ::: "memory"); grid.sync(); __builtin_amdgcn_fence(__ATOMIC_ACQUIRE, "agent"); asm volatile("s_waitcnt vmcnt(0)" ::: "memory"); } else xcd_barrier(xbar); } } while (0)

    if (IN(0)) {
        TIDS; GRIDV; const int gw = vcu * 8 + wave, ngw = G * 8; const float* x = args.in[0];
        WSP(WinT, WS_WIN); WSP(WpaT, WS_WPA); WSP(WpbT, WS_WPB); WSP(WoT, WS_WO); WSP(W1T, WS_W1); WSP(W2T, WS_W2); WSP(XB, WS_XB);
        LAS float* scr = (LAS float*)(L + wave * 16384);
        constexpr int I_IN = 16 * 304, I_PA = 8 * 32, I_PB = 16 * 32, I_O = 16 * 32, I_1 = 16 * 128, I_2 = 64 * 32;
        constexpr int NITEMS = I_IN + I_PA + I_PB + I_O + I_1 + I_2;
        for (int it = gw; it < NITEMS; it += ngw) {
            int r = it;
            if (r < I_IN) { p0_transpose_item(args.in[1], 1024, 9728, WinT, scr, r, lane); continue; } r -= I_IN;
            if (r < I_PA) { p0_transpose_item(args.in[9], 512, 1024, WpaT, scr, r, lane); continue; } r -= I_PA;
            if (r < I_PB) { p0_transpose_item(args.in[10], 1024, 1024, WpbT, scr, r, lane); continue; } r -= I_PB;
            if (r < I_O) { p0_transpose_item(args.in[11], 1024, 1024, WoT, scr, r, lane); continue; } r -= I_O;
            if (r < I_1) { p0_transpose_item(args.in[16], 1024, 4096, W1T, scr, r, lane); continue; } r -= I_1;
            p0_transpose_item(args.in[17], 4096, 1024, W2T, scr, r, lane);
        }
        for (int m = gw; m < M; m += ngw) {
            const f32x4* xr = (const f32x4*)(x + (size_t)m * 1024) + lane; v2u* bo = (v2u*)(XB + (size_t)m * 1024) + lane;
#pragma unroll
            for (int j = 0; j < 4; ++j) { const f32x4 v = xr[64 * j]; v2u w; w.x = pk2(v.x, v.y); w.y = pk2(v.z, v.w); bo[64 * j] = w; }
        }
    }
    SEAM(0);
    if (IN(1)) {
        GRIDV; WSP(XB, WS_XB); WSP(WinT, WS_WIN); WSP(QA, WS_R1);
        pg8::Gemm g{XB, WinT, M, COLS_A, 1024}; pg8::StaticOrder S; S.init(M, COLS_A, G, bx);
        pg8::EpiA E{QA};
        pg8::gemm_phase<pg8::EpiA, pg8::StaticOrder, true, true>(L, g, S, E);
    }
    SEAM(1);
    if (IN(2)) {
        GRIDV; WSP(QA, WS_R1); WSP(OG, WS_OG); float* LSE = (float*)(args.ws + WS_LSE);
        const bf16* KA = QA + (size_t)3 * M * 512; const bf16* VA = KA + (size_t)3 * M * 512;
        for (int u = vcu; u < 3072; u += G) attn_a::unit(u >> 10, (u >> 7) & 7, u & 127, QA, KA, VA, OG, LSE, args.in[8], L);
    }
    SEAM(2);
    if (IN(3)) {
        { TIDS; GRIDV; const int gw = vcu * 8 + wave, ngw = G * 8; WSP(OG, WS_OG); const float* LSE = (const float*)(args.ws + WS_LSE); WSP(OA, WS_OA);
          for (int m = gw; m < M; m += ngw) {
            { const int hh = lane >> 3; float l0 = LSE[(size_t)m * 8 + hh], l1 = LSE[(size_t)M * 8 + (size_t)m * 8 + hh], l2 = LSE[(size_t)2 * M * 8 + (size_t)m * 8 + hh];
              const float mx = fmaxf(l0, fmaxf(l1, l2)); float w0 = exp2f(l0 - mx), w1 = exp2f(l1 - mx), w2 = exp2f(l2 - mx); const float rs = 1.f / (w0 + w1 + w2); w0 *= rs; w1 *= rs; w2 *= rs;
              const v4u a = *(const v4u*)(OG + (size_t)m * 512 + lane * 8), b = *(const v4u*)(OG + (size_t)M * 512 + (size_t)m * 512 + lane * 8), c = *(const v4u*)(OG + (size_t)2 * M * 512 + (size_t)m * 512 + lane * 8);
              v4u o;
              o.x = pk2(w0 * blo(a.x) + w1 * blo(b.x) + w2 * blo(c.x), w0 * bhi(a.x) + w1 * bhi(b.x) + w2 * bhi(c.x));
              o.y = pk2(w0 * blo(a.y) + w1 * blo(b.y) + w2 * blo(c.y), w0 * bhi(a.y) + w1 * bhi(b.y) + w2 * bhi(c.y));
              o.z = pk2(w0 * blo(a.z) + w1 * blo(b.z) + w2 * blo(c.z), w0 * bhi(a.z) + w1 * bhi(b.z) + w2 * bhi(c.z));
              o.w = pk2(w0 * blo(a.w) + w1 * blo(b.w) + w2 * blo(c.w), w0 * bhi(a.w) + w1 * bhi(b.w) + w2 * bhi(c.w));
              *(v4u*)(OA + (size_t)m * 512 + lane * 8) = o; }
          } }
        GRIDV; WSP(XB, WS_XB); WSP(WinT, WS_WIN); WSP(QB, WS_QB);
        pg8::Gemm g{XB, WinT + (size_t)COLS_A * 1024, M, 3072, 1024}; pg8::StaticOrder S; S.init(M, 3072, G, bx);
        pg8::EpiB E{QB};
        pg8::gemm_phase<pg8::EpiB, pg8::StaticOrder, true, true>(L, g, S, E);
    }
    SEAM(3);
    if (IN(4)) {
        TIDS; GRIDV; WSP(QB, WS_QB); WSP(O1, WS_O1); WSP(O2, WS_O2);
        LAS float* btab = (LAS float*)(L + 116736);
        const float* rb = args.in[8];
        for (int i = tid; i < 8 * 640; i += 512) { const int hh = i / 640, d = i - hh * 640 - 255;
            btab[i] = d < 0 ? -INFINITY : (d < 128 ? (rb[t5_bucket(d) * 32 + 24 + hh] - rb[31 * 32 + 24 + hh]) * LOG2E : 0.f); }
        __syncthreads();
        const bf16* KB = QB + (size_t)M * 1024; const bf16* VB = KB + (size_t)M * 1024;
        for (int i = 0; i < 8; ++i) {
            const int sq = (vcu >> 3) * 2 + (i >> 2), k = i & 3, s = vcu & 7;
            const int qb = (k == 0) ? s : (k == 1) ? 15 - s : (k == 2) ? 16 + s : 31 - s;
            const int mp = sq & 1, hh = (sq >> 1) & 7, bb = sq >> 4;
            const size_t rb0 = (size_t)bb * SEQ * 1024;
            const size_t qk0 = (size_t)((bb * 16 + mp * 8 + hh) * SEQ) * 64, v0 = (size_t)((bb * 8 + hh) * SEQ) * 128;
            attn_b2::unit<8>(qb, QB + qk0, KB + qk0, VB + v0, (mp ? O2 : O1) + rb0 + hh * 128, (attn_body::lds_fptr)(btab + hh * 640), L);
        }
    }
    SEAM(4);
    if (IN(5)) {
        { TIDS; GRIDV; const int gw = vcu * 8 + wave, ngw = G * 8; WSP(O1, WS_O1); WSP(O2, WS_O2); WSP(OB, WS_OB);
          const float d1 = wave_sum(args.in[3][lane] * args.in[4][lane]), d2 = wave_sum(args.in[5][lane] * args.in[6][lane]);
          const float lam = expf(d1) - expf(d2) + 0.2f;
          const float* sg = args.in[7] + (lane & 7) * 16;
          float gsc[16];
#pragma unroll
          for (int e = 0; e < 16; ++e) gsc[e] = sg[e] * 0.8f;
          for (int m = gw; m < M; m += ngw) {
            { const v4u a0 = *(const v4u*)(O1 + (size_t)m * 1024 + lane * 16), a1 = *(const v4u*)(O1 + (size_t)m * 1024 + lane * 16 + 8);
              const v4u b0 = *(const v4u*)(O2 + (size_t)m * 1024 + lane * 16), b1 = *(const v4u*)(O2 + (size_t)m * 1024 + lane * 16 + 8);
              float d[16];
              d[0] = blo(a0.x) - lam * blo(b0.x); d[1] = bhi(a0.x) - lam * bhi(b0.x); d[2] = blo(a0.y) - lam * blo(b0.y); d[3] = bhi(a0.y) - lam * bhi(b0.y);
              d[4] = blo(a0.z) - lam * blo(b0.z); d[5] = bhi(a0.z) - lam * bhi(b0.z); d[6] = blo(a0.w) - lam * blo(b0.w); d[7] = bhi(a0.w) - lam * bhi(b0.w);
              d[8] = blo(a1.x) - lam * blo(b1.x); d[9] = bhi(a1.x) - lam * bhi(b1.x); d[10] = blo(a1.y) - lam * blo(b1.y); d[11] = bhi(a1.y) - lam * bhi(b1.y);
              d[12] = blo(a1.z) - lam * blo(b1.z); d[13] = bhi(a1.z) - lam * bhi(b1.z); d[14] = blo(a1.w) - lam * blo(b1.w); d[15] = bhi(a1.w) - lam * bhi(b1.w);
              float ss = 0.f;
#pragma unroll
              for (int e = 0; e < 16; ++e) ss += d[e] * d[e];
              ss += __shfl_xor(ss, 1); ss += __shfl_xor(ss, 2); ss += __shfl_xor(ss, 4);
              const float rn = 1.f / sqrtf(ss * (1.f / 128.f) + LN_EPS);
              v4u o0, o1;
              o0.x = pk2(d[0] * rn * gsc[0], d[1] * rn * gsc[1]); o0.y = pk2(d[2] * rn * gsc[2], d[3] * rn * gsc[3]); o0.z = pk2(d[4] * rn * gsc[4], d[5] * rn * gsc[5]); o0.w = pk2(d[6] * rn * gsc[6], d[7] * rn * gsc[7]);
              o1.x = pk2(d[8] * rn * gsc[8], d[9] * rn * gsc[9]); o1.y = pk2(d[10] * rn * gsc[10], d[11] * rn * gsc[11]); o1.z = pk2(d[12] * rn * gsc[12], d[13] * rn * gsc[13]); o1.w = pk2(d[14] * rn * gsc[14], d[15] * rn * gsc[15]);
              *(v4u*)(OB + (size_t)m * 1024 + lane * 16) = o0; *(v4u*)(OB + (size_t)m * 1024 + lane * 16 + 8) = o1; }
          } }
        GRIDV; WSP(XB, WS_XB); WSP(WinT, WS_WIN); WSP(GATES, WS_GATES);
        pg8::Gemm g{XB, WinT + (size_t)7680 * 1024, M, 2048, 1024}; pg8::StaticOrder S; S.init(M, 2048, G, bx);
        pg8::EpiSig E{GATES, args.in[2]};
        pg8::gemm_phase<pg8::EpiSig, pg8::StaticOrder, true, true>(L, g, S, E);
    }
    SEAM(5);
    if (IN(6)) {
        GRIDV; WSP(OA, WS_OA); WSP(OB, WS_OB); WSP(WpaT, WS_WPA); WSP(WpbT, WS_WPB); WSP(TMP, WS_TMP); WSP(MERGED, WS_MERGED); WSP(GATES, WS_GATES);
        { pg8::Gemm g{OA, WpaT, M, 1024, 512}; pg8::StaticOrder S; S.init(M, 1024, G, bx);
          pg8::EpiGate<false> E{GATES, nullptr, TMP};
          pg8::gemm_phase<pg8::EpiGate<false>, pg8::StaticOrder, true, true>(L, g, S, E); }
        { pg8::Gemm g{OB, WpbT, M, 1024, 1024}; pg8::StaticOrder S; S.init(M, 1024, G, bx);
          pg8::EpiGate<true> E{GATES + 1024, TMP, MERGED};
          pg8::gemm_phase<pg8::EpiGate<true>, pg8::StaticOrder, true, true>(L, g, S, E); }
    }
    SEAM(6);
    if (IN(7)) {
        GRIDV; WSP(MERGED, WS_MERGED); WSP(WoT, WS_WO); const float* x = args.in[0]; float* Z = (float*)(args.ws + WS_Z);
        pg8::Gemm g{MERGED, WoT, M, 1024, 1024}; pg8::StaticOrder S; S.init(M, 1024, G, bx);
        pg8::EpiZ E{x, Z, DN_ALPHA};
        pg8::gemm_phase<pg8::EpiZ, pg8::StaticOrder, true, true>(L, g, S, E);
    }
    SEAM(7);
    if (IN(8)) { TIDS; GRIDV; WSP(X1B, WS_X1B); float* Z = (float*)(args.ws + WS_Z); ln_rows(Z, Z, X1B, args.in[12], args.in[13], vcu * 8 + wave, G * 8, lane); }
    SEAM(8);
    if (IN(9)) {
        GRIDV; WSP(X1B, WS_X1B); WSP(W1T, WS_W1); WSP(HB, WS_H);
        pg8::Gemm g{X1B, W1T, M, FF, 1024}; pg8::StaticOrder S; S.init(M, FF, G, bx);
        pg8::EpiRelu2 E{HB};
        pg8::gemm_phase<pg8::EpiRelu2, pg8::StaticOrder, true, true>(L, g, S, E);
    }
    SEAM(9);
    if (IN(10)) {
        GRIDV; WSP(HB, WS_H); WSP(W2T, WS_W2);
        pg8::Gemm g{HB, W2T, M, 1024, FF}; pg8::StaticOrder S; S.init(M, 1024, G, bx);
        float* Z = (float*)(args.ws + WS_Z); pg8::EpiZ E{Z, Z, DN_ALPHA};
        pg8::gemm_phase<pg8::EpiZ, pg8::StaticOrder, true, true>(L, g, S, E);
    }
    SEAM(10);
    if (IN(11)) { TIDS; GRIDV; const float* Z = (const float*)(args.ws + WS_Z); ln_rows(Z, args.out, nullptr, args.in[14], args.in[15], vcu * 8 + wave, G * 8, lane); }
#undef IN
#undef SEAM
}

extern "C" void kernel_launch(void* const* d_in, const int* in_sizes, int n_in, void* d_out, int out_size, void* d_ws, size_t ws_size, hipStream_t stream) {
    static int grid = 0;
    if (grid == 0) {
        if (n_in != 18 || in_sizes[0] != M * DMODEL || out_size != M * DMODEL || ws_size < WS_END) { fprintf(stderr, "kernel_launch: unexpected shapes (n_in %d, x %d, out %d, ws %zu)\n", n_in, n_in > 0 ? in_sizes[0] : -1, out_size, ws_size); grid = -1; return; }
        int dev = 0, cus = 0, per_cu = 0;
        hipGetDevice(&dev); hipDeviceGetAttribute(&cus, hipDeviceAttributeMultiprocessorCount, dev);
        if (hipFuncSetAttribute((const void*)fwd_mega, hipFuncAttributeMaxDynamicSharedMemorySize, LDS_BYTES) != hipSuccess) { fprintf(stderr, "kernel_launch: hipFuncSetAttribute failed\n"); grid = -1; return; }
        if (hipOccupancyMaxActiveBlocksPerMultiprocessor(&per_cu, (const void*)fwd_mega, 512, LDS_BYTES) != hipSuccess || per_cu < 1) { fprintf(stderr, "kernel_launch: occupancy query says %d\n", per_cu); per_cu = 1; }
        (void)hipGetLastError();
        grid = cus * 1;
    }
    if (grid < 0) return;
    if (hipMemsetAsync((char*)d_ws + WS_CTL, 0, CTL_BYTES, stream) != hipSuccess) { fprintf(stderr, "kernel_launch: memset of the barrier words failed\n"); return; }
    Args a{};
    for (int i = 0; i < 18; ++i) a.in[i] = (const float*)d_in[i];
    a.out = (float*)d_out; a.ws = (unsigned char*)d_ws;
    constexpr int NL = MK_N_LAUNCHES;
    for (int li = 0; li < NL; ++li) {
        a.ph_lo = (NL == 1) ? 0 : li; a.ph_hi = (NL == 1) ? NPHASE : li + 1;
        void* kargs[] = {&a};
        const hipError_t e = hipLaunchCooperativeKernel((const void*)fwd_mega, dim3(grid), dim3(512), kargs, LDS_BYTES, stream);
        if (e != hipSuccess) { fprintf(stderr, "kernel_launch: cooperative launch %d failed: %s (grid %d)\n", li, hipGetErrorString(e), grid); break; }
    }
}
```

```cpp
#include <hip/hip_runtime.h>
#include <hip/hip_cooperative_groups.h>
#include <cstdio>
#include <cstdint>
namespace cg = cooperative_groups;
namespace pg8 {
#define PG8_LAS __attribute__((address_space(3)))
typedef unsigned short bf16_t;
typedef short bf16x8 __attribute__((ext_vector_type(8)));
typedef float f32x4 __attribute__((ext_vector_type(4)));
typedef unsigned u32x4 __attribute__((ext_vector_type(4)));
constexpr int BM = 256, BK = 64, HALF = 128, HTB = HALF * BK * 2  , STAGE_BYTES = 8 * HTB, NXCD = 8, WGM = 8;

__host__ __device__ __forceinline__ int lds_byte(int r, int c) { const int st = (r >> 4) * 2 + (c >> 5), rr = r & 15, cc = c & 31, ob = rr * 64 + cc * 2; return st * 1024 + (ob ^ (((ob >> 9) & 1) << 5)); }
__host__ __device__ __forceinline__ void stage_rc(int b, int& R, int& C) { const int st = b / 1024, sb = b % 1024, swz = sb ^ (((sb >> 9) & 1) << 5); R = (st >> 1) * 16 + swz / 64; C = (st & 1) * 32 + (swz % 64) / 2; }
__host__ __device__ __forceinline__ int perm32(int rho) { const int n = rho >> 4, i = rho & 15; return 8 * (i >> 2) + 4 * n + (i & 3); }

struct Unit { int pm, pn; };
struct Gemm { const bf16_t* A; const bf16_t* Bt; int M, N, K; };

struct StaticOrder {
    int nM, nN, nwg, G, c;
    __host__ __device__ void init(int M, int N, int G_, int c_) { nM = M / BM; nN = N / BM; nwg = nM * nN; G = G_; c = c_; }
    __host__ __device__ bool next(int i, Unit& u) const {
        const long L = (long)i * G + c; if (L >= nwg) return false;
        int wgid = (int)L; { const int q = nwg / NXCD, r = nwg % NXCD, xcd = wgid % NXCD, off = wgid / NXCD; wgid = (xcd < r ? xcd * (q + 1) : r * (q + 1) + (xcd - r) * q) + off; }
        const int nig = WGM * nN, gid = wgid / nig, fm = gid * WGM, gsz = (nM - fm) < WGM ? (nM - fm) : WGM;
        u.pm = fm + ((wgid % nig) % gsz); u.pn = (wgid % nig) / gsz; return true;
    }
    __device__ __forceinline__ void a_ready(const Unit&) const {}
    __device__ __forceinline__ void done(const Unit&) const {}
};

__device__ __forceinline__ unsigned cvt_pk_bf16(float lo, float hi) { unsigned r; asm volatile("v_cvt_pk_bf16_f32 %0, %1, %2" : "=v"(r) : "v"(lo), "v"(hi)); return r; }
typedef float f32x2 __attribute__((ext_vector_type(2)));
constexpr float QK_C2 = 0.125f * 1.4426950408889634f;
constexpr int MROWS = 32768;
__device__ __forceinline__ float bf_lo(unsigned w) { return __uint_as_float(w << 16); }
__device__ __forceinline__ float bf_hi(unsigned w) { return __uint_as_float(w & 0xffff0000u); }
typedef float f32x2c_t __attribute__((ext_vector_type(2))); typedef __bf16 bf16x2c_t __attribute__((ext_vector_type(2)));
__device__ __forceinline__ unsigned cvt_pk_bf16_c(float lo, float hi) { f32x2c_t v = {lo, hi}; bf16x2c_t b = __builtin_convertvector(v, bf16x2c_t); return __builtin_bit_cast(unsigned, b); }
__device__ __forceinline__ u32x4 pack8c(const f32x4 v0, const f32x4 v1) { u32x4 w; w.x = cvt_pk_bf16_c(v0[0], v0[1]); w.y = cvt_pk_bf16_c(v0[2], v0[3]); w.z = cvt_pk_bf16_c(v1[0], v1[1]); w.w = cvt_pk_bf16_c(v1[2], v1[3]); return w; }
__device__ __forceinline__ u32x4 pack8(const f32x4 v0, const f32x4 v1) { u32x4 w; w.x = cvt_pk_bf16(v0[0], v0[1]); w.y = cvt_pk_bf16(v0[2], v0[3]); w.z = cvt_pk_bf16(v1[0], v1[1]); w.w = cvt_pk_bf16(v1[2], v1[3]); return w; }
struct EpiA {
    static constexpr bool PERM = true, AFTER_DRAIN = false;
    bf16_t* base;
    __device__ __forceinline__ void operator()(const f32x4 (&acc)[2][2][4][2], const Unit& u, int wr, int wc, int fr, int fq) const {
        const int which = u.pn / 6, rem = u.pn - which * 6, g = rem >> 1, half = rem & 1, sh = 2 * g;
        const float sc = which == 0 ? QK_C2 : 1.f;
        bf16_t* b0 = base + (size_t)(which * 3 + g) * ((size_t)MROWS * 512) + half * 256 + wc * 32 + 8 * fq;
#pragma unroll
        for (int ai = 0; ai < 2; ++ai)
#pragma unroll
            for (int m = 0; m < 4; ++m) { const int row = u.pm * BM + ai * HALF + wr * 64 + m * 16 + fr; const int bb = row >> 13, t = row & 8191;
                const int pos = (bb << 13) + ((t & ((1 << sh) - 1)) << (13 - sh)) + (t >> sh);
                bf16_t* rowp = b0 + (size_t)pos * 512;
#pragma unroll
                for (int bj = 0; bj < 2; ++bj) *(u32x4*)(rowp + bj * HALF) = pack8(acc[ai][bj][m][0] * sc, acc[ai][bj][m][1] * sc); }
    }
};
struct EpiB {
    static constexpr bool PERM = true, AFTER_DRAIN = false;
    bf16_t* qkv;
    __device__ __forceinline__ void operator()(const f32x4 (&acc)[2][2][4][2], const Unit& u, int wr, int wc, int fr, int fq) const {
        const int row0 = u.pm * BM + wr * 64 + fr;
        const int which = u.pn >> 2; const float sc = which == 0 ? QK_C2 : 1.f;
        bf16_t* b0 = qkv + (size_t)which * ((size_t)MROWS * 1024);
        const int c0 = (u.pn & 3) * 256 + wc * 32 + 8 * fq;
#pragma unroll
        for (int ai = 0; ai < 2; ++ai)
#pragma unroll
            for (int m = 0; m < 4; ++m) { const int row = row0 + ai * HALF + m * 16, bb = row >> 13, t = row & 8191;
#pragma unroll
                for (int bj = 0; bj < 2; ++bj) { const int c = c0 + bj * HALF;
                    const size_t off = (which == 2) ? ((size_t)((bb * 8 + (c >> 7)) * 8192 + t) * 128 + (c & 127)) : ((size_t)((bb * 16 + (c >> 6)) * 8192 + t) * 64 + (c & 63));
                    *(u32x4*)(b0 + off) = pack8(acc[ai][bj][m][0] * sc, acc[ai][bj][m][1] * sc); } }
    }
};
struct EpiSig {
    static constexpr bool PERM = true, AFTER_DRAIN = false;
    bf16_t* gates; const float* bgate;
    __device__ __forceinline__ void operator()(const f32x4 (&acc)[2][2][4][2], const Unit& u, int wr, int wc, int fr, int fq) const {
        const int row0 = u.pm * BM + wr * 64 + fr;
        const int gc = u.pn * 256 + wc * 32 + 8 * fq;
        f32x4 bv[2][2];
#pragma unroll
        for (int bj = 0; bj < 2; ++bj)
#pragma unroll
            for (int n = 0; n < 2; ++n) bv[bj][n] = *(const f32x4*)(bgate + gc + bj * HALF + 4 * n);
#pragma unroll
        for (int ai = 0; ai < 2; ++ai)
#pragma unroll
            for (int m = 0; m < 4; ++m) { bf16_t* rowp = gates + (size_t)(row0 + ai * HALF + m * 16) * 2048 + gc;
#pragma unroll
                for (int bj = 0; bj < 2; ++bj) { f32x4 v[2];
#pragma unroll
                    for (int n = 0; n < 2; ++n) { const f32x4 x = acc[ai][bj][m][n] + bv[bj][n];
#pragma unroll
                        for (int e = 0; e < 4; ++e) v[n][e] = __builtin_amdgcn_rcpf(1.f + __builtin_amdgcn_exp2f(-1.4426950408889634f * x[e])); }
                    *(u32x4*)(rowp + bj * HALF) = pack8c(v[0], v[1]); } }
    }
};
template <bool ADD> struct EpiGate {
    static constexpr bool PERM = true, AFTER_DRAIN = false;
    const bf16_t* gates; const bf16_t* tin; bf16_t* out;
    __device__ __forceinline__ void operator()(const f32x4 (&acc)[2][2][4][2], const Unit& u, int wr, int wc, int fr, int fq) const {
        const int row0 = u.pm * BM + wr * 64 + fr, col0 = u.pn * BM + wc * 32 + 8 * fq;
#pragma unroll
        for (int ai = 0; ai < 2; ++ai) {
            u32x4 gw[4][2], tw[4][2];
#pragma unroll
            for (int m = 0; m < 4; ++m)
#pragma unroll
                for (int bj = 0; bj < 2; ++bj) { const size_t row = (size_t)(row0 + ai * HALF + m * 16);
                    gw[m][bj] = *(const u32x4*)(gates + row * 2048 + col0 + bj * HALF);
                    if (ADD) tw[m][bj] = *(const u32x4*)(tin + row * 1024 + col0 + bj * HALF); }
#pragma unroll
            for (int m = 0; m < 4; ++m)
#pragma unroll
                for (int bj = 0; bj < 2; ++bj) { const size_t row = (size_t)(row0 + ai * HALF + m * 16); const u32x4 g = gw[m][bj];
                    f32x4 v0 = acc[ai][bj][m][0], v1 = acc[ai][bj][m][1];
                    v0[0] *= bf_lo(g.x); v0[1] *= bf_hi(g.x); v0[2] *= bf_lo(g.y); v0[3] *= bf_hi(g.y);
                    v1[0] *= bf_lo(g.z); v1[1] *= bf_hi(g.z); v1[2] *= bf_lo(g.w); v1[3] *= bf_hi(g.w);
                    if (ADD) { const u32x4 t = tw[m][bj];
                        v0[0] += bf_lo(t.x); v0[1] += bf_hi(t.x); v0[2] += bf_lo(t.y); v0[3] += bf_hi(t.y);
                        v1[0] += bf_lo(t.z); v1[1] += bf_hi(t.z); v1[2] += bf_lo(t.w); v1[3] += bf_hi(t.w); }
                    *(u32x4*)(out + row * 1024 + col0 + bj * HALF) = pack8(v0, v1); }
        }
    }
};
struct EpiZ {
    static constexpr bool PERM = false, AFTER_DRAIN = false;
    const float* res; float* out; float alpha;
    __device__ __forceinline__ void operator()(const f32x4 (&acc)[2][2][4][2], const Unit& u, int wr, int wc, int fr, int fq) const {
        const int row0 = u.pm * BM + wr * 64 + fr, col0 = u.pn * BM + wc * 32 + 4 * fq;
#pragma unroll
        for (int ai = 0; ai < 2; ++ai) {
            f32x4 r[4][2][2];
#pragma unroll
            for (int m = 0; m < 4; ++m) { const size_t off = (size_t)(row0 + ai * HALF + m * 16) * 1024 + col0;
#pragma unroll
                for (int bj = 0; bj < 2; ++bj)
#pragma unroll
                    for (int n = 0; n < 2; ++n) r[m][bj][n] = *(const f32x4*)(res + off + bj * HALF + n * 16); }
#pragma unroll
            for (int m = 0; m < 4; ++m) { const size_t off = (size_t)(row0 + ai * HALF + m * 16) * 1024 + col0;
#pragma unroll
                for (int bj = 0; bj < 2; ++bj)
#pragma unroll
                    for (int n = 0; n < 2; ++n) *(f32x4*)(out + off + bj * HALF + n * 16) = r[m][bj][n] * alpha + acc[ai][bj][m][n]; }
        }
    }
};
struct EpiRelu2 {
    static constexpr bool PERM = true, AFTER_DRAIN = false;
    bf16_t* out;
    __device__ __forceinline__ void operator()(const f32x4 (&acc)[2][2][4][2], const Unit& u, int wr, int wc, int fr, int fq) const {
        const int row0 = u.pm * BM + wr * 64 + fr, col0 = u.pn * BM + wc * 32 + 8 * fq;
#pragma unroll
        for (int ai = 0; ai < 2; ++ai)
#pragma unroll
            for (int m = 0; m < 4; ++m) { bf16_t* rowp = out + (size_t)(row0 + ai * HALF + m * 16) * 4096 + col0;
#pragma unroll
                for (int bj = 0; bj < 2; ++bj) { f32x4 v0 = acc[ai][bj][m][0], v1 = acc[ai][bj][m][1];
#pragma unroll
                    for (int e = 0; e < 4; ++e) { const float a = fmaxf(v0[e], 0.f), b = fmaxf(v1[e], 0.f); v0[e] = a * a; v1[e] = b * b; }
                    *(u32x4*)(rowp + bj * HALF) = pack8(v0, v1); } }
    }
};

template <class Epi, class Sched, bool ALIGN_EPI = false, bool SP2 = false>
__device__ __forceinline__ void gemm_phase(PG8_LAS unsigned char* lds, const Gemm g, const Sched& S, const Epi& E) {
    const int tid = threadIdx.x, wid = __builtin_amdgcn_readfirstlane(tid >> 6), lane = tid & 63, wr = wid >> 2, wc = wid & 3, fr = lane & 15, fq = lane >> 4;
    const int K = g.K, nt = K / BK;
    unsigned voffA[2], voffB[2];
#pragma unroll
    for (int i = 0; i < 2; ++i) { int R, C; stage_rc(tid * 16 + i * 8192, R, C); const int Rb = Epi::PERM ? ((R & ~31) + perm32(R & 31)) : R;
        voffA[i] = (unsigned)(R * K + C) * 2u; voffB[i] = (unsigned)(Rb * K + C) * 2u; }
    const size_t kstep = (size_t)(BK * 2);
    const size_t hstep = (size_t)HALF * K * 2;
    const size_t tstep = 2 * hstep;
    const unsigned ldsw = (unsigned)wid * 1024u;
    const int aoff = lds_byte(wr * 64 + fr, fq * 8), boff = lds_byte(wc * 32 + fr, fq * 8);
#define PG8_SA(b, h) (((b) * 2 + (h)) * HTB)
#define PG8_SB(b, h) ((4 + (b) * 2 + (h)) * HTB)
#define PG8_STAGE(bufoff, gbase, voff) do { _Pragma("unroll") for (int _i = 0; _i < 2; ++_i) \
        __builtin_amdgcn_global_load_lds((const unsigned*)((const char*)(gbase) + (voff)[_i]), (PG8_LAS unsigned*)(lds + (bufoff) + ldsw + _i * 8192), 16, 0, 0); } while (0)
#define PG8_LDA(dst, b, h) do { _Pragma("unroll") for (int m = 0; m < 4; ++m) _Pragma("unroll") for (int k = 0; k < 2; ++k) dst[m][k] = *(const PG8_LAS bf16x8*)(lds + PG8_SA(b, h) + aoff + m * 2048 + k * 1024); } while (0)
#define PG8_LDB(dst, b, h) do { _Pragma("unroll") for (int n = 0; n < 2; ++n) _Pragma("unroll") for (int k = 0; k < 2; ++k) dst[n][k] = *(const PG8_LAS bf16x8*)(lds + PG8_SB(b, h) + boff + n * 2048 + k * 1024); } while (0)
#define PG8_MMA(ai, bj, At, Bt) do { __builtin_amdgcn_s_setprio(1); _Pragma("unroll") for (int m = 0; m < 4; ++m) _Pragma("unroll") for (int n = 0; n < 2; ++n) _Pragma("unroll") for (int k = 0; k < 2; ++k) \
        acc[ai][bj][m][n] = __builtin_amdgcn_mfma_f32_16x16x32_bf16(Bt[n][k], At[m][k], acc[ai][bj][m][n], 0, 0, 0); __builtin_amdgcn_s_setprio(0); } while (0)
#define PG8_WAIT_V(n) asm volatile("s_waitcnt vmcnt(" #n ")" ::: "memory")
#define PG8_WAIT_L(n) asm volatile("s_waitcnt lgkmcnt(" #n ")" ::: "memory")
#define PG8_BAR __builtin_amdgcn_s_barrier()
#define PG8_SCHED __builtin_amdgcn_sched_barrier(0)
    Unit cur, nxt; int ui = 0;
    if (!S.next(0, cur)) return;
    f32x4 acc[2][2][4][2];
#pragma unroll
    for (int a = 0; a < 2; ++a)
#pragma unroll
        for (int b = 0; b < 2; ++b)
#pragma unroll
            for (int m = 0; m < 4; ++m)
#pragma unroll
                for (int n = 0; n < 2; ++n) acc[a][b][m][n] = (f32x4){0.f, 0.f, 0.f, 0.f};
    bf16x8 At[4][2], B0[2][2], B1[2][2];
    const char* cA = (const char*)g.A + (size_t)cur.pm * tstep; const char* cB = (const char*)g.Bt + (size_t)cur.pn * tstep;
    S.a_ready(cur);
    if constexpr (SP2) {
        PG8_STAGE(PG8_SB(0, 0), cB, voffB); PG8_STAGE(PG8_SB(0, 1), cB + hstep, voffB); PG8_STAGE(PG8_SA(0, 0), cA, voffA); PG8_STAGE(PG8_SA(0, 1), cA + hstep, voffA);
        if (wr == 1) PG8_BAR;
        PG8_WAIT_V(2); PG8_BAR;
        PG8_STAGE(PG8_SB(1, 0), cB + kstep, voffB); PG8_STAGE(PG8_SA(1, 0), cA + kstep, voffA); PG8_STAGE(PG8_SB(1, 1), cB + hstep + kstep, voffB);
        PG8_WAIT_V(6); PG8_BAR;
    } else {
        PG8_STAGE(PG8_SB(0, 0), cB, voffB); PG8_STAGE(PG8_SA(0, 0), cA, voffA); PG8_STAGE(PG8_SB(0, 1), cB + hstep, voffB); PG8_STAGE(PG8_SA(0, 1), cA + hstep, voffA);
        if (wr == 1) PG8_BAR;
        PG8_WAIT_V(4); PG8_BAR;
        PG8_STAGE(PG8_SB(1, 0), cB + kstep, voffB); PG8_STAGE(PG8_SA(1, 0), cA + kstep, voffA); PG8_STAGE(PG8_SB(1, 1), cB + hstep + kstep, voffB);
        PG8_WAIT_V(6); PG8_BAR;
    }
    for (;;) {
        const bool has_next = S.next(ui + 1, nxt);
        const char* nA = has_next ? (const char*)g.A + (size_t)nxt.pm * tstep : cA; const char* nB = has_next ? (const char*)g.Bt + (size_t)nxt.pn * tstep : cB;
        for (int t = 0; t < nt; t += 2) {
            const bool last = (t == nt - 2);
            const char* a1 = cA + (size_t)(t + 1) * kstep;
            const char* a2 = last ? nA : cA + (size_t)(t + 2) * kstep; const char* b2 = last ? nB : cB + (size_t)(t + 2) * kstep;
            const char* a3 = a2 + kstep; const char* b3 = b2 + kstep;
            if (last && has_next) S.a_ready(nxt);
            if constexpr (SP2) {
            PG8_LDB(B0, 0, 0); PG8_LDB(B1, 0, 1); PG8_SCHED; PG8_LDA(At, 0, 0); PG8_STAGE(PG8_SA(1, 1), a1 + hstep, voffA);
            PG8_WAIT_V(8); PG8_WAIT_L(0); PG8_BAR; PG8_MMA(0, 0, At, B0); PG8_MMA(0, 1, At, B1); PG8_BAR; PG8_SCHED;
            PG8_LDA(At, 0, 1); PG8_STAGE(PG8_SB(0, 0), b2, voffB); PG8_STAGE(PG8_SB(0, 1), b2 + hstep, voffB); PG8_STAGE(PG8_SA(0, 0), a2, voffA);
            PG8_WAIT_V(8); PG8_WAIT_L(0); PG8_BAR; PG8_MMA(1, 0, At, B0); PG8_MMA(1, 1, At, B1); PG8_BAR; PG8_SCHED;
            PG8_LDB(B0, 1, 0); PG8_LDB(B1, 1, 1); PG8_SCHED; PG8_LDA(At, 1, 0); PG8_STAGE(PG8_SA(0, 1), a2 + hstep, voffA);
            PG8_WAIT_V(8); PG8_WAIT_L(0); PG8_BAR; PG8_MMA(0, 0, At, B0); PG8_MMA(0, 1, At, B1); PG8_BAR; PG8_SCHED;
            PG8_LDA(At, 1, 1); PG8_STAGE(PG8_SB(1, 0), b3, voffB); PG8_STAGE(PG8_SB(1, 1), b3 + hstep, voffB); PG8_STAGE(PG8_SA(1, 0), a3, voffA);
            PG8_WAIT_V(8); PG8_WAIT_L(0); PG8_BAR; PG8_MMA(1, 0, At, B0); PG8_MMA(1, 1, At, B1); PG8_BAR; PG8_SCHED;
            } else {
            PG8_LDB(B0, 0, 0); PG8_SCHED; PG8_LDA(At, 0, 0); PG8_STAGE(PG8_SA(1, 1), a1 + hstep, voffA);
            PG8_WAIT_L(8); PG8_BAR; PG8_WAIT_L(0); PG8_MMA(0, 0, At, B0); PG8_BAR; PG8_SCHED;
            PG8_LDB(B1, 0, 1); PG8_STAGE(PG8_SB(0, 0), b2, voffB);
            PG8_BAR; PG8_WAIT_L(0); PG8_MMA(0, 1, At, B1); PG8_BAR;
            PG8_LDA(At, 0, 1); PG8_STAGE(PG8_SA(0, 0), a2, voffA);
            PG8_BAR; PG8_WAIT_L(0); PG8_MMA(1, 0, At, B0); PG8_BAR; PG8_SCHED;
            PG8_STAGE(PG8_SB(0, 1), b2 + hstep, voffB);
            PG8_WAIT_V(6); PG8_BAR; PG8_MMA(1, 1, At, B1); PG8_BAR;
            PG8_LDB(B0, 1, 0); PG8_SCHED; PG8_LDA(At, 1, 0); PG8_STAGE(PG8_SA(0, 1), a2 + hstep, voffA);
            PG8_WAIT_L(8); PG8_BAR; PG8_WAIT_L(0); PG8_MMA(0, 0, At, B0); PG8_BAR; PG8_SCHED;
            PG8_LDB(B1, 1, 1); PG8_STAGE(PG8_SB(1, 0), b3, voffB);
            PG8_BAR; PG8_WAIT_L(0); PG8_MMA(0, 1, At, B1); PG8_BAR;
            PG8_LDA(At, 1, 1); PG8_STAGE(PG8_SA(1, 0), a3, voffA);
            PG8_BAR; PG8_WAIT_L(0); PG8_MMA(1, 0, At, B0); PG8_BAR; PG8_SCHED;
            PG8_STAGE(PG8_SB(1, 1), b3 + hstep, voffB);
            PG8_WAIT_V(6); PG8_BAR; PG8_MMA(1, 1, At, B1); PG8_BAR;
            }
        }
        if constexpr (ALIGN_EPI) { if (wr == 0) PG8_BAR; }
        if constexpr (!Epi::AFTER_DRAIN) { E(acc, cur, wr, wc, fr, fq); S.done(cur); }
        if (!has_next) break;
#pragma unroll
        for (int a = 0; a < 2; ++a)
#pragma unroll
            for (int b = 0; b < 2; ++b)
#pragma unroll
                for (int m = 0; m < 4; ++m)
#pragma unroll
                    for (int n = 0; n < 2; ++n) acc[a][b][m][n] = (f32x4){0.f, 0.f, 0.f, 0.f};
        cur = nxt; cA = nA; cB = nB; ++ui;
        if constexpr (ALIGN_EPI) { if (wr == 1) PG8_BAR; }
    }
    PG8_WAIT_V(0);
    if constexpr (!ALIGN_EPI) { if (wr == 0) PG8_BAR; }
    PG8_BAR;
    if constexpr (Epi::AFTER_DRAIN) { E.fused(acc, cur, wr, wc, fr, fq, lds, wid, lane); S.done(cur); }
#undef PG8_SA
#undef PG8_SB
#undef PG8_STAGE
#undef PG8_LDA
#undef PG8_LDB
#undef PG8_MMA
#undef PG8_WAIT_V
#undef PG8_WAIT_L
#undef PG8_BAR
#undef PG8_SCHED
}
}
#include <hip/hip_bf16.h>
#include <cmath>
namespace attn_body {
using bf16=__hip_bfloat16;
using bf16x8=__attribute__((ext_vector_type(8)))short;
using s16x4=__attribute__((ext_vector_type(4)))short;
using f32x16=__attribute__((ext_vector_type(16)))float;
using u32x4=__attribute__((ext_vector_type(4)))unsigned;
constexpr int SEQ=8192,D=64,DM=1024;
constexpr int NW=8,QBLK=32,QB=QBLK*NW,KVBLK=64,NQB=SEQ/QB;
constexpr int ATTN_PITCH=DM, ATTN_UNIT_ROWS=QB;
__device__ __forceinline__ int crow(int r,int hi){return (r&3)+8*(r>>2)+4*hi;}
#define SBAR() __builtin_amdgcn_sched_barrier(0)
__device__ __forceinline__ void cmask(f32x16&p0,f32x16&p1,int jb,int qrel,int hi){
  const float NEG=-INFINITY; int kb=64*jb+4*hi;
  #pragma unroll
  for(int r=0;r<16;++r){int kv=kb+(r&3)+8*(r>>2); if(kv>qrel)p0[r]=NEG; if(kv+32>qrel)p1[r]=NEG;}
}

typedef __attribute__((address_space(3))) const float* lds_fptr;
__device__ __forceinline__ void bmask(f32x16&p0,f32x16&p1,int jb,int qrel,int hi,lds_fptr tab){
  lds_fptr tp=tab+(qrel-64*jb-4*hi+196);
  #pragma unroll
  for(int r=0;r<16;++r){const int off=(r&3)+8*(r>>2); p0[r]+=tp[59-off]; p1[r]+=tp[27-off];}
}
constexpr int NSLOT=3, SLOTB=8192;
constexpr int LDS_K=0, LDS_V=NSLOT*SLOTB, LDS_WS=2*NSLOT*SLOTB, LDS_OST=LDS_WS+NW*64*4, LDS_BYTES=LDS_OST+NW*4096;
constexpr float C2=0.125f*1.4426950408889634f;
__device__ __forceinline__ void glds16(const void*gsrc,unsigned lds_dst){unsigned keep;
  asm volatile("s_mov_b32 %0, m0\n\ts_mov_b32 m0, %2\n\ts_nop 0\n\tglobal_load_lds_dwordx4 %1, off\n\ts_mov_b32 m0, %0":"=&s"(keep):"v"(gsrc),"s"(lds_dst):"memory");}
__device__ __forceinline__ float max3f(float a,float b,float c){float r;asm("v_max3_f32 %0, %1, %2, %3":"=v"(r):"v"(a),"v"(b),"v"(c));return r;}
__device__ __forceinline__ float max2f(float a,float b){float r;asm("v_max_f32_e32 %0, %1, %2":"=v"(r):"v"(a),"v"(b));return r;}
__device__ __forceinline__ float fadd_s(float a,float b){float r;asm("v_add_f32_e32 %0, %1, %2":"=v"(r):"v"(a),"v"(b));return r;}
__device__ __forceinline__ float fsub_s(float a,float b){float r;asm("v_sub_f32_e32 %0, %1, %2":"=v"(r):"v"(a),"v"(b));return r;}
typedef float f32x2_t __attribute__((ext_vector_type(2))); typedef __bf16 bf16x2_t __attribute__((ext_vector_type(2)));
__device__ __forceinline__ unsigned cvtpk_s(float lo,float hi){f32x2_t v={lo,hi};bf16x2_t b=__builtin_convertvector(v,bf16x2_t);return __builtin_bit_cast(unsigned,b);}
#define WAIT_BAR(N) asm volatile("s_waitcnt vmcnt(" #N ") lgkmcnt(0)\n\ts_barrier":::"memory")

__device__ __forceinline__ void qkt(f32x16&p0,f32x16&p1,const char*Kslot,const bf16x8*qr,const f32x16&negm,int r32,int hi){
  const char*kb=Kslot+hi*1024+r32*16;
  #pragma unroll
  for(int d0=0;d0<4;++d0){
    const bf16x8 b0=*reinterpret_cast<const bf16x8*>(kb+d0*2048);
    const bf16x8 b1=*reinterpret_cast<const bf16x8*>(kb+d0*2048+512);
    if(d0==0){p0=__builtin_amdgcn_mfma_f32_32x32x16_bf16(b0,qr[0],negm,0,0,0);p1=__builtin_amdgcn_mfma_f32_32x32x16_bf16(b1,qr[0],negm,0,0,0);}
    else{p0=__builtin_amdgcn_mfma_f32_32x32x16_bf16(b0,qr[d0],p0,0,0,0);p1=__builtin_amdgcn_mfma_f32_32x32x16_bf16(b1,qr[d0],p1,0,0,0);}}
}
typedef __attribute__((address_space(3))) const char* lds_cptr;
typedef short v4i16_t __attribute__((ext_vector_type(4)));
__device__ __forceinline__ void kload8(bf16x8*kf,lds_cptr kp){
  kf[0]=*(const __attribute__((address_space(3))) bf16x8*)(kp);      kf[1]=*(const __attribute__((address_space(3))) bf16x8*)(kp+512);
  kf[2]=*(const __attribute__((address_space(3))) bf16x8*)(kp+2048); kf[3]=*(const __attribute__((address_space(3))) bf16x8*)(kp+2560);
  kf[4]=*(const __attribute__((address_space(3))) bf16x8*)(kp+4096); kf[5]=*(const __attribute__((address_space(3))) bf16x8*)(kp+4608);
  kf[6]=*(const __attribute__((address_space(3))) bf16x8*)(kp+6144); kf[7]=*(const __attribute__((address_space(3))) bf16x8*)(kp+6656);
}
__device__ __forceinline__ void kload2(bf16x8*kf,lds_cptr kp,int j){ kf[2*j]=*(const __attribute__((address_space(3))) bf16x8*)(kp+j*2048); kf[2*j+1]=*(const __attribute__((address_space(3))) bf16x8*)(kp+j*2048+512); }
__device__ __forceinline__ s16x4 vtr(lds_cptr p){ return __builtin_bit_cast(s16x4,__builtin_amdgcn_ds_read_tr16_b64_v4i16((__attribute__((address_space(3))) v4i16_t*)p)); }
__device__ __forceinline__ float rowmax(const f32x16&p0,const f32x16&p1){
  float a=max3f(p0[0],p0[1],p1[0]),b=max3f(p0[2],p0[3],p1[1]);a=max3f(a,p1[2],p1[3]);
  #pragma unroll
  for(int r=4;r<16;r+=4){a=max3f(a,p0[r],p0[r+1]);b=max3f(b,p0[r+2],p0[r+3]);a=max3f(a,p1[r],p1[r+1]);b=max3f(b,p1[r+2],p1[r+3]);}
  const float m=max2f(a,b);
  auto rr=__builtin_amdgcn_permlane32_swap(__float_as_uint(m),__float_as_uint(m),false,false);
  return max2f(__uint_as_float(rr[0]),__uint_as_float(rr[1]));
}
__device__ __forceinline__ void pv(f32x16*o,int vb,bf16x8 pa0,bf16x8 pa1,bf16x8 pa2,bf16x8 pa3){
  #pragma unroll
  for(int d0=0;d0<2;++d0){s16x4 lo[4],hi[4];
    #pragma unroll
    for(int ks=0;ks<4;++ks){
      asm volatile("ds_read_b64_tr_b16 %0,%1 offset:%c2":"=&v"(lo[ks]):"v"(vb),"i"(d0*4096+ks*1024):"memory");
      asm volatile("ds_read_b64_tr_b16 %0,%1 offset:%c2":"=&v"(hi[ks]):"v"(vb),"i"(d0*4096+ks*1024+512):"memory");}
    asm volatile("s_waitcnt lgkmcnt(0)":::"memory");SBAR();
    #define PK(k) (bf16x8){lo[k][0],lo[k][1],lo[k][2],lo[k][3],hi[k][0],hi[k][1],hi[k][2],hi[k][3]}
    o[d0]=__builtin_amdgcn_mfma_f32_32x32x16_bf16(pa0,PK(0),o[d0],0,0,0);
    o[d0]=__builtin_amdgcn_mfma_f32_32x32x16_bf16(pa1,PK(1),o[d0],0,0,0);
    o[d0]=__builtin_amdgcn_mfma_f32_32x32x16_bf16(pa2,PK(2),o[d0],0,0,0);
    o[d0]=__builtin_amdgcn_mfma_f32_32x32x16_bf16(pa3,PK(3),o[d0],0,0,0);
    #undef PK
  }
}

#ifndef ATTN_STORE16
#define ATTN_STORE16(p,v) (*(u32x4*)(p)=(v))
#endif
template<int THRL> __device__ __forceinline__ void attn_unit(int qb,const bf16*Q,const bf16*__restrict__ K,const bf16*__restrict__ V,bf16*O,lds_fptr tab,char*shm){
  __builtin_amdgcn_sched_barrier(0); int tid_=threadIdx.x; asm volatile("":"+v"(tid_));
  const int tid=tid_,lane=tid&63,r32=lane&31,hi=lane>>5; const int wid=__builtin_amdgcn_readfirstlane(tid>>6);
  const int q0=qb*QB;
  const bf16*Qw=Q+(long)(q0+wid*QBLK)*DM;
  const bf16*Kh=K,*Vh=V;
  const unsigned lds0=(unsigned)(uintptr_t)shm;
  float*wsf=(float*)(shm+LDS_WS)+wid*64;
  const bf16*ksrc=Kh+(long)lane*DM+wid*8;
  const bf16*vsrc=Vh+(long)(16*(wid&3)+(lane>>2))*DM+(wid>>2)*32+(lane&3)*8;
  const unsigned kdst=lds0+LDS_K+wid*1024, vdst=lds0+LDS_V+wid*1024;
  #define DMA_K(t,slot) glds16(ksrc+(long)(t)*KVBLK*DM,(unsigned)__builtin_amdgcn_readfirstlane(kdst+(slot)))
  #define DMA_V(t,slot) glds16(vsrc+(long)(t)*KVBLK*DM,(unsigned)__builtin_amdgcn_readfirstlane(vdst+(slot)))
  const int vb0=(int)(lds0+LDS_V)+((lane>>4)&1)*32+(lane&3)*8+(4*hi+((lane&15)>>2))*64;
  const char*Kbase=shm+LDS_K; bf16x8 kf[8];
  const lds_cptr shm3=(lds_cptr)shm; const lds_cptr kp0=shm3+LDS_K+hi*1024+r32*16; const lds_cptr vp0=shm3+LDS_V+((lane>>4)&1)*32+(lane&3)*8+(4*hi+((lane&15)>>2))*64;
  const int NT=(q0+QB)/KVBLK;
  DMA_K(0,0);DMA_V(0,0);DMA_K(1,SLOTB);
  bf16x8 qr[4];
  #pragma unroll
  for(int d0=0;d0<4;++d0)qr[d0]=*reinterpret_cast<const bf16x8*>(&Qw[(long)r32*DM+d0*16+hi*8]);
  float mhat=0.f,l_reg=0.f;f32x16 o[2];o[0]=f32x16{};o[1]=f32x16{};f32x16 negm=f32x16{};asm volatile("":"+v"(negm));
  const int qrel=wid*QBLK+r32;
  #define CMASK(P0,P1,t) do{int jb_=(t)-(NT-4); if(jb_>=-2)bmask(P0,P1,jb_,qrel,hi,tab);}while(0)
  bool resc=false;
  #define START(P0,P1) do{ const float rm=rowmax(P0,P1); resc=false; \
    { const float dl=rm; mhat=fadd_s(mhat,dl); \
      _Pragma("unroll") for(int r=0;r<16;++r){P0[r]=fsub_s(P0[r],dl);P1[r]=fsub_s(P1[r],dl);} \
      _Pragma("unroll") for(int r=0;r<16;++r)negm[r]=-mhat; asm volatile("":"+v"(negm)); } \
    _Pragma("unroll") for(int r=0;r<16;++r)P0[r]=__builtin_amdgcn_exp2f(P0[r]); }while(0)
  #define RESC() do{ if(resc){ asm volatile("s_waitcnt lgkmcnt(0)":::"memory"); \
      _Pragma("unroll") for(int d_=0;d_<2;++d_) _Pragma("unroll") for(int r=0;r<16;++r)o[d_][r]*=wsf[crow(r,hi)]; } }while(0)
  f32x16 pA0,pA1,pB0,pB1;
  int sl_prev=0,sl_cur=0,sl_next=SLOTB;
  #define ROT() do{sl_prev=sl_cur;sl_cur=sl_next;sl_next=(sl_next==(NSLOT-1)*SLOTB)?0:sl_next+SLOTB;}while(0)
  DMA_K(2,2*SLOTB);
  WAIT_BAR(3);
  qkt(pA0,pA1,Kbase,qr,negm,r32,hi);asm volatile("s_nop 15\n\ts_nop 7":"+v"(pA0),"+v"(pA1));CMASK(pA0,pA1,0);
  START(pA0,pA1);
  _Pragma("unroll") for(int r=0;r<16;++r)pA1[r]=__builtin_amdgcn_exp2f(pA1[r]);
  WAIT_BAR(0);
  DMA_K(3,0);DMA_V(1,SLOTB);
  ROT();
  kload8(kf,kp0+sl_cur);
  WAIT_BAR(2);
  s16x4 vlo[8],vhi[8]; u32x4 pw0,pw1,pw2,pw3;
  #define PKW(P,B) cvtpk_s(P[B],P[B+1])
  #define PAF(k) __builtin_bit_cast(bf16x8,pw##k)
  #define VFR(i) (bf16x8){vlo[i][0],vlo[i][1],vlo[i][2],vlo[i][3],vhi[i][0],vhi[i][1],vhi[i][2],vhi[i][3]}
  #define PIN(x) asm volatile("":"+v"(x))
  #define MX3(a,b,c) __builtin_fmaxf(__builtin_fmaxf((a),(b)),(c))
  #define GAPA(MF,A0,A1,A2,A3,W0,W1,PW) do{ MF; sacc+=A0; sacc+=A1; sacc+=A2; sacc+=A3; PIN(sacc); W0; W1; PIN(PW); SBAR(); }while(0)
  #define EX(v) __builtin_amdgcn_exp2f(v)
  #define GAPB(MF,X,B) do{ MF; X[B]=EX(X[B]); X[B+1]=EX(X[B+1]); X[B+2]=EX(X[B+2]); X[B+3]=EX(X[B+3]); PIN(X); SBAR(); }while(0)
  #define VRD(i) do{ vlo[i]=vtr(vp_+(((i)>>2)*4096+((i)&3)*1024)); vhi[i]=vtr(vp_+(((i)>>2)*4096+((i)&3)*1024+512)); }while(0)
  #define KRD(G,j) do{ if(G){ kload2(kf,kp0+sl_next,j); SBAR(); } }while(0)
  #define STEP(C0,C1,P0,P1,t,GK,GV,GL) do{ SBAR(); \
    const lds_cptr vp_=vp0+sl_prev; \
    VRD(0); SBAR(); float sacc=(P0[0]+P0[1]); \
    GAPA(C0=__builtin_amdgcn_mfma_f32_32x32x16_bf16(kf[0],qr[0],negm,0,0,0), P0[2],P0[3],P0[4],P0[5],     pw0[0]=PKW(P0,0), pw0[1]=PKW(P0,2), pw0); \
    VRD(4); SBAR(); GAPA(C1=__builtin_amdgcn_mfma_f32_32x32x16_bf16(kf[1],qr[0],negm,0,0,0), P0[6],P0[7],P0[8],P0[9],     pw0[2]=PKW(P0,4), pw0[3]=PKW(P0,6), pw0); \
    VRD(1); SBAR(); GAPA(C0=__builtin_amdgcn_mfma_f32_32x32x16_bf16(kf[2],qr[1],C0,0,0,0),   P0[10],P0[11],P0[12],P0[13], pw1[0]=PKW(P0,8), pw1[1]=PKW(P0,10), pw1); \
    VRD(5); SBAR(); GAPA(C1=__builtin_amdgcn_mfma_f32_32x32x16_bf16(kf[3],qr[1],C1,0,0,0),   P0[14],P0[15],P1[0],P1[1],   pw1[2]=PKW(P0,12),pw1[3]=PKW(P0,14), pw1); \
    VRD(2); SBAR(); GAPA(C0=__builtin_amdgcn_mfma_f32_32x32x16_bf16(kf[4],qr[2],C0,0,0,0),   P1[2],P1[3],P1[4],P1[5],     pw2[0]=PKW(P1,0), pw2[1]=PKW(P1,2), pw2); \
    VRD(6); SBAR(); GAPA(C1=__builtin_amdgcn_mfma_f32_32x32x16_bf16(kf[5],qr[2],C1,0,0,0),   P1[6],P1[7],P1[8],P1[9],     pw2[2]=PKW(P1,4), pw2[3]=PKW(P1,6), pw2); \
    VRD(3); SBAR(); GAPA(C0=__builtin_amdgcn_mfma_f32_32x32x16_bf16(kf[6],qr[3],C0,0,0,0),   P1[10],P1[11],P1[12],P1[13], pw3[0]=PKW(P1,8), pw3[1]=PKW(P1,10), pw3); \
    VRD(7); SBAR(); GAPA(C1=__builtin_amdgcn_mfma_f32_32x32x16_bf16(kf[7],qr[3],C1,0,0,0),   P1[14],P1[15],0.f,0.f,       pw3[2]=PKW(P1,12),pw3[3]=PKW(P1,14), pw3); \
    l_reg+=sacc; \
    if(GK){DMA_K((t)+3,sl_cur);} if(GV){DMA_V((t)+1,sl_next);} \
    CMASK(C0,C1,t); \
    { float a=MX3(C0[0],C0[1],C1[0]),b=MX3(C0[2],C0[3],C1[1]); a=MX3(a,C1[2],C1[3]); \
      _Pragma("unroll") for(int r=4;r<16;r+=4){a=MX3(a,C0[r],C0[r+1]);b=MX3(b,C0[r+2],C0[r+3]);a=MX3(a,C1[r],C1[r+1]);b=MX3(b,C1[r+2],C1[r+3]);} \
      float rm=__builtin_fmaxf(a,b); { auto rr=__builtin_amdgcn_permlane32_swap(__float_as_uint(rm),__float_as_uint(rm),false,false); rm=__builtin_fmaxf(__uint_as_float(rr[0]),__uint_as_float(rr[1])); } \
      resc=false; \
      if(__builtin_expect(__any(rm>(float)THRL),0)){ const float dl=__builtin_fmaxf(rm,0.f); mhat+=dl; \
        _Pragma("unroll") for(int r=0;r<16;++r){C0[r]-=dl;C1[r]-=dl;} \
        _Pragma("unroll") for(int r=0;r<16;++r)negm[r]=-mhat; asm volatile("":"+v"(negm)); \
        const float f=__builtin_amdgcn_exp2f(-dl); l_reg*=f; if(hi==0)wsf[r32]=f; resc=true; } } \
    SBAR(); \
    GAPB(o[0]=__builtin_amdgcn_mfma_f32_32x32x16_bf16(PAF(0),VFR(0),o[0],0,0,0), C0,0); \
    GAPB(o[1]=__builtin_amdgcn_mfma_f32_32x32x16_bf16(PAF(0),VFR(4),o[1],0,0,0), C0,4); \
    KRD(GL,0); GAPB(o[0]=__builtin_amdgcn_mfma_f32_32x32x16_bf16(PAF(1),VFR(1),o[0],0,0,0), C0,8); \
    KRD(GL,1); GAPB(o[1]=__builtin_amdgcn_mfma_f32_32x32x16_bf16(PAF(1),VFR(5),o[1],0,0,0), C0,12); \
    KRD(GL,2); GAPB(o[0]=__builtin_amdgcn_mfma_f32_32x32x16_bf16(PAF(2),VFR(2),o[0],0,0,0), C1,0); \
    KRD(GL,3); GAPB(o[1]=__builtin_amdgcn_mfma_f32_32x32x16_bf16(PAF(2),VFR(6),o[1],0,0,0), C1,4); \
    GAPB(o[0]=__builtin_amdgcn_mfma_f32_32x32x16_bf16(PAF(3),VFR(3),o[0],0,0,0), C1,8); \
    GAPB(o[1]=__builtin_amdgcn_mfma_f32_32x32x16_bf16(PAF(3),VFR(7),o[1],0,0,0), C1,12); \
    }while(0)
  int t=1;
  #undef CMASK
  #define CMASK(P0,P1,t) do{}while(0)
  for(;t+7<NT;t+=2){
    STEP(pB0,pB1,pA0,pA1,t,true,true,true);     WAIT_BAR(2); RESC(); ROT();
    STEP(pA0,pA1,pB0,pB1,t+1,true,true,true);   WAIT_BAR(2); RESC(); ROT();
  }
  #undef CMASK
  #define CMASK(P0,P1,t) do{int jb_=(t)-(NT-4); if(jb_>=-2)bmask(P0,P1,jb_,qrel,hi,tab);}while(0)
  #define ENDW(tt) do{ if((tt)+3<NT){WAIT_BAR(2);} else if((tt)+2<NT){WAIT_BAR(1);} else {WAIT_BAR(0);} }while(0)
  for(;t+1<NT;t+=2){
    STEP(pB0,pB1,pA0,pA1,t,(t+3<NT),(t+1<NT),(t+1<NT));       ENDW(t);   RESC(); ROT();
    STEP(pA0,pA1,pB0,pB1,t+1,(t+4<NT),(t+2<NT),(t+2<NT));     ENDW(t+1); RESC(); ROT();
  }
  STEP(pB0,pB1,pA0,pA1,NT-1,false,false,false); RESC();
  { float sacc=pB0[0]+pB0[1]; _Pragma("unroll") for(int r=2;r<16;++r)sacc+=pB0[r]; _Pragma("unroll") for(int r=0;r<16;++r)sacc+=pB1[r]; l_reg+=sacc;
    pw0=(u32x4){PKW(pB0,0),PKW(pB0,2),PKW(pB0,4),PKW(pB0,6)};pw1=(u32x4){PKW(pB0,8),PKW(pB0,10),PKW(pB0,12),PKW(pB0,14)};pw2=(u32x4){PKW(pB1,0),PKW(pB1,2),PKW(pB1,4),PKW(pB1,6)};pw3=(u32x4){PKW(pB1,8),PKW(pB1,10),PKW(pB1,12),PKW(pB1,14)};
    SBAR(); pv(o,vb0+sl_cur,PAF(0),PAF(1),PAF(2),PAF(3)); }
  #undef PKW
  #undef PAF
  #undef VFR
  #undef PIN
  #undef MX3
  #undef GAPA
  #undef GAPB
  #undef EX
  #undef VRD
  #undef KRD
  #undef STEP
  #undef ENDW
  {auto rr=__builtin_amdgcn_permlane32_swap(__float_as_uint(l_reg),__float_as_uint(l_reg),false,false);l_reg=__uint_as_float(rr[0])+__uint_as_float(rr[1]);}
  if(hi==0)wsf[32+r32]=l_reg;asm volatile("s_waitcnt lgkmcnt(0)":::"memory");
  float rli[16];
  #pragma unroll
  for(int r=0;r<16;++r)rli[r]=__builtin_amdgcn_rcpf(wsf[32+crow(r,hi)]);
  bf16*Ow=O+(long)(q0+wid*QBLK)*DM;
  { bf16*stg=(bf16*)(shm+LDS_OST)+wid*2048;
    #pragma unroll
    for(int r=0;r<16;++r){const int orow=crow(r,hi);
      #pragma unroll
      for(int d0=0;d0<2;++d0)stg[orow*64+d0*32+r32]=__float2bfloat16(o[d0][r]*rli[r]);}
    asm volatile("s_waitcnt lgkmcnt(0)":::"memory");
    #pragma unroll
    for(int i=0;i<4;++i){const int row=i*8+(lane>>3),ch=lane&7; const u32x4 v=*(const u32x4*)(stg+row*64+ch*8); ATTN_STORE16(Ow+(long)row*DM+ch*8,v);} }
  asm volatile("s_waitcnt lgkmcnt(0)\n\ts_barrier":::"memory");
  __builtin_amdgcn_sched_barrier(0);
  #undef DMA_K
  #undef DMA_V
  #undef CMASK
  #undef START
  #undef RESC
  #undef ROT
}
constexpr int ATTN_LDS_BYTES=LDS_BYTES;
#undef SBAR
#undef WAIT_BAR
}
constexpr int SEQ = 8192, DMODEL = 1024, M = 4 * SEQ, FF = 4096, COLS_A = 4608, COLS_B2 = 5120;
constexpr float LN_EPS = 1e-5f, LOG2E = 1.4426950408889634f;
constexpr float DN_ALPHA = 1.189207115002721f;
constexpr size_t MiB = 1u << 20;
constexpr size_t WS_WIN = 0, WS_WPA = 19 * MiB, WS_WPB = 20 * MiB, WS_WO = 22 * MiB, WS_W1 = 24 * MiB, WS_W2 = 32 * MiB;
constexpr size_t WS_R1 = 40 * MiB;
constexpr size_t WS_R2 = 328 * MiB;
constexpr size_t WS_OG = WS_R2, WS_LSE = WS_R2 + 96 * MiB;
constexpr size_t WS_XB = 427 * MiB;
constexpr size_t WS_OA = WS_R1, WS_QB = WS_R1 + 32 * MiB, WS_O1 = WS_R1 + 224 * MiB, WS_O2 = WS_R2;
constexpr size_t WS_OB = WS_R1 + 32 * MiB, WS_GATES = WS_R1 + 96 * MiB, WS_TMP = WS_R1 + 224 * MiB, WS_MERGED = WS_XB;
constexpr size_t WS_Z = WS_R1, WS_X1B = WS_XB, WS_H = WS_R1 + 128 * MiB, WS_CTL = 496 * MiB, CTL_BYTES = 16384, WS_END = 497 * MiB;
constexpr int RING_BYTES = 131072, LDS_BYTES = 147456;

#define GAS __attribute__((address_space(1)))
#define LAS __attribute__((address_space(3)))
typedef unsigned short bf16;
typedef unsigned v4u __attribute__((ext_vector_type(4)));
typedef unsigned v2u __attribute__((ext_vector_type(2)));
typedef float f32x4 __attribute__((ext_vector_type(4)));
typedef float f32x16 __attribute__((ext_vector_type(16)));
typedef short bf16x8 __attribute__((ext_vector_type(8)));
typedef short s16x4 __attribute__((ext_vector_type(4)));
#define LDS_WAIT() asm volatile("s_waitcnt lgkmcnt(0)" ::: "memory")
__device__ __forceinline__ unsigned f2bf(float f) { unsigned u = __builtin_bit_cast(unsigned, f); return (u + 0x7fffu + ((u >> 16) & 1u)) >> 16; }
__device__ __forceinline__ unsigned pk2(float lo, float hi) { return f2bf(lo) | (f2bf(hi) << 16); }
__device__ __forceinline__ float blo(unsigned w) { return __uint_as_float(w << 16); }
__device__ __forceinline__ float bhi(unsigned w) { return __uint_as_float(w & 0xffff0000u); }
__device__ __forceinline__ float wave_sum(float v) {
#pragma unroll
    for (int o = 1; o < 64; o <<= 1) v += __shfl_xor(v, o);
    return v;
}
__device__ __forceinline__ int t5_bucket(int n) {
    if (n < 16) return n;
    const float v = logf((float)n / 16.0f) / 2.0794415416798357f * 16.0f;
    int l = 16 + (int)v; return l > 31 ? 31 : l;
}
__device__ __forceinline__ void p0_transpose_item(const float* W, int K, int N, bf16* WT, LAS float* scr, int item, int lane) {
    const int nblk = N / 32, kb = item / nblk, nb = item % nblk, k0 = 64 * kb, n0 = 32 * nb;
#pragma unroll 8
    for (int i = 0; i < 32; ++i) { const int kk = 2 * i + (lane >> 5); scr[kk * 33 + (lane & 31)] = W[(size_t)(k0 + kk) * N + n0 + (lane & 31)]; }
    LDS_WAIT(); asm volatile("" ::: "memory");
    const int c = lane & 7;
#pragma unroll
    for (int j = 0; j < 4; ++j) { const int n = (lane >> 3) + 8 * j; const LAS float* s = scr + (8 * c) * 33 + n;
        v4u o; o.x = pk2(s[0 * 33], s[1 * 33]); o.y = pk2(s[2 * 33], s[3 * 33]); o.z = pk2(s[4 * 33], s[5 * 33]); o.w = pk2(s[6 * 33], s[7 * 33]);
        *(v4u*)(WT + (size_t)(n0 + n) * K + k0 + 8 * c) = o; }
    LDS_WAIT(); asm volatile("" ::: "memory");
}

namespace attn_a {
constexpr int KP = 144, VP = 192, LDS_KS = 0, LDS_VS = 384 * KP, LDS_TAB = 384 * KP + 384 * VP;
typedef __attribute__((address_space(3))) const char* lds_cptr;
typedef short v4i16_t __attribute__((ext_vector_type(4)));
__device__ __forceinline__ s16x4 vtr(lds_cptr p) { return __builtin_bit_cast(s16x4, __builtin_amdgcn_ds_read_tr16_b64_v4i16((__attribute__((address_space(3))) v4i16_t*)p)); }
typedef float f32x2_t __attribute__((ext_vector_type(2))); typedef __bf16 bf16x2_t __attribute__((ext_vector_type(2)));
__device__ __forceinline__ unsigned cvtpk(float lo, float hi) { f32x2_t v = {lo, hi}; bf16x2_t b = __builtin_convertvector(v, bf16x2_t); return __builtin_bit_cast(unsigned, b); }
__device__ __forceinline__ void unit(int g, int h, int blk, const bf16* qa, const bf16* ka, const bf16* va, bf16* og, float* lse, const float* rel_bias, LAS unsigned char* lds) {
    const int tid = threadIdx.x, lane = tid & 63, r32 = lane & 31, hi = lane >> 5; const int wid = __builtin_amdgcn_readfirstlane(tid >> 6);
    const int sh = 2 * g, Lm1 = (SEQ >> sh) - 1, p0 = blk * 256;
    const bool first = ((p0 & Lm1) == 0);
    const size_t gofs = (size_t)g * ((size_t)M * 512);
    const bf16* kg = ka + gofs + h * 64; const bf16* vg = va + gofs + h * 64;
#pragma unroll
    for (int it = 0; it < 6; ++it) { const int idx = it * 512 + tid, row = idx >> 3, ch = idx & 7; const long prow = (long)p0 - 128 + row;
        v4u kv4 = {0u, 0u, 0u, 0u}, vv4 = {0u, 0u, 0u, 0u};
        if (!(first && row < 128)) { kv4 = *(const v4u*)(kg + prow * 512 + ch * 8); vv4 = *(const v4u*)(vg + prow * 512 + ch * 8); }
        *(LAS v4u*)(lds + LDS_KS + row * KP + ch * 16) = kv4; *(LAS v4u*)(lds + LDS_VS + row * VP + ch * 16) = vv4; }
    LAS float* tab = (LAS float*)(lds + LDS_TAB);
    if (tid < 129) tab[tid] = rel_bias[t5_bucket(tid << sh) * 32 + g * 8 + h] * LOG2E;
    bf16x8 qr[4];
    { const bf16* qrow = qa + gofs + (size_t)(p0 + wid * 32 + r32) * 512 + h * 64 + hi * 8;
#pragma unroll
      for (int d0 = 0; d0 < 4; ++d0) qr[d0] = *(const bf16x8*)(qrow + d0 * 16); }
    __syncthreads();
    f32x16 S[5];
    { const LAS unsigned char* kb = lds + LDS_KS + (wid * 32 + r32) * KP + hi * 16;
#pragma unroll
      for (int c = 0; c < 5; ++c) { f32x16 a = {};
#pragma unroll
          for (int d0 = 0; d0 < 4; ++d0) { const bf16x8 kf = *(const LAS bf16x8*)(kb + c * 32 * KP + d0 * 32); a = __builtin_amdgcn_mfma_f32_32x32x16_bf16(kf, qr[d0], a, 0, 0, 0); }
          S[c] = a; } }
    float mx = -1e30f;
#pragma unroll
    for (int c = 0; c < 5; ++c)
#pragma unroll
        for (int i = 0; i < 16; ++i) { const int cr = (i & 3) + 8 * (i >> 2) + 4 * hi; const int steps = r32 + 128 - 32 * c - cr;
            bool valid = (steps >= 0) && (steps <= 128); if (first) valid = valid && (wid * 32 + 32 * c + cr >= 128);
            const int si = steps < 0 ? 0 : (steps > 128 ? 128 : steps);
            const float v = valid ? S[c][i] + tab[si] : -1e30f; S[c][i] = v; mx = fmaxf(mx, v); }
    mx = fmaxf(mx, __shfl_xor(mx, 32));
    float l = 0.f;
#pragma unroll
    for (int c = 0; c < 5; ++c)
#pragma unroll
        for (int i = 0; i < 16; ++i) { const float p = __builtin_amdgcn_exp2f(S[c][i] - mx); S[c][i] = p; l += p; }
    l += __shfl_xor(l, 32);
    f32x16 O[2]; O[0] = f32x16{}; O[1] = f32x16{};
    { const lds_cptr vb = (lds_cptr)(lds + LDS_VS) + (wid * 32 + 4 * hi + ((lane & 15) >> 2)) * VP + ((lane >> 4) & 1) * 32 + (lane & 3) * 8;
#pragma unroll
      for (int c = 0; c < 5; ++c)
#pragma unroll
          for (int s = 0; s < 2; ++s) { v4u pw; pw.x = cvtpk(S[c][8 * s], S[c][8 * s + 1]); pw.y = cvtpk(S[c][8 * s + 2], S[c][8 * s + 3]); pw.z = cvtpk(S[c][8 * s + 4], S[c][8 * s + 5]); pw.w = cvtpk(S[c][8 * s + 6], S[c][8 * s + 7]);
              const bf16x8 pk = __builtin_bit_cast(bf16x8, pw);
#pragma unroll
              for (int db = 0; db < 2; ++db) { const s16x4 lo = vtr(vb + (c * 32 + 16 * s) * VP + db * 64), h4 = vtr(vb + (c * 32 + 16 * s + 8) * VP + db * 64);
                  const bf16x8 vf = (bf16x8){lo[0], lo[1], lo[2], lo[3], h4[0], h4[1], h4[2], h4[3]};
                  O[db] = __builtin_amdgcn_mfma_f32_32x32x16_bf16(vf, pk, O[db], 0, 0, 0); } } }
    const float rl = 1.0f / l;
    const int p = p0 + wid * 32 + r32, bb = p >> 13, pp = p & 8191, rr = pp >> (13 - sh), ii = pp & Lm1; const int tok = (bb << 13) + (ii << sh) + rr;
    bf16* orow = og + gofs + (size_t)tok * 512 + h * 64 + 4 * hi;
#pragma unroll
    for (int db = 0; db < 2; ++db)
#pragma unroll
        for (int k4 = 0; k4 < 4; ++k4) { v2u w; w.x = cvtpk(O[db][4 * k4] * rl, O[db][4 * k4 + 1] * rl); w.y = cvtpk(O[db][4 * k4 + 2] * rl, O[db][4 * k4 + 3] * rl);
            *(v2u*)(orow + 32 * db + 8 * k4) = w; }
    if (hi == 0) lse[(size_t)g * ((size_t)M * 8) + (size_t)tok * 8 + h] = mx + __builtin_amdgcn_logf(l);
    __syncthreads();
}
}
namespace attn_b2 {
constexpr int KBUF = 8192, VBUF = 16384, NKS = 4, NVS = 5, L_K = 0, L_V = NKS * KBUF, L_END = NKS * KBUF + NVS * VBUF;
typedef __attribute__((address_space(3))) const char* lds_cptr;
using attn_a::vtr; using attn_a::cvtpk;
__device__ __forceinline__ void glds16(const void* gsrc, unsigned lds_dst) { unsigned keep;
    asm volatile("s_mov_b32 %0, m0\n\ts_mov_b32 m0, %2\n\ts_nop 0\n\tglobal_load_lds_dwordx4 %1, off\n\ts_mov_b32 m0, %0" : "=&s"(keep) : "v"(gsrc), "s"(lds_dst) : "memory"); }
template <int THR> __device__ __forceinline__ void unit(int qb, const bf16* Q, const bf16* K, const bf16* V, bf16* O, attn_body::lds_fptr tab, LAS unsigned char* lds) {
    const int tid = threadIdx.x, lane = tid & 63, r32 = lane & 31, hi = lane >> 5; const int wid = __builtin_amdgcn_readfirstlane(tid >> 6);
    const int q0 = qb * 256, NT = 4 * qb + 4, qrel = wid * 32 + r32;
    const unsigned lds0 = (unsigned)(uintptr_t)lds;
    const int krow = 8 * wid + (lane >> 3), kc = (lane & 7) ^ ((krow >> 1) & 7);
    const bf16* ksrc = K + krow * 64 + kc * 8;
    const int vrow0 = 8 * wid + (lane >> 4), vrow1 = vrow0 + 4, vc0 = (lane & 15) ^ ((vrow0 & 3) << 2), vc1 = (lane & 15) ^ ((vrow1 & 3) << 2);
    const bf16* vsrc0 = V + vrow0 * 128 + vc0 * 8; const bf16* vsrc1 = V + vrow1 * 128 + vc1 * 8;
    const unsigned kdst = lds0 + L_K + wid * 1024, vdst = lds0 + L_V + wid * 2048;
#define B2_DMA(tile, ks, vs) do { const int tt_ = (tile) < NT ? (tile) : NT - 1; \
        glds16(ksrc + (size_t)tt_ * 4096, (unsigned)__builtin_amdgcn_readfirstlane(kdst + (ks) * KBUF)); \
        glds16(vsrc0 + (size_t)tt_ * 8192, (unsigned)__builtin_amdgcn_readfirstlane(vdst + (vs) * VBUF)); \
        glds16(vsrc1 + (size_t)tt_ * 8192, (unsigned)__builtin_amdgcn_readfirstlane(vdst + (vs) * VBUF + 1024)); } while (0)
#define B2_WAITBAR(n) asm volatile("s_waitcnt vmcnt(" #n ") lgkmcnt(0)\n\ts_barrier" ::: "memory")
    B2_DMA(0, 0, 0); B2_DMA(1, 1, 1); B2_DMA(2, 2, 2);
    bf16x8 qr[4];
    { const bf16* qrow = Q + (size_t)(q0 + qrel) * 64 + hi * 8;
#pragma unroll
      for (int d0 = 0; d0 < 4; ++d0) qr[d0] = *(const bf16x8*)(qrow + d0 * 16); }
    asm volatile("s_waitcnt vmcnt(0)" ::: "memory");
    B2_WAITBAR(0);
    float m = 0.f, l = 0.f;
    f32x16 negm = f32x16{};
    f32x16 Oa[4]; Oa[0] = f32x16{}; Oa[1] = f32x16{}; Oa[2] = f32x16{}; Oa[3] = f32x16{};
    bf16x8 pk[4];
    const int sw = (r32 >> 1) & 7;
    int aK[4];
#pragma unroll
    for (int d0 = 0; d0 < 4; ++d0) aK[d0] = L_K + r32 * 128 + (((2 * d0 + hi) ^ sw) << 4);
    const int q4 = (lane & 15) >> 2, blk = (lane >> 4) & 1, p = lane & 3;
    int aV[4];
#pragma unroll
    for (int db = 0; db < 4; ++db) aV[db] = L_V + (4 * hi + q4) * 256 + ((((db ^ q4) << 2) + blk * 2 + (p >> 1)) << 4) + (p & 1) * 8;
    const lds_cptr L3 = (lds_cptr)lds;
    int ks = 0, vs = 0;
#define B2_PV(vslot) do { const int vo_ = (vslot) * VBUF; \
_Pragma("unroll") \
        for (int s = 0; s < 4; ++s) \
_Pragma("unroll") \
            for (int db = 0; db < 4; ++db) { const s16x4 lo = vtr(L3 + aV[db] + vo_ + s * 4096), h4 = vtr(L3 + aV[db] + vo_ + s * 4096 + 2048); \
                const bf16x8 vf = (bf16x8){lo[0], lo[1], lo[2], lo[3], h4[0], h4[1], h4[2], h4[3]}; \
                Oa[db] = __builtin_amdgcn_mfma_f32_32x32x16_bf16(vf, pk[s], Oa[db], 0, 0, 0); } } while (0)
#define MX3(a, b, c) __builtin_fmaxf(__builtin_fmaxf((a), (b)), (c))
#define B2_STEP(t, HASPREV) do { \
        { const int k3 = (ks + 3) & 3; int v3 = vs + 3; v3 = v3 >= NVS ? v3 - NVS : v3; B2_DMA((t) + 3, k3, v3); } \
        f32x16 p0 = negm, p1 = negm; \
_Pragma("unroll") \
        for (int d0 = 0; d0 < 4; ++d0) { const bf16x8 kf0 = *(const LAS bf16x8*)(lds + aK[d0] + ks * KBUF), kf1 = *(const LAS bf16x8*)(lds + aK[d0] + ks * KBUF + 4096); \
            p0 = __builtin_amdgcn_mfma_f32_32x32x16_bf16(kf0, qr[d0], p0, 0, 0, 0); p1 = __builtin_amdgcn_mfma_f32_32x32x16_bf16(kf1, qr[d0], p1, 0, 0, 0); } \
        if ((t) >= NT - 6) attn_body::bmask(p0, p1, (t) - (NT - 4), qrel, hi, tab); \
        float ra = MX3(p0[0], p0[1], p1[0]), rb = MX3(p0[2], p0[3], p1[1]); ra = MX3(ra, p1[2], p1[3]); \
_Pragma("unroll") \
        for (int i = 4; i < 16; i += 4) { ra = MX3(ra, p0[i], p0[i + 1]); rb = MX3(rb, p0[i + 2], p0[i + 3]); ra = MX3(ra, p1[i], p1[i + 1]); rb = MX3(rb, p1[i + 2], p1[i + 3]); } \
        float rm = fmaxf(ra, rb); rm = fmaxf(rm, __shfl_xor(rm, 32)); \
        const bool resc = !(HASPREV) || __any(rm > (float)THR); \
        float al = 1.f; \
        if (resc) { const float dl = (HASPREV) ? fmaxf(rm, 0.f) : rm; m += dl; if (HASPREV) { al = __builtin_amdgcn_exp2f(-dl); l *= al; } \
_Pragma("unroll") \
            for (int i = 0; i < 16; ++i) { p0[i] -= dl; p1[i] -= dl; negm[i] = -m; } } \
        float sum = 0.f; \
_Pragma("unroll") \
        for (int i = 0; i < 16; ++i) { p0[i] = __builtin_amdgcn_exp2f(p0[i]); p1[i] = __builtin_amdgcn_exp2f(p1[i]); sum += p0[i] + p1[i]; } \
        l += sum; \
        if (HASPREV) { const int vp_ = vs == 0 ? NVS - 1 : vs - 1; B2_PV(vp_); } \
        if (resc) { \
_Pragma("unroll") \
            for (int db = 0; db < 4; ++db) \
_Pragma("unroll") \
                for (int i = 0; i < 16; ++i) Oa[db][i] *= al; } \
_Pragma("unroll") \
        for (int s = 0; s < 2; ++s) { v4u w0, w1; \
            w0.x = cvtpk(p0[8 * s], p0[8 * s + 1]); w0.y = cvtpk(p0[8 * s + 2], p0[8 * s + 3]); w0.z = cvtpk(p0[8 * s + 4], p0[8 * s + 5]); w0.w = cvtpk(p0[8 * s + 6], p0[8 * s + 7]); \
            w1.x = cvtpk(p1[8 * s], p1[8 * s + 1]); w1.y = cvtpk(p1[8 * s + 2], p1[8 * s + 3]); w1.z = cvtpk(p1[8 * s + 4], p1[8 * s + 5]); w1.w = cvtpk(p1[8 * s + 6], p1[8 * s + 7]); \
            pk[s] = __builtin_bit_cast(bf16x8, w0); pk[2 + s] = __builtin_bit_cast(bf16x8, w1); } \
        ks = (ks + 1) & 3; vs = vs + 1 == NVS ? 0 : vs + 1; \
        B2_WAITBAR(6); \
    } while (0)
    B2_STEP(0, false);
    for (int t = 1; t < NT; ++t) B2_STEP(t, true);
    { const int vp_ = vs == 0 ? NVS - 1 : vs - 1; B2_PV(vp_); }
#undef B2_STEP
#undef MX3
#undef B2_PV
#undef B2_DMA
    l += __shfl_xor(l, 32);
    const float rl = 1.0f / l;
    bf16* orow = O + (size_t)(q0 + qrel) * 1024 + 4 * hi;
#pragma unroll
    for (int db = 0; db < 4; ++db)
#pragma unroll
        for (int k4 = 0; k4 < 4; ++k4) { v2u w; w.x = cvtpk(Oa[db][4 * k4] * rl, Oa[db][4 * k4 + 1] * rl); w.y = cvtpk(Oa[db][4 * k4 + 2] * rl, Oa[db][4 * k4 + 3] * rl);
            *(v2u*)(orow + 32 * db + 8 * k4) = w; }
    B2_WAITBAR(0);
#undef B2_WAITBAR
}
}

#define XB_TMO      128
#define XB_XCNT(j)  (256  + 64 * (j))
#define XB_XSUB(j)  (1280 + 64 * (j))
#define XB_XGEN(j)  (2304 + 64 * (j))
#define XB_TOP      3328
#define XB_TOPGEN   3392
#define XCD_BAR_WORDS 3456
#define XB_SPIN_CAP (1u << 18)

__device__ __forceinline__ unsigned xb_ld(unsigned* p)              { return __hip_atomic_load(p, __ATOMIC_RELAXED, __HIP_MEMORY_SCOPE_AGENT); }
__device__ __forceinline__ unsigned xb_add(unsigned* p, unsigned v) { return __hip_atomic_fetch_add(p, v, __ATOMIC_RELAXED, __HIP_MEMORY_SCOPE_AGENT); }
__device__ __forceinline__ unsigned xb_xcc_id() { return (unsigned)__builtin_amdgcn_s_getreg((3 << 11) | 20) & 0xFu; }
#define XB_SPIN(cond, bar) do { unsigned _sp = 0; while (cond) { __builtin_amdgcn_s_sleep(1); \
    if ((++_sp & 255u) == 0u) { if (xb_ld(&(bar)[XB_TMO])) break; if (_sp > XB_SPIN_CAP) { atomicAdd(&(bar)[XB_TMO], 1u); break; } } } } while (0)

struct XcdBarrier {
    unsigned* bar; unsigned x;
    volatile LAS unsigned* st;
};

__device__ __forceinline__ XcdBarrier xcd_barrier_post(unsigned* bar, volatile LAS unsigned* st) {
    XcdBarrier b; b.bar = bar; b.x = xb_xcc_id(); b.st = st;
    if (threadIdx.x == 0) (void)xb_add(&bar[XB_XCNT(b.x)], 1u);
    return b;
}
__device__ __forceinline__ void xcd_barrier_complete(unsigned* bar, unsigned x, unsigned& nloc, unsigned& nx) {
    const unsigned G = gridDim.x * gridDim.y * gridDim.z;
    unsigned sum, cnt, mine, sp = 0u;
    for (;;) {
        sum = 0u; cnt = 0u; mine = 0u;
#pragma unroll
        for (unsigned j = 0; j < 16; ++j) { const unsigned c = xb_ld(&bar[XB_XCNT(j)]); sum += c; cnt += (c > 0u) ? 1u : 0u; mine = (j == x) ? c : mine; }
        if (sum == G) break;
        __builtin_amdgcn_s_sleep(1);
        if ((++sp & 255u) == 0u) { if (xb_ld(&bar[XB_TMO])) break; if (sp > XB_SPIN_CAP) { atomicAdd(&bar[XB_TMO], 1u); break; } }
    }
    nloc = mine > 0u ? mine : 1u; nx = cnt > 0u ? cnt : 1u;
}

__device__ __forceinline__ void xcd_barrier(const XcdBarrier& b) {
    asm volatile("s_waitcnt vmcnt(0)" ::: "memory");
    __syncthreads();
    if (threadIdx.x == 0) {
        unsigned* bar = b.bar;
        __builtin_amdgcn_s_waitcnt(0);
        unsigned nloc = b.st[0], nx = b.st[1];
        if (nloc == 0u) { xcd_barrier_complete(bar, b.x, nloc, nx); b.st[0] = nloc; b.st[1] = nx; }
        const unsigned old = xb_add(&bar[XB_XSUB(b.x)], 1u);
        const unsigned gen = old / nloc;
        if (old + 1u == (gen + 1u) * nloc) {
            __builtin_amdgcn_fence(__ATOMIC_RELEASE, "agent");
            asm volatile("s_waitcnt vmcnt(0)" ::: "memory");
            const unsigned og = xb_add(&bar[XB_TOP], 1u);
            const unsigned tg = og / nx;
            if (og + 1u == (tg + 1u) * nx) xb_add(&bar[XB_TOPGEN], 1u);
            else XB_SPIN(xb_ld(&bar[XB_TOPGEN]) == tg, bar);
            __builtin_amdgcn_fence(__ATOMIC_ACQUIRE, "agent");
            xb_add(&bar[XB_XGEN(b.x)], 1u);
            asm volatile("s_waitcnt vmcnt(0)" ::: "memory");
        } else {
            XB_SPIN(xb_ld(&bar[XB_XGEN(b.x)]) == gen, bar);
            __builtin_amdgcn_fence(__ATOMIC_ACQUIRE, "agent");
            asm volatile("s_waitcnt vmcnt(0)" ::: "memory");
        }
    }
    __syncthreads();
}

constexpr int NPHASE = 12;
#ifndef MK_N_LAUNCHES
#define MK_N_LAUNCHES 1
#endif
struct Args { const float* in[18]; float* out; unsigned char* ws; int ph_lo, ph_hi; };
__device__ __forceinline__ void ln_rows(const float* zin, float* fout, bf16* bout, const float* gam, const float* bet, int gw, int ngw, int lane) {
    f32x4 gv[4], bv[4];
#pragma unroll
    for (int j = 0; j < 4; ++j) { gv[j] = *(const f32x4*)(gam + 4 * (64 * j + lane)); bv[j] = *(const f32x4*)(bet + 4 * (64 * j + lane)); }
    for (int m0 = gw; m0 < M; m0 += 2 * ngw) {
        f32x4 v[2][4]; float s1[2] = {0.f, 0.f};
#pragma unroll
        for (int r = 0; r < 2; ++r) { const f32x4* xr = (const f32x4*)(zin + (size_t)(m0 + r * ngw) * 1024) + lane;
#pragma unroll
            for (int j = 0; j < 4; ++j) v[r][j] = xr[64 * j]; }
#pragma unroll
        for (int r = 0; r < 2; ++r)
#pragma unroll
            for (int j = 0; j < 4; ++j) s1[r] += (v[r][j].x + v[r][j].y) + (v[r][j].z + v[r][j].w);
        float rstd[2];
#pragma unroll
        for (int r = 0; r < 2; ++r) { const float mean = wave_sum(s1[r]) * (1.f / 1024.f); float s2 = 0.f;
#pragma unroll
            for (int j = 0; j < 4; ++j) { v[r][j] = v[r][j] - mean; s2 += (v[r][j].x * v[r][j].x + v[r][j].y * v[r][j].y) + (v[r][j].z * v[r][j].z + v[r][j].w * v[r][j].w); }
            rstd[r] = 1.f / sqrtf(wave_sum(s2) * (1.f / 1024.f) + LN_EPS); }
#pragma unroll
        for (int r = 0; r < 2; ++r) { const size_t m = (size_t)(m0 + r * ngw); f32x4* fo = (f32x4*)(fout + m * 1024) + lane;
#pragma unroll
            for (int j = 0; j < 4; ++j) { v[r][j] = v[r][j] * rstd[r] * gv[j] + bv[j]; fo[64 * j] = v[r][j]; }
            if (bout) { v2u* bo = (v2u*)(bout + m * 1024) + lane;
#pragma unroll
                for (int j = 0; j < 4; ++j) { v2u w; w.x = pk2(v[r][j].x, v[r][j].y); w.y = pk2(v[r][j].z, v[r][j].w); bo[64 * j] = w; } } }
    }
}

__global__ void __launch_bounds__(512, 2) fwd_mega(Args args) {
    extern __shared__ __attribute__((aligned(16))) unsigned char lds[];
    cg::grid_group grid = cg::this_grid();
    LAS unsigned char* L = (LAS unsigned char*)lds;
    volatile LAS unsigned* bst = (volatile LAS unsigned*)(L + LDS_BYTES - 16);
    if (threadIdx.x < 2) bst[threadIdx.x] = 0u;
    __syncthreads();
    const XcdBarrier xbar = xcd_barrier_post((unsigned*)(args.ws + WS_CTL), bst);
    grid.sync();
#define TIDS const int tid = threadIdx.x, lane = tid & 63, wave = __builtin_amdgcn_readfirstlane(tid >> 6); (void)tid; (void)lane; (void)wave
#define GRIDV const int G = gridDim.x, bx = blockIdx.x, vcu = (bx & 7) * (G >> 3) + (bx >> 3); (void)vcu
#define WSP(name, off) bf16* name = (bf16*)(args.ws + (off))
#define IN(k) (args.ph_lo <= (k) && (k) < args.ph_hi)
#define SEAM(k) do { if (IN(k) && IN((k) + 1)) xcd_barrier(xbar); } while (0)

    if (IN(0)) {
        TIDS; GRIDV; const int gw = vcu * 8 + wave, ngw = G * 8; const float* x = args.in[0];
        WSP(WinT, WS_WIN); WSP(WpaT, WS_WPA); WSP(WpbT, WS_WPB); WSP(WoT, WS_WO); WSP(W1T, WS_W1); WSP(W2T, WS_W2); WSP(XB, WS_XB);
        LAS float* scr = (LAS float*)(L + wave * 16384);
        constexpr int I_IN = 16 * 304, I_PA = 8 * 32, I_PB = 16 * 32, I_O = 16 * 32, I_1 = 16 * 128, I_2 = 64 * 32;
        constexpr int NITEMS = I_IN + I_PA + I_PB + I_O + I_1 + I_2;
        for (int it = gw; it < NITEMS; it += ngw) {
            int r = it;
            if (r < I_IN) { p0_transpose_item(args.in[1], 1024, 9728, WinT, scr, r, lane); continue; } r -= I_IN;
            if (r < I_PA) { p0_transpose_item(args.in[9], 512, 1024, WpaT, scr, r, lane); continue; } r -= I_PA;
            if (r < I_PB) { p0_transpose_item(args.in[10], 1024, 1024, WpbT, scr, r, lane); continue; } r -= I_PB;
            if (r < I_O) { p0_transpose_item(args.in[11], 1024, 1024, WoT, scr, r, lane); continue; } r -= I_O;
            if (r < I_1) { p0_transpose_item(args.in[16], 1024, 4096, W1T, scr, r, lane); continue; } r -= I_1;
            p0_transpose_item(args.in[17], 4096, 1024, W2T, scr, r, lane);
        }
        for (int m = gw; m < M; m += ngw) {
            const f32x4* xr = (const f32x4*)(x + (size_t)m * 1024) + lane; v2u* bo = (v2u*)(XB + (size_t)m * 1024) + lane;
#pragma unroll
            for (int j = 0; j < 4; ++j) { const f32x4 v = xr[64 * j]; v2u w; w.x = pk2(v.x, v.y); w.y = pk2(v.z, v.w); bo[64 * j] = w; }
        }
    }
    SEAM(0);
    if (IN(1)) {
        GRIDV; WSP(XB, WS_XB); WSP(WinT, WS_WIN); WSP(QA, WS_R1);
        pg8::Gemm g{XB, WinT, M, COLS_A, 1024}; pg8::StaticOrder S; S.init(M, COLS_A, G, bx);
        pg8::EpiA E{QA};
        pg8::gemm_phase<pg8::EpiA, pg8::StaticOrder, true, true>(L, g, S, E);
    }
    SEAM(1);
    if (IN(2)) {
        GRIDV; WSP(QA, WS_R1); WSP(OG, WS_OG); float* LSE = (float*)(args.ws + WS_LSE);
        const bf16* KA = QA + (size_t)3 * M * 512; const bf16* VA = KA + (size_t)3 * M * 512;
        for (int u = vcu; u < 3072; u += G) attn_a::unit(u >> 10, (u >> 7) & 7, u & 127, QA, KA, VA, OG, LSE, args.in[8], L);
    }
    SEAM(2);
    if (IN(3)) {
        { TIDS; GRIDV; const int gw = vcu * 8 + wave, ngw = G * 8; WSP(OG, WS_OG); const float* LSE = (const float*)(args.ws + WS_LSE); WSP(OA, WS_OA);
          for (int m = gw; m < M; m += ngw) {
            { const int hh = lane >> 3; float l0 = LSE[(size_t)m * 8 + hh], l1 = LSE[(size_t)M * 8 + (size_t)m * 8 + hh], l2 = LSE[(size_t)2 * M * 8 + (size_t)m * 8 + hh];
              const float mx = fmaxf(l0, fmaxf(l1, l2)); float w0 = exp2f(l0 - mx), w1 = exp2f(l1 - mx), w2 = exp2f(l2 - mx); const float rs = 1.f / (w0 + w1 + w2); w0 *= rs; w1 *= rs; w2 *= rs;
              const v4u a = *(const v4u*)(OG + (size_t)m * 512 + lane * 8), b = *(const v4u*)(OG + (size_t)M * 512 + (size_t)m * 512 + lane * 8), c = *(const v4u*)(OG + (size_t)2 * M * 512 + (size_t)m * 512 + lane * 8);
              v4u o;
              o.x = pk2(w0 * blo(a.x) + w1 * blo(b.x) + w2 * blo(c.x), w0 * bhi(a.x) + w1 * bhi(b.x) + w2 * bhi(c.x));
              o.y = pk2(w0 * blo(a.y) + w1 * blo(b.y) + w2 * blo(c.y), w0 * bhi(a.y) + w1 * bhi(b.y) + w2 * bhi(c.y));
              o.z = pk2(w0 * blo(a.z) + w1 * blo(b.z) + w2 * blo(c.z), w0 * bhi(a.z) + w1 * bhi(b.z) + w2 * bhi(c.z));
              o.w = pk2(w0 * blo(a.w) + w1 * blo(b.w) + w2 * blo(c.w), w0 * bhi(a.w) + w1 * bhi(b.w) + w2 * bhi(c.w));
              *(v4u*)(OA + (size_t)m * 512 + lane * 8) = o; }
          } }
        GRIDV; WSP(XB, WS_XB); WSP(WinT, WS_WIN); WSP(QB, WS_QB);
        pg8::Gemm g{XB, WinT + (size_t)COLS_A * 1024, M, 3072, 1024}; pg8::StaticOrder S; S.init(M, 3072, G, bx);
        pg8::EpiB E{QB};
        pg8::gemm_phase<pg8::EpiB, pg8::StaticOrder, true, true>(L, g, S, E);
    }
    SEAM(3);
    if (IN(4)) {
        TIDS; GRIDV; WSP(QB, WS_QB); WSP(O1, WS_O1); WSP(O2, WS_O2);
        LAS float* btab = (LAS float*)(L + 116736);
        const float* rb = args.in[8];
        for (int i = tid; i < 8 * 640; i += 512) { const int hh = i / 640, d = i - hh * 640 - 255;
            btab[i] = d < 0 ? -INFINITY : (d < 128 ? (rb[t5_bucket(d) * 32 + 24 + hh] - rb[31 * 32 + 24 + hh]) * LOG2E : 0.f); }
        __syncthreads();
        const bf16* KB = QB + (size_t)M * 1024; const bf16* VB = KB + (size_t)M * 1024;
        for (int i = 0; i < 8; ++i) {
            const int sq = (vcu >> 3) * 2 + (i >> 2), k = i & 3, s = vcu & 7;
            const int qb = (k == 0) ? s : (k == 1) ? 15 - s : (k == 2) ? 16 + s : 31 - s;
            const int mp = sq & 1, hh = (sq >> 1) & 7, bb = sq >> 4;
            const size_t rb0 = (size_t)bb * SEQ * 1024;
            const size_t qk0 = (size_t)((bb * 16 + mp * 8 + hh) * SEQ) * 64, v0 = (size_t)((bb * 8 + hh) * SEQ) * 128;
            attn_b2::unit<8>(qb, QB + qk0, KB + qk0, VB + v0, (mp ? O2 : O1) + rb0 + hh * 128, (attn_body::lds_fptr)(btab + hh * 640), L);
        }
    }
    SEAM(4);
    if (IN(5)) {
        { TIDS; GRIDV; const int gw = vcu * 8 + wave, ngw = G * 8; WSP(O1, WS_O1); WSP(O2, WS_O2); WSP(OB, WS_OB);
          const float d1 = wave_sum(args.in[3][lane] * args.in[4][lane]), d2 = wave_sum(args.in[5][lane] * args.in[6][lane]);
          const float lam = expf(d1) - expf(d2) + 0.2f;
          const float* sg = args.in[7] + (lane & 7) * 16;
          float gsc[16];
#pragma unroll
          for (int e = 0; e < 16; ++e) gsc[e] = sg[e] * 0.8f;
          for (int m = gw; m < M; m += ngw) {
            { const v4u a0 = *(const v4u*)(O1 + (size_t)m * 1024 + lane * 16), a1 = *(const v4u*)(O1 + (size_t)m * 1024 + lane * 16 + 8);
              const v4u b0 = *(const v4u*)(O2 + (size_t)m * 1024 + lane * 16), b1 = *(const v4u*)(O2 + (size_t)m * 1024 + lane * 16 + 8);
              float d[16];
              d[0] = blo(a0.x) - lam * blo(b0.x); d[1] = bhi(a0.x) - lam * bhi(b0.x); d[2] = blo(a0.y) - lam * blo(b0.y); d[3] = bhi(a0.y) - lam * bhi(b0.y);
              d[4] = blo(a0.z) - lam * blo(b0.z); d[5] = bhi(a0.z) - lam * bhi(b0.z); d[6] = blo(a0.w) - lam * blo(b0.w); d[7] = bhi(a0.w) - lam * bhi(b0.w);
              d[8] = blo(a1.x) - lam * blo(b1.x); d[9] = bhi(a1.x) - lam * bhi(b1.x); d[10] = blo(a1.y) - lam * blo(b1.y); d[11] = bhi(a1.y) - lam * bhi(b1.y);
              d[12] = blo(a1.z) - lam * blo(b1.z); d[13] = bhi(a1.z) - lam * bhi(b1.z); d[14] = blo(a1.w) - lam * blo(b1.w); d[15] = bhi(a1.w) - lam * bhi(b1.w);
              float ss = 0.f;
#pragma unroll
              for (int e = 0; e < 16; ++e) ss += d[e] * d[e];
              ss += __shfl_xor(ss, 1); ss += __shfl_xor(ss, 2); ss += __shfl_xor(ss, 4);
              const float rn = 1.f / sqrtf(ss * (1.f / 128.f) + LN_EPS);
              v4u o0, o1;
              o0.x = pk2(d[0] * rn * gsc[0], d[1] * rn * gsc[1]); o0.y = pk2(d[2] * rn * gsc[2], d[3] * rn * gsc[3]); o0.z = pk2(d[4] * rn * gsc[4], d[5] * rn * gsc[5]); o0.w = pk2(d[6] * rn * gsc[6], d[7] * rn * gsc[7]);
              o1.x = pk2(d[8] * rn * gsc[8], d[9] * rn * gsc[9]); o1.y = pk2(d[10] * rn * gsc[10], d[11] * rn * gsc[11]); o1.z = pk2(d[12] * rn * gsc[12], d[13] * rn * gsc[13]); o1.w = pk2(d[14] * rn * gsc[14], d[15] * rn * gsc[15]);
              *(v4u*)(OB + (size_t)m * 1024 + lane * 16) = o0; *(v4u*)(OB + (size_t)m * 1024 + lane * 16 + 8) = o1; }
          } }
        GRIDV; WSP(XB, WS_XB); WSP(WinT, WS_WIN); WSP(GATES, WS_GATES);
        pg8::Gemm g{XB, WinT + (size_t)7680 * 1024, M, 2048, 1024}; pg8::StaticOrder S; S.init(M, 2048, G, bx);
        pg8::EpiSig E{GATES, args.in[2]};
        pg8::gemm_phase<pg8::EpiSig, pg8::StaticOrder, true, true>(L, g, S, E);
    }
    SEAM(5);
    if (IN(6)) {
        GRIDV; WSP(OA, WS_OA); WSP(OB, WS_OB); WSP(WpaT, WS_WPA); WSP(WpbT, WS_WPB); WSP(TMP, WS_TMP); WSP(MERGED, WS_MERGED); WSP(GATES, WS_GATES);
        { pg8::Gemm g{OA, WpaT, M, 1024, 512}; pg8::StaticOrder S; S.init(M, 1024, G, bx);
          pg8::EpiGate<false> E{GATES, nullptr, TMP};
          pg8::gemm_phase<pg8::EpiGate<false>, pg8::StaticOrder, true, true>(L, g, S, E); }
        { pg8::Gemm g{OB, WpbT, M, 1024, 1024}; pg8::StaticOrder S; S.init(M, 1024, G, bx);
          pg8::EpiGate<true> E{GATES + 1024, TMP, MERGED};
          pg8::gemm_phase<pg8::EpiGate<true>, pg8::StaticOrder, true, true>(L, g, S, E); }
    }
    SEAM(6);
    if (IN(7)) {
        GRIDV; WSP(MERGED, WS_MERGED); WSP(WoT, WS_WO); const float* x = args.in[0]; float* Z = (float*)(args.ws + WS_Z);
        pg8::Gemm g{MERGED, WoT, M, 1024, 1024}; pg8::StaticOrder S; S.init(M, 1024, G, bx);
        pg8::EpiZ E{x, Z, DN_ALPHA};
        pg8::gemm_phase<pg8::EpiZ, pg8::StaticOrder, true, true>(L, g, S, E);
    }
    SEAM(7);
    if (IN(8)) { TIDS; GRIDV; WSP(X1B, WS_X1B); float* Z = (float*)(args.ws + WS_Z); ln_rows(Z, Z, X1B, args.in[12], args.in[13], vcu * 8 + wave, G * 8, lane); }
    SEAM(8);
    if (IN(9)) {
        GRIDV; WSP(X1B, WS_X1B); WSP(W1T, WS_W1); WSP(HB, WS_H);
        pg8::Gemm g{X1B, W1T, M, FF, 1024}; pg8::StaticOrder S; S.init(M, FF, G, bx);
        pg8::EpiRelu2 E{HB};
        pg8::gemm_phase<pg8::EpiRelu2, pg8::StaticOrder, true, true>(L, g, S, E);
    }
    SEAM(9);
    if (IN(10)) {
        GRIDV; WSP(HB, WS_H); WSP(W2T, WS_W2);
        pg8::Gemm g{HB, W2T, M, 1024, FF}; pg8::StaticOrder S; S.init(M, 1024, G, bx);
        float* Z = (float*)(args.ws + WS_Z); pg8::EpiZ E{Z, Z, DN_ALPHA};
        pg8::gemm_phase<pg8::EpiZ, pg8::StaticOrder, true, true>(L, g, S, E);
    }
    SEAM(10);
    if (IN(11)) { TIDS; GRIDV; const float* Z = (const float*)(args.ws + WS_Z); ln_rows(Z, args.out, nullptr, args.in[14], args.in[15], vcu * 8 + wave, G * 8, lane); }
#undef IN
#undef SEAM
}

extern "C" void kernel_launch(void* const* d_in, const int* in_sizes, int n_in, void* d_out, int out_size, void* d_ws, size_t ws_size, hipStream_t stream) {
    static int grid = 0;
    if (grid == 0) {
        if (n_in != 18 || in_sizes[0] != M * DMODEL || out_size != M * DMODEL || ws_size < WS_END) { fprintf(stderr, "kernel_launch: unexpected shapes (n_in %d, x %d, out %d, ws %zu)\n", n_in, n_in > 0 ? in_sizes[0] : -1, out_size, ws_size); grid = -1; return; }
        int dev = 0, cus = 0, per_cu = 0;
        hipGetDevice(&dev); hipDeviceGetAttribute(&cus, hipDeviceAttributeMultiprocessorCount, dev);
        if (hipFuncSetAttribute((const void*)fwd_mega, hipFuncAttributeMaxDynamicSharedMemorySize, LDS_BYTES) != hipSuccess) { fprintf(stderr, "kernel_launch: hipFuncSetAttribute failed\n"); grid = -1; return; }
        if (hipOccupancyMaxActiveBlocksPerMultiprocessor(&per_cu, (const void*)fwd_mega, 512, LDS_BYTES) != hipSuccess || per_cu < 1) { fprintf(stderr, "kernel_launch: occupancy query says %d\n", per_cu); per_cu = 1; }
        (void)hipGetLastError();
        grid = cus * 1;
    }
    if (grid < 0) return;
    if (hipMemsetAsync((char*)d_ws + WS_CTL, 0, CTL_BYTES, stream) != hipSuccess) { fprintf(stderr, "kernel_launch: memset of the barrier words failed\n"); return; }
    Args a{};
    for (int i = 0; i < 18; ++i) a.in[i] = (const float*)d_in[i];
    a.out = (float*)d_out; a.ws = (unsigned char*)d_ws;
    constexpr int NL = MK_N_LAUNCHES;
    for (int li = 0; li < NL; ++li) {
        a.ph_lo = (NL == 1) ? 0 : li; a.ph_hi = (NL == 1) ? NPHASE : li + 1;
        void* kargs[] = {&a};
        const hipError_t e = hipLaunchCooperativeKernel((const void*)fwd_mega, dim3(grid), dim3(512), kargs, LDS_BYTES, stream);
        if (e != hipSuccess) { fprintf(stderr, "kernel_launch: cooperative launch %d failed: %s (grid %d)\n", li, hipGetErrorString(e), grid); break; }
    }
}
```

```cpp
#include <hip/hip_runtime.h>
#include <hip/hip_cooperative_groups.h>
#include <cstdio>
#include <cstdint>
namespace cg = cooperative_groups;
namespace pg8 {
#define PG8_LAS __attribute__((address_space(3)))
typedef unsigned short bf16_t;
typedef short bf16x8 __attribute__((ext_vector_type(8)));
typedef float f32x4 __attribute__((ext_vector_type(4)));
typedef unsigned u32x4 __attribute__((ext_vector_type(4)));
constexpr int BM = 256, BK = 64, HALF = 128, HTB = HALF * BK * 2  , STAGE_BYTES = 8 * HTB, NXCD = 8, WGM = 8;

__host__ __device__ __forceinline__ int lds_byte(int r, int c) { const int st = (r >> 4) * 2 + (c >> 5), rr = r & 15, cc = c & 31, ob = rr * 64 + cc * 2; return st * 1024 + (ob ^ (((ob >> 9) & 1) << 5)); }
__host__ __device__ __forceinline__ void stage_rc(int b, int& R, int& C) { const int st = b / 1024, sb = b % 1024, swz = sb ^ (((sb >> 9) & 1) << 5); R = (st >> 1) * 16 + swz / 64; C = (st & 1) * 32 + (swz % 64) / 2; }
__host__ __device__ __forceinline__ int perm32(int rho) { const int n = rho >> 4, i = rho & 15; return 8 * (i >> 2) + 4 * n + (i & 3); }

struct Unit { int pm, pn; };
struct Gemm { const bf16_t* A; const bf16_t* Bt; int M, N, K; };

struct StaticOrder {
    int nM, nN, nwg, G, c;
    __host__ __device__ void init(int M, int N, int G_, int c_) { nM = M / BM; nN = N / BM; nwg = nM * nN; G = G_; c = c_; }
    __host__ __device__ bool next(int i, Unit& u) const {
        const long L = (long)i * G + c; if (L >= nwg) return false;
        int wgid = (int)L; { const int q = nwg / NXCD, r = nwg % NXCD, xcd = wgid % NXCD, off = wgid / NXCD; wgid = (xcd < r ? xcd * (q + 1) : r * (q + 1) + (xcd - r) * q) + off; }
        const int nig = WGM * nN, gid = wgid / nig, fm = gid * WGM, gsz = (nM - fm) < WGM ? (nM - fm) : WGM;
        u.pm = fm + ((wgid % nig) % gsz); u.pn = (wgid % nig) / gsz; return true;
    }
    __device__ __forceinline__ void a_ready(const Unit&) const {}
    __device__ __forceinline__ void done(const Unit&) const {}
};

__device__ __forceinline__ unsigned cvt_pk_bf16(float lo, float hi) { unsigned r; asm volatile("v_cvt_pk_bf16_f32 %0, %1, %2" : "=v"(r) : "v"(lo), "v"(hi)); return r; }
typedef float f32x2 __attribute__((ext_vector_type(2)));
constexpr float QK_C2 = 0.125f * 1.4426950408889634f;
constexpr int MROWS = 32768;
__device__ __forceinline__ float bf_lo(unsigned w) { return __uint_as_float(w << 16); }
__device__ __forceinline__ float bf_hi(unsigned w) { return __uint_as_float(w & 0xffff0000u); }
typedef float f32x2c_t __attribute__((ext_vector_type(2))); typedef __bf16 bf16x2c_t __attribute__((ext_vector_type(2)));
__device__ __forceinline__ unsigned cvt_pk_bf16_c(float lo, float hi) { f32x2c_t v = {lo, hi}; bf16x2c_t b = __builtin_convertvector(v, bf16x2c_t); return __builtin_bit_cast(unsigned, b); }
__device__ __forceinline__ u32x4 pack8c(const f32x4 v0, const f32x4 v1) { u32x4 w; w.x = cvt_pk_bf16_c(v0[0], v0[1]); w.y = cvt_pk_bf16_c(v0[2], v0[3]); w.z = cvt_pk_bf16_c(v1[0], v1[1]); w.w = cvt_pk_bf16_c(v1[2], v1[3]); return w; }
__device__ __forceinline__ u32x4 pack8(const f32x4 v0, const f32x4 v1) { u32x4 w; w.x = cvt_pk_bf16(v0[0], v0[1]); w.y = cvt_pk_bf16(v0[2], v0[3]); w.z = cvt_pk_bf16(v1[0], v1[1]); w.w = cvt_pk_bf16(v1[2], v1[3]); return w; }
struct EpiA {
    static constexpr bool PERM = true, AFTER_DRAIN = false;
    bf16_t* base;
    __device__ __forceinline__ void operator()(const f32x4 (&acc)[2][2][4][2], const Unit& u, int wr, int wc, int fr, int fq) const {
        const int which = u.pn / 6, rem = u.pn - which * 6, g = rem >> 1, half = rem & 1, sh = 2 * g;
        const float sc = which == 0 ? QK_C2 : 1.f;
        bf16_t* b0 = base + (size_t)(which * 3 + g) * ((size_t)MROWS * 512) + half * 256 + wc * 32 + 8 * fq;
#pragma unroll
        for (int ai = 0; ai < 2; ++ai)
#pragma unroll
            for (int m = 0; m < 4; ++m) { const int row = u.pm * BM + ai * HALF + wr * 64 + m * 16 + fr; const int bb = row >> 13, t = row & 8191;
                const int pos = (bb << 13) + ((t & ((1 << sh) - 1)) << (13 - sh)) + (t >> sh);
                bf16_t* rowp = b0 + (size_t)pos * 512;
#pragma unroll
                for (int bj = 0; bj < 2; ++bj) *(u32x4*)(rowp + bj * HALF) = pack8(acc[ai][bj][m][0] * sc, acc[ai][bj][m][1] * sc); }
    }
};
struct EpiB {
    static constexpr bool PERM = true, AFTER_DRAIN = false;
    bf16_t* qkv;
    __device__ __forceinline__ void operator()(const f32x4 (&acc)[2][2][4][2], const Unit& u, int wr, int wc, int fr, int fq) const {
        const int row0 = u.pm * BM + wr * 64 + fr;
        const int which = u.pn >> 2; const float sc = which == 0 ? QK_C2 : 1.f;
        bf16_t* b0 = qkv + (size_t)which * ((size_t)MROWS * 1024);
        const int c0 = (u.pn & 3) * 256 + wc * 32 + 8 * fq;
#pragma unroll
        for (int ai = 0; ai < 2; ++ai)
#pragma unroll
            for (int m = 0; m < 4; ++m) { const int row = row0 + ai * HALF + m * 16, bb = row >> 13, t = row & 8191;
#pragma unroll
                for (int bj = 0; bj < 2; ++bj) { const int c = c0 + bj * HALF;
                    const size_t off = (which == 2) ? ((size_t)((bb * 8 + (c >> 7)) * 8192 + t) * 128 + (c & 127)) : ((size_t)((bb * 16 + (c >> 6)) * 8192 + t) * 64 + (c & 63));
                    *(u32x4*)(b0 + off) = pack8(acc[ai][bj][m][0] * sc, acc[ai][bj][m][1] * sc); } }
    }
};
struct EpiSig {
    static constexpr bool PERM = true, AFTER_DRAIN = false;
    bf16_t* gates; const float* bgate;
    __device__ __forceinline__ void operator()(const f32x4 (&acc)[2][2][4][2], const Unit& u, int wr, int wc, int fr, int fq) const {
        const int row0 = u.pm * BM + wr * 64 + fr;
        const int gc = u.pn * 256 + wc * 32 + 8 * fq;
        f32x4 bv[2][2];
#pragma unroll
        for (int bj = 0; bj < 2; ++bj)
#pragma unroll
            for (int n = 0; n < 2; ++n) bv[bj][n] = *(const f32x4*)(bgate + gc + bj * HALF + 4 * n);
#pragma unroll
        for (int ai = 0; ai < 2; ++ai)
#pragma unroll
            for (int m = 0; m < 4; ++m) { bf16_t* rowp = gates + (size_t)(row0 + ai * HALF + m * 16) * 2048 + gc;
#pragma unroll
                for (int bj = 0; bj < 2; ++bj) { f32x4 v[2];
#pragma unroll
                    for (int n = 0; n < 2; ++n) { const f32x4 x = acc[ai][bj][m][n] + bv[bj][n];
#pragma unroll
                        for (int e = 0; e < 4; ++e) v[n][e] = __builtin_amdgcn_rcpf(1.f + __builtin_amdgcn_exp2f(-1.4426950408889634f * x[e])); }
                    *(u32x4*)(rowp + bj * HALF) = pack8c(v[0], v[1]); } }
    }
};
template <bool ADD> struct EpiGate {
    static constexpr bool PERM = true, AFTER_DRAIN = false;
    const bf16_t* gates; const bf16_t* tin; bf16_t* out;
    __device__ __forceinline__ void operator()(const f32x4 (&acc)[2][2][4][2], const Unit& u, int wr, int wc, int fr, int fq) const {
        const int row0 = u.pm * BM + wr * 64 + fr, col0 = u.pn * BM + wc * 32 + 8 * fq;
#pragma unroll
        for (int ai = 0; ai < 2; ++ai) {
            u32x4 gw[4][2], tw[4][2];
#pragma unroll
            for (int m = 0; m < 4; ++m)
#pragma unroll
                for (int bj = 0; bj < 2; ++bj) { const size_t row = (size_t)(row0 + ai * HALF + m * 16);
                    gw[m][bj] = *(const u32x4*)(gates + row * 2048 + col0 + bj * HALF);
                    if (ADD) tw[m][bj] = *(const u32x4*)(tin + row * 1024 + col0 + bj * HALF); }
#pragma unroll
            for (int m = 0; m < 4; ++m)
#pragma unroll
                for (int bj = 0; bj < 2; ++bj) { const size_t row = (size_t)(row0 + ai * HALF + m * 16); const u32x4 g = gw[m][bj];
                    f32x4 v0 = acc[ai][bj][m][0], v1 = acc[ai][bj][m][1];
                    v0[0] *= bf_lo(g.x); v0[1] *= bf_hi(g.x); v0[2] *= bf_lo(g.y); v0[3] *= bf_hi(g.y);
                    v1[0] *= bf_lo(g.z); v1[1] *= bf_hi(g.z); v1[2] *= bf_lo(g.w); v1[3] *= bf_hi(g.w);
                    if (ADD) { const u32x4 t = tw[m][bj];
                        v0[0] += bf_lo(t.x); v0[1] += bf_hi(t.x); v0[2] += bf_lo(t.y); v0[3] += bf_hi(t.y);
                        v1[0] += bf_lo(t.z); v1[1] += bf_hi(t.z); v1[2] += bf_lo(t.w); v1[3] += bf_hi(t.w); }
                    *(u32x4*)(out + row * 1024 + col0 + bj * HALF) = pack8(v0, v1); }
        }
    }
};
struct EpiZ {
    static constexpr bool PERM = false, AFTER_DRAIN = false;
    const float* res; float* out; float alpha;
    __device__ __forceinline__ void operator()(const f32x4 (&acc)[2][2][4][2], const Unit& u, int wr, int wc, int fr, int fq) const {
        const int row0 = u.pm * BM + wr * 64 + fr, col0 = u.pn * BM + wc * 32 + 4 * fq;
#pragma unroll
        for (int ai = 0; ai < 2; ++ai) {
            f32x4 r[4][2][2];
#pragma unroll
            for (int m = 0; m < 4; ++m) { const size_t off = (size_t)(row0 + ai * HALF + m * 16) * 1024 + col0;
#pragma unroll
                for (int bj = 0; bj < 2; ++bj)
#pragma unroll
                    for (int n = 0; n < 2; ++n) r[m][bj][n] = *(const f32x4*)(res + off + bj * HALF + n * 16); }
#pragma unroll
            for (int m = 0; m < 4; ++m) { const size_t off = (size_t)(row0 + ai * HALF + m * 16) * 1024 + col0;
#pragma unroll
                for (int bj = 0; bj < 2; ++bj)
#pragma unroll
                    for (int n = 0; n < 2; ++n) *(f32x4*)(out + off + bj * HALF + n * 16) = r[m][bj][n] * alpha + acc[ai][bj][m][n]; }
        }
    }
};
struct EpiRelu2 {
    static constexpr bool PERM = true, AFTER_DRAIN = false;
    bf16_t* out;
    __device__ __forceinline__ void operator()(const f32x4 (&acc)[2][2][4][2], const Unit& u, int wr, int wc, int fr, int fq) const {
        const int row0 = u.pm * BM + wr * 64 + fr, col0 = u.pn * BM + wc * 32 + 8 * fq;
#pragma unroll
        for (int ai = 0; ai < 2; ++ai)
#pragma unroll
            for (int m = 0; m < 4; ++m) { bf16_t* rowp = out + (size_t)(row0 + ai * HALF + m * 16) * 4096 + col0;
#pragma unroll
                for (int bj = 0; bj < 2; ++bj) { f32x4 v0 = acc[ai][bj][m][0], v1 = acc[ai][bj][m][1];
#pragma unroll
                    for (int e = 0; e < 4; ++e) { const float a = fmaxf(v0[e], 0.f), b = fmaxf(v1[e], 0.f); v0[e] = a * a; v1[e] = b * b; }
                    *(u32x4*)(rowp + bj * HALF) = pack8(v0, v1); } }
    }
};

template <class Epi, class Sched, bool ALIGN_EPI = false, bool SP2 = false>
__device__ __forceinline__ void gemm_phase(PG8_LAS unsigned char* lds, const Gemm g, const Sched& S, const Epi& E) {
    const int tid = threadIdx.x, wid = __builtin_amdgcn_readfirstlane(tid >> 6), lane = tid & 63, wr = wid >> 2, wc = wid & 3, fr = lane & 15, fq = lane >> 4;
    const int K = g.K, nt = K / BK;
    unsigned voffA[2], voffB[2];
#pragma unroll
    for (int i = 0; i < 2; ++i) { int R, C; stage_rc(tid * 16 + i * 8192, R, C); const int Rb = Epi::PERM ? ((R & ~31) + perm32(R & 31)) : R;
        voffA[i] = (unsigned)(R * K + C) * 2u; voffB[i] = (unsigned)(Rb * K + C) * 2u; }
    const size_t kstep = (size_t)(BK * 2);
    const size_t hstep = (size_t)HALF * K * 2;
    const size_t tstep = 2 * hstep;
    const unsigned ldsw = (unsigned)wid * 1024u;
    const int aoff = lds_byte(wr * 64 + fr, fq * 8), boff = lds_byte(wc * 32 + fr, fq * 8);
#define PG8_SA(b, h) (((b) * 2 + (h)) * HTB)
#define PG8_SB(b, h) ((4 + (b) * 2 + (h)) * HTB)
#define PG8_STAGE(bufoff, gbase, voff) do { _Pragma("unroll") for (int _i = 0; _i < 2; ++_i) \
        __builtin_amdgcn_global_load_lds((const unsigned*)((const char*)(gbase) + (voff)[_i]), (PG8_LAS unsigned*)(lds + (bufoff) + ldsw + _i * 8192), 16, 0, 0); } while (0)
#define PG8_LDA(dst, b, h) do { _Pragma("unroll") for (int m = 0; m < 4; ++m) _Pragma("unroll") for (int k = 0; k < 2; ++k) dst[m][k] = *(const PG8_LAS bf16x8*)(lds + PG8_SA(b, h) + aoff + m * 2048 + k * 1024); } while (0)
#define PG8_LDB(dst, b, h) do { _Pragma("unroll") for (int n = 0; n < 2; ++n) _Pragma("unroll") for (int k = 0; k < 2; ++k) dst[n][k] = *(const PG8_LAS bf16x8*)(lds + PG8_SB(b, h) + boff + n * 2048 + k * 1024); } while (0)
#define PG8_MMA(ai, bj, At, Bt) do { __builtin_amdgcn_s_setprio(1); _Pragma("unroll") for (int m = 0; m < 4; ++m) _Pragma("unroll") for (int n = 0; n < 2; ++n) _Pragma("unroll") for (int k = 0; k < 2; ++k) \
        acc[ai][bj][m][n] = __builtin_amdgcn_mfma_f32_16x16x32_bf16(Bt[n][k], At[m][k], acc[ai][bj][m][n], 0, 0, 0); __builtin_amdgcn_s_setprio(0); } while (0)
#define PG8_WAIT_V(n) asm volatile("s_waitcnt vmcnt(" #n ")" ::: "memory")
#define PG8_WAIT_L(n) asm volatile("s_waitcnt lgkmcnt(" #n ")" ::: "memory")
#define PG8_BAR __builtin_amdgcn_s_barrier()
#define PG8_SCHED __builtin_amdgcn_sched_barrier(0)
    Unit cur, nxt; int ui = 0;
    if (!S.next(0, cur)) return;
    f32x4 acc[2][2][4][2];
#pragma unroll
    for (int a = 0; a < 2; ++a)
#pragma unroll
        for (int b = 0; b < 2; ++b)
#pragma unroll
            for (int m = 0; m < 4; ++m)
#pragma unroll
                for (int n = 0; n < 2; ++n) acc[a][b][m][n] = (f32x4){0.f, 0.f, 0.f, 0.f};
    bf16x8 At[4][2], B0[2][2], B1[2][2];
    const char* cA = (const char*)g.A + (size_t)cur.pm * tstep; const char* cB = (const char*)g.Bt + (size_t)cur.pn * tstep;
    S.a_ready(cur);
    if constexpr (SP2) {
        PG8_STAGE(PG8_SB(0, 0), cB, voffB); PG8_STAGE(PG8_SB(0, 1), cB + hstep, voffB); PG8_STAGE(PG8_SA(0, 0), cA, voffA); PG8_STAGE(PG8_SA(0, 1), cA + hstep, voffA);
        if (wr == 1) PG8_BAR;
        PG8_WAIT_V(2); PG8_BAR;
        PG8_STAGE(PG8_SB(1, 0), cB + kstep, voffB); PG8_STAGE(PG8_SA(1, 0), cA + kstep, voffA); PG8_STAGE(PG8_SB(1, 1), cB + hstep + kstep, voffB);
        PG8_WAIT_V(6); PG8_BAR;
    } else {
        PG8_STAGE(PG8_SB(0, 0), cB, voffB); PG8_STAGE(PG8_SA(0, 0), cA, voffA); PG8_STAGE(PG8_SB(0, 1), cB + hstep, voffB); PG8_STAGE(PG8_SA(0, 1), cA + hstep, voffA);
        if (wr == 1) PG8_BAR;
        PG8_WAIT_V(4); PG8_BAR;
        PG8_STAGE(PG8_SB(1, 0), cB + kstep, voffB); PG8_STAGE(PG8_SA(1, 0), cA + kstep, voffA); PG8_STAGE(PG8_SB(1, 1), cB + hstep + kstep, voffB);
        PG8_WAIT_V(6); PG8_BAR;
    }
    for (;;) {
        const bool has_next = S.next(ui + 1, nxt);
        const char* nA = has_next ? (const char*)g.A + (size_t)nxt.pm * tstep : cA; const char* nB = has_next ? (const char*)g.Bt + (size_t)nxt.pn * tstep : cB;
        for (int t = 0; t < nt; t += 2) {
            const bool last = (t == nt - 2);
            const char* a1 = cA + (size_t)(t + 1) * kstep;
            const char* a2 = last ? nA : cA + (size_t)(t + 2) * kstep; const char* b2 = last ? nB : cB + (size_t)(t + 2) * kstep;
            const char* a3 = a2 + kstep; const char* b3 = b2 + kstep;
            if (last && has_next) S.a_ready(nxt);
            if constexpr (SP2) {
            PG8_LDB(B0, 0, 0); PG8_LDB(B1, 0, 1); PG8_SCHED; PG8_LDA(At, 0, 0); PG8_STAGE(PG8_SA(1, 1), a1 + hstep, voffA);
            PG8_WAIT_V(8); PG8_WAIT_L(0); PG8_BAR; PG8_MMA(0, 0, At, B0); PG8_MMA(0, 1, At, B1); PG8_BAR; PG8_SCHED;
            PG8_LDA(At, 0, 1); PG8_STAGE(PG8_SB(0, 0), b2, voffB); PG8_STAGE(PG8_SB(0, 1), b2 + hstep, voffB); PG8_STAGE(PG8_SA(0, 0), a2, voffA);
            PG8_WAIT_V(8); PG8_WAIT_L(0); PG8_BAR; PG8_MMA(1, 0, At, B0); PG8_MMA(1, 1, At, B1); PG8_BAR; PG8_SCHED;
            PG8_LDB(B0, 1, 0); PG8_LDB(B1, 1, 1); PG8_SCHED; PG8_LDA(At, 1, 0); PG8_STAGE(PG8_SA(0, 1), a2 + hstep, voffA);
            PG8_WAIT_V(8); PG8_WAIT_L(0); PG8_BAR; PG8_MMA(0, 0, At, B0); PG8_MMA(0, 1, At, B1); PG8_BAR; PG8_SCHED;
            PG8_LDA(At, 1, 1); PG8_STAGE(PG8_SB(1, 0), b3, voffB); PG8_STAGE(PG8_SB(1, 1), b3 + hstep, voffB); PG8_STAGE(PG8_SA(1, 0), a3, voffA);
            PG8_WAIT_V(8); PG8_WAIT_L(0); PG8_BAR; PG8_MMA(1, 0, At, B0); PG8_MMA(1, 1, At, B1); PG8_BAR; PG8_SCHED;
            } else {
            PG8_LDB(B0, 0, 0); PG8_SCHED; PG8_LDA(At, 0, 0); PG8_STAGE(PG8_SA(1, 1), a1 + hstep, voffA);
            PG8_WAIT_L(8); PG8_BAR; PG8_WAIT_L(0); PG8_MMA(0, 0, At, B0); PG8_BAR; PG8_SCHED;
            PG8_LDB(B1, 0, 1); PG8_STAGE(PG8_SB(0, 0), b2, voffB);
            PG8_BAR; PG8_WAIT_L(0); PG8_MMA(0, 1, At, B1); PG8_BAR;
            PG8_LDA(At, 0, 1); PG8_STAGE(PG8_SA(0, 0), a2, voffA);
            PG8_BAR; PG8_WAIT_L(0); PG8_MMA(1, 0, At, B0); PG8_BAR; PG8_SCHED;
            PG8_STAGE(PG8_SB(0, 1), b2 + hstep, voffB);
            PG8_WAIT_V(6); PG8_BAR; PG8_MMA(1, 1, At, B1); PG8_BAR;
            PG8_LDB(B0, 1, 0); PG8_SCHED; PG8_LDA(At, 1, 0); PG8_STAGE(PG8_SA(0, 1), a2 + hstep, voffA);
            PG8_WAIT_L(8); PG8_BAR; PG8_WAIT_L(0); PG8_MMA(0, 0, At, B0); PG8_BAR; PG8_SCHED;
            PG8_LDB(B1, 1, 1); PG8_STAGE(PG8_SB(1, 0), b3, voffB);
            PG8_BAR; PG8_WAIT_L(0); PG8_MMA(0, 1, At, B1); PG8_BAR;
            PG8_LDA(At, 1, 1); PG8_STAGE(PG8_SA(1, 0), a3, voffA);
            PG8_BAR; PG8_WAIT_L(0); PG8_MMA(1, 0, At, B0); PG8_BAR; PG8_SCHED;
            PG8_STAGE(PG8_SB(1, 1), b3 + hstep, voffB);
            PG8_WAIT_V(6); PG8_BAR; PG8_MMA(1, 1, At, B1); PG8_BAR;
            }
        }
        if constexpr (ALIGN_EPI) { if (wr == 0) PG8_BAR; }
        if constexpr (!Epi::AFTER_DRAIN) { E(acc, cur, wr, wc, fr, fq); S.done(cur); }
        if (!has_next) break;
#pragma unroll
        for (int a = 0; a < 2; ++a)
#pragma unroll
            for (int b = 0; b < 2; ++b)
#pragma unroll
                for (int m = 0; m < 4; ++m)
#pragma unroll
                    for (int n = 0; n < 2; ++n) acc[a][b][m][n] = (f32x4){0.f, 0.f, 0.f, 0.f};
        cur = nxt; cA = nA; cB = nB; ++ui;
        if constexpr (ALIGN_EPI) { if (wr == 1) PG8_BAR; }
    }
    PG8_WAIT_V(0);
    if constexpr (!ALIGN_EPI) { if (wr == 0) PG8_BAR; }
    PG8_BAR;
    if constexpr (Epi::AFTER_DRAIN) { E.fused(acc, cur, wr, wc, fr, fq, lds, wid, lane); S.done(cur); }
#undef PG8_SA
#undef PG8_SB
#undef PG8_STAGE
#undef PG8_LDA
#undef PG8_LDB
#undef PG8_MMA
#undef PG8_WAIT_V
#undef PG8_WAIT_L
#undef PG8_BAR
#undef PG8_SCHED
}
}
#include <hip/hip_bf16.h>
#include <cmath>
namespace attn_body {
using bf16=__hip_bfloat16;
using bf16x8=__attribute__((ext_vector_type(8)))short;
using s16x4=__attribute__((ext_vector_type(4)))short;
using f32x16=__attribute__((ext_vector_type(16)))float;
using u32x4=__attribute__((ext_vector_type(4)))unsigned;
constexpr int SEQ=8192,D=64,DM=1024;
constexpr int NW=8,QBLK=32,QB=QBLK*NW,KVBLK=64,NQB=SEQ/QB;
constexpr int ATTN_PITCH=DM, ATTN_UNIT_ROWS=QB;
__device__ __forceinline__ int crow(int r,int hi){return (r&3)+8*(r>>2)+4*hi;}
#define SBAR() __builtin_amdgcn_sched_barrier(0)
__device__ __forceinline__ void cmask(f32x16&p0,f32x16&p1,int jb,int qrel,int hi){
  const float NEG=-INFINITY; int kb=64*jb+4*hi;
  #pragma unroll
  for(int r=0;r<16;++r){int kv=kb+(r&3)+8*(r>>2); if(kv>qrel)p0[r]=NEG; if(kv+32>qrel)p1[r]=NEG;}
}

typedef __attribute__((address_space(3))) const float* lds_fptr;
__device__ __forceinline__ void bmask(f32x16&p0,f32x16&p1,int jb,int qrel,int hi,lds_fptr tab){
  lds_fptr tp=tab+(qrel-64*jb-4*hi+196);
  #pragma unroll
  for(int r=0;r<16;++r){const int off=(r&3)+8*(r>>2); p0[r]+=tp[59-off]; p1[r]+=tp[27-off];}
}
constexpr int NSLOT=3, SLOTB=8192;
constexpr int LDS_K=0, LDS_V=NSLOT*SLOTB, LDS_WS=2*NSLOT*SLOTB, LDS_OST=LDS_WS+NW*64*4, LDS_BYTES=LDS_OST+NW*4096;
constexpr float C2=0.125f*1.4426950408889634f;
__device__ __forceinline__ void glds16(const void*gsrc,unsigned lds_dst){unsigned keep;
  asm volatile("s_mov_b32 %0, m0\n\ts_mov_b32 m0, %2\n\ts_nop 0\n\tglobal_load_lds_dwordx4 %1, off\n\ts_mov_b32 m0, %0":"=&s"(keep):"v"(gsrc),"s"(lds_dst):"memory");}
__device__ __forceinline__ float max3f(float a,float b,float c){float r;asm("v_max3_f32 %0, %1, %2, %3":"=v"(r):"v"(a),"v"(b),"v"(c));return r;}
__device__ __forceinline__ float max2f(float a,float b){float r;asm("v_max_f32_e32 %0, %1, %2":"=v"(r):"v"(a),"v"(b));return r;}
__device__ __forceinline__ float fadd_s(float a,float b){float r;asm("v_add_f32_e32 %0, %1, %2":"=v"(r):"v"(a),"v"(b));return r;}
__device__ __forceinline__ float fsub_s(float a,float b){float r;asm("v_sub_f32_e32 %0, %1, %2":"=v"(r):"v"(a),"v"(b));return r;}
typedef float f32x2_t __attribute__((ext_vector_type(2))); typedef __bf16 bf16x2_t __attribute__((ext_vector_type(2)));
__device__ __forceinline__ unsigned cvtpk_s(float lo,float hi){f32x2_t v={lo,hi};bf16x2_t b=__builtin_convertvector(v,bf16x2_t);return __builtin_bit_cast(unsigned,b);}
#define WAIT_BAR(N) asm volatile("s_waitcnt vmcnt(" #N ") lgkmcnt(0)\n\ts_barrier":::"memory")

__device__ __forceinline__ void qkt(f32x16&p0,f32x16&p1,const char*Kslot,const bf16x8*qr,const f32x16&negm,int r32,int hi){
  const char*kb=Kslot+hi*1024+r32*16;
  #pragma unroll
  for(int d0=0;d0<4;++d0){
    const bf16x8 b0=*reinterpret_cast<const bf16x8*>(kb+d0*2048);
    const bf16x8 b1=*reinterpret_cast<const bf16x8*>(kb+d0*2048+512);
    if(d0==0){p0=__builtin_amdgcn_mfma_f32_32x32x16_bf16(b0,qr[0],negm,0,0,0);p1=__builtin_amdgcn_mfma_f32_32x32x16_bf16(b1,qr[0],negm,0,0,0);}
    else{p0=__builtin_amdgcn_mfma_f32_32x32x16_bf16(b0,qr[d0],p0,0,0,0);p1=__builtin_amdgcn_mfma_f32_32x32x16_bf16(b1,qr[d0],p1,0,0,0);}}
}
typedef __attribute__((address_space(3))) const char* lds_cptr;
typedef short v4i16_t __attribute__((ext_vector_type(4)));
__device__ __forceinline__ void kload8(bf16x8*kf,lds_cptr kp){
  kf[0]=*(const __attribute__((address_space(3))) bf16x8*)(kp);      kf[1]=*(const __attribute__((address_space(3))) bf16x8*)(kp+512);
  kf[2]=*(const __attribute__((address_space(3))) bf16x8*)(kp+2048); kf[3]=*(const __attribute__((address_space(3))) bf16x8*)(kp+2560);
  kf[4]=*(const __attribute__((address_space(3))) bf16x8*)(kp+4096); kf[5]=*(const __attribute__((address_space(3))) bf16x8*)(kp+4608);
  kf[6]=*(const __attribute__((address_space(3))) bf16x8*)(kp+6144); kf[7]=*(const __attribute__((address_space(3))) bf16x8*)(kp+6656);
}
__device__ __forceinline__ void kload2(bf16x8*kf,lds_cptr kp,int j){ kf[2*j]=*(const __attribute__((address_space(3))) bf16x8*)(kp+j*2048); kf[2*j+1]=*(const __attribute__((address_space(3))) bf16x8*)(kp+j*2048+512); }
__device__ __forceinline__ s16x4 vtr(lds_cptr p){ return __builtin_bit_cast(s16x4,__builtin_amdgcn_ds_read_tr16_b64_v4i16((__attribute__((address_space(3))) v4i16_t*)p)); }
__device__ __forceinline__ float rowmax(const f32x16&p0,const f32x16&p1){
  float a=max3f(p0[0],p0[1],p1[0]),b=max3f(p0[2],p0[3],p1[1]);a=max3f(a,p1[2],p1[3]);
  #pragma unroll
  for(int r=4;r<16;r+=4){a=max3f(a,p0[r],p0[r+1]);b=max3f(b,p0[r+2],p0[r+3]);a=max3f(a,p1[r],p1[r+1]);b=max3f(b,p1[r+2],p1[r+3]);}
  const float m=max2f(a,b);
  auto rr=__builtin_amdgcn_permlane32_swap(__float_as_uint(m),__float_as_uint(m),false,false);
  return max2f(__uint_as_float(rr[0]),__uint_as_float(rr[1]));
}
__device__ __forceinline__ void pv(f32x16*o,int vb,bf16x8 pa0,bf16x8 pa1,bf16x8 pa2,bf16x8 pa3){
  #pragma unroll
  for(int d0=0;d0<2;++d0){s16x4 lo[4],hi[4];
    #pragma unroll
    for(int ks=0;ks<4;++ks){
      asm volatile("ds_read_b64_tr_b16 %0,%1 offset:%c2":"=&v"(lo[ks]):"v"(vb),"i"(d0*4096+ks*1024):"memory");
      asm volatile("ds_read_b64_tr_b16 %0,%1 offset:%c2":"=&v"(hi[ks]):"v"(vb),"i"(d0*4096+ks*1024+512):"memory");}
    asm volatile("s_waitcnt lgkmcnt(0)":::"memory");SBAR();
    #define PK(k) (bf16x8){lo[k][0],lo[k][1],lo[k][2],lo[k][3],hi[k][0],hi[k][1],hi[k][2],hi[k][3]}
    o[d0]=__builtin_amdgcn_mfma_f32_32x32x16_bf16(pa0,PK(0),o[d0],0,0,0);
    o[d0]=__builtin_amdgcn_mfma_f32_32x32x16_bf16(pa1,PK(1),o[d0],0,0,0);
    o[d0]=__builtin_amdgcn_mfma_f32_32x32x16_bf16(pa2,PK(2),o[d0],0,0,0);
    o[d0]=__builtin_amdgcn_mfma_f32_32x32x16_bf16(pa3,PK(3),o[d0],0,0,0);
    #undef PK
  }
}

#ifndef ATTN_STORE16
#define ATTN_STORE16(p,v) (*(u32x4*)(p)=(v))
#endif
template<int THRL> __device__ __forceinline__ void attn_unit(int qb,const bf16*Q,const bf16*__restrict__ K,const bf16*__restrict__ V,bf16*O,lds_fptr tab,char*shm){
  __builtin_amdgcn_sched_barrier(0); int tid_=threadIdx.x; asm volatile("":"+v"(tid_));
  const int tid=tid_,lane=tid&63,r32=lane&31,hi=lane>>5; const int wid=__builtin_amdgcn_readfirstlane(tid>>6);
  const int q0=qb*QB;
  const bf16*Qw=Q+(long)(q0+wid*QBLK)*DM;
  const bf16*Kh=K,*Vh=V;
  const unsigned lds0=(unsigned)(uintptr_t)shm;
  float*wsf=(float*)(shm+LDS_WS)+wid*64;
  const bf16*ksrc=Kh+(long)lane*DM+wid*8;
  const bf16*vsrc=Vh+(long)(16*(wid&3)+(lane>>2))*DM+(wid>>2)*32+(lane&3)*8;
  const unsigned kdst=lds0+LDS_K+wid*1024, vdst=lds0+LDS_V+wid*1024;
  #define DMA_K(t,slot) glds16(ksrc+(long)(t)*KVBLK*DM,(unsigned)__builtin_amdgcn_readfirstlane(kdst+(slot)))
  #define DMA_V(t,slot) glds16(vsrc+(long)(t)*KVBLK*DM,(unsigned)__builtin_amdgcn_readfirstlane(vdst+(slot)))
  const int vb0=(int)(lds0+LDS_V)+((lane>>4)&1)*32+(lane&3)*8+(4*hi+((lane&15)>>2))*64;
  const char*Kbase=shm+LDS_K; bf16x8 kf[8];
  const lds_cptr shm3=(lds_cptr)shm; const lds_cptr kp0=shm3+LDS_K+hi*1024+r32*16; const lds_cptr vp0=shm3+LDS_V+((lane>>4)&1)*32+(lane&3)*8+(4*hi+((lane&15)>>2))*64;
  const int NT=(q0+QB)/KVBLK;
  DMA_K(0,0);DMA_V(0,0);DMA_K(1,SLOTB);
  bf16x8 qr[4];
  #pragma unroll
  for(int d0=0;d0<4;++d0)qr[d0]=*reinterpret_cast<const bf16x8*>(&Qw[(long)r32*DM+d0*16+hi*8]);
  float mhat=0.f,l_reg=0.f;f32x16 o[2];o[0]=f32x16{};o[1]=f32x16{};f32x16 negm=f32x16{};asm volatile("":"+v"(negm));
  const int qrel=wid*QBLK+r32;
  #define CMASK(P0,P1,t) do{int jb_=(t)-(NT-4); if(jb_>=-2)bmask(P0,P1,jb_,qrel,hi,tab);}while(0)
  bool resc=false;
  #define START(P0,P1) do{ const float rm=rowmax(P0,P1); resc=false; \
    { const float dl=rm; mhat=fadd_s(mhat,dl); \
      _Pragma("unroll") for(int r=0;r<16;++r){P0[r]=fsub_s(P0[r],dl);P1[r]=fsub_s(P1[r],dl);} \
      _Pragma("unroll") for(int r=0;r<16;++r)negm[r]=-mhat; asm volatile("":"+v"(negm)); } \
    _Pragma("unroll") for(int r=0;r<16;++r)P0[r]=__builtin_amdgcn_exp2f(P0[r]); }while(0)
  #define RESC() do{ if(resc){ asm volatile("s_waitcnt lgkmcnt(0)":::"memory"); \
      _Pragma("unroll") for(int d_=0;d_<2;++d_) _Pragma("unroll") for(int r=0;r<16;++r)o[d_][r]*=wsf[crow(r,hi)]; } }while(0)
  f32x16 pA0,pA1,pB0,pB1;
  int sl_prev=0,sl_cur=0,sl_next=SLOTB;
  #define ROT() do{sl_prev=sl_cur;sl_cur=sl_next;sl_next=(sl_next==(NSLOT-1)*SLOTB)?0:sl_next+SLOTB;}while(0)
  DMA_K(2,2*SLOTB);
  WAIT_BAR(3);
  qkt(pA0,pA1,Kbase,qr,negm,r32,hi);asm volatile("s_nop 15\n\ts_nop 7":"+v"(pA0),"+v"(pA1));CMASK(pA0,pA1,0);
  START(pA0,pA1);
  _Pragma("unroll") for(int r=0;r<16;++r)pA1[r]=__builtin_amdgcn_exp2f(pA1[r]);
  WAIT_BAR(0);
  DMA_K(3,0);DMA_V(1,SLOTB);
  ROT();
  kload8(kf,kp0+sl_cur);
  WAIT_BAR(2);
  s16x4 vlo[8],vhi[8]; u32x4 pw0,pw1,pw2,pw3;
  #define PKW(P,B) cvtpk_s(P[B],P[B+1])
  #define PAF(k) __builtin_bit_cast(bf16x8,pw##k)
  #define VFR(i) (bf16x8){vlo[i][0],vlo[i][1],vlo[i][2],vlo[i][3],vhi[i][0],vhi[i][1],vhi[i][2],vhi[i][3]}
  #define PIN(x) asm volatile("":"+v"(x))
  #define MX3(a,b,c) __builtin_fmaxf(__builtin_fmaxf((a),(b)),(c))
  #define GAPA(MF,A0,A1,A2,A3,W0,W1,PW) do{ MF; sacc+=A0; sacc+=A1; sacc+=A2; sacc+=A3; PIN(sacc); W0; W1; PIN(PW); SBAR(); }while(0)
  #define EX(v) __builtin_amdgcn_exp2f(v)
  #define GAPB(MF,X,B) do{ MF; X[B]=EX(X[B]); X[B+1]=EX(X[B+1]); X[B+2]=EX(X[B+2]); X[B+3]=EX(X[B+3]); PIN(X); SBAR(); }while(0)
  #define VRD(i) do{ vlo[i]=vtr(vp_+(((i)>>2)*4096+((i)&3)*1024)); vhi[i]=vtr(vp_+(((i)>>2)*4096+((i)&3)*1024+512)); }while(0)
  #define KRD(G,j) do{ if(G){ kload2(kf,kp0+sl_next,j); SBAR(); } }while(0)
  #define STEP(C0,C1,P0,P1,t,GK,GV,GL) do{ SBAR(); \
    const lds_cptr vp_=vp0+sl_prev; \
    VRD(0); SBAR(); float sacc=(P0[0]+P0[1]); \
    GAPA(C0=__builtin_amdgcn_mfma_f32_32x32x16_bf16(kf[0],qr[0],negm,0,0,0), P0[2],P0[3],P0[4],P0[5],     pw0[0]=PKW(P0,0), pw0[1]=PKW(P0,2), pw0); \
    VRD(4); SBAR(); GAPA(C1=__builtin_amdgcn_mfma_f32_32x32x16_bf16(kf[1],qr[0],negm,0,0,0), P0[6],P0[7],P0[8],P0[9],     pw0[2]=PKW(P0,4), pw0[3]=PKW(P0,6), pw0); \
    VRD(1); SBAR(); GAPA(C0=__builtin_amdgcn_mfma_f32_32x32x16_bf16(kf[2],qr[1],C0,0,0,0),   P0[10],P0[11],P0[12],P0[13], pw1[0]=PKW(P0,8), pw1[1]=PKW(P0,10), pw1); \
    VRD(5); SBAR(); GAPA(C1=__builtin_amdgcn_mfma_f32_32x32x16_bf16(kf[3],qr[1],C1,0,0,0),   P0[14],P0[15],P1[0],P1[1],   pw1[2]=PKW(P0,12),pw1[3]=PKW(P0,14), pw1); \
    VRD(2); SBAR(); GAPA(C0=__builtin_amdgcn_mfma_f32_32x32x16_bf16(kf[4],qr[2],C0,0,0,0),   P1[2],P1[3],P1[4],P1[5],     pw2[0]=PKW(P1,0), pw2[1]=PKW(P1,2), pw2); \
    VRD(6); SBAR(); GAPA(C1=__builtin_amdgcn_mfma_f32_32x32x16_bf16(kf[5],qr[2],C1,0,0,0),   P1[6],P1[7],P1[8],P1[9],     pw2[2]=PKW(P1,4), pw2[3]=PKW(P1,6), pw2); \
    VRD(3); SBAR(); GAPA(C0=__builtin_amdgcn_mfma_f32_32x32x16_bf16(kf[6],qr[3],C0,0,0,0),   P1[10],P1[11],P1[12],P1[13], pw3[0]=PKW(P1,8), pw3[1]=PKW(P1,10), pw3); \
    VRD(7); SBAR(); GAPA(C1=__builtin_amdgcn_mfma_f32_32x32x16_bf16(kf[7],qr[3],C1,0,0,0),   P1[14],P1[15],0.f,0.f,       pw3[2]=PKW(P1,12),pw3[3]=PKW(P1,14), pw3); \
    l_reg+=sacc; \
    if(GK){DMA_K((t)+3,sl_cur);} if(GV){DMA_V((t)+1,sl_next);} \
    CMASK(C0,C1,t); \
    { float a=MX3(C0[0],C0[1],C1[0]),b=MX3(C0[2],C0[3],C1[1]); a=MX3(a,C1[2],C1[3]); \
      _Pragma("unroll") for(int r=4;r<16;r+=4){a=MX3(a,C0[r],C0[r+1]);b=MX3(b,C0[r+2],C0[r+3]);a=MX3(a,C1[r],C1[r+1]);b=MX3(b,C1[r+2],C1[r+3]);} \
      float rm=__builtin_fmaxf(a,b); { auto rr=__builtin_amdgcn_permlane32_swap(__float_as_uint(rm),__float_as_uint(rm),false,false); rm=__builtin_fmaxf(__uint_as_float(rr[0]),__uint_as_float(rr[1])); } \
      resc=false; \
      if(__builtin_expect(__any(rm>(float)THRL),0)){ const float dl=__builtin_fmaxf(rm,0.f); mhat+=dl; \
        _Pragma("unroll") for(int r=0;r<16;++r){C0[r]-=dl;C1[r]-=dl;} \
        _Pragma("unroll") for(int r=0;r<16;++r)negm[r]=-mhat; asm volatile("":"+v"(negm)); \
        const float f=__builtin_amdgcn_exp2f(-dl); l_reg*=f; if(hi==0)wsf[r32]=f; resc=true; } } \
    SBAR(); \
    GAPB(o[0]=__builtin_amdgcn_mfma_f32_32x32x16_bf16(PAF(0),VFR(0),o[0],0,0,0), C0,0); \
    GAPB(o[1]=__builtin_amdgcn_mfma_f32_32x32x16_bf16(PAF(0),VFR(4),o[1],0,0,0), C0,4); \
    KRD(GL,0); GAPB(o[0]=__builtin_amdgcn_mfma_f32_32x32x16_bf16(PAF(1),VFR(1),o[0],0,0,0), C0,8); \
    KRD(GL,1); GAPB(o[1]=__builtin_amdgcn_mfma_f32_32x32x16_bf16(PAF(1),VFR(5),o[1],0,0,0), C0,12); \
    KRD(GL,2); GAPB(o[0]=__builtin_amdgcn_mfma_f32_32x32x16_bf16(PAF(2),VFR(2),o[0],0,0,0), C1,0); \
    KRD(GL,3); GAPB(o[1]=__builtin_amdgcn_mfma_f32_32x32x16_bf16(PAF(2),VFR(6),o[1],0,0,0), C1,4); \
    GAPB(o[0]=__builtin_amdgcn_mfma_f32_32x32x16_bf16(PAF(3),VFR(3),o[0],0,0,0), C1,8); \
    GAPB(o[1]=__builtin_amdgcn_mfma_f32_32x32x16_bf16(PAF(3),VFR(7),o[1],0,0,0), C1,12); \
    }while(0)
  int t=1;
  #undef CMASK
  #define CMASK(P0,P1,t) do{}while(0)
  for(;t+7<NT;t+=2){
    STEP(pB0,pB1,pA0,pA1,t,true,true,true);     WAIT_BAR(2); RESC(); ROT();
    STEP(pA0,pA1,pB0,pB1,t+1,true,true,true);   WAIT_BAR(2); RESC(); ROT();
  }
  #undef CMASK
  #define CMASK(P0,P1,t) do{int jb_=(t)-(NT-4); if(jb_>=-2)bmask(P0,P1,jb_,qrel,hi,tab);}while(0)
  #define ENDW(tt) do{ if((tt)+3<NT){WAIT_BAR(2);} else if((tt)+2<NT){WAIT_BAR(1);} else {WAIT_BAR(0);} }while(0)
  for(;t+1<NT;t+=2){
    STEP(pB0,pB1,pA0,pA1,t,(t+3<NT),(t+1<NT),(t+1<NT));       ENDW(t);   RESC(); ROT();
    STEP(pA0,pA1,pB0,pB1,t+1,(t+4<NT),(t+2<NT),(t+2<NT));     ENDW(t+1); RESC(); ROT();
  }
  STEP(pB0,pB1,pA0,pA1,NT-1,false,false,false); RESC();
  { float sacc=pB0[0]+pB0[1]; _Pragma("unroll") for(int r=2;r<16;++r)sacc+=pB0[r]; _Pragma("unroll") for(int r=0;r<16;++r)sacc+=pB1[r]; l_reg+=sacc;
    pw0=(u32x4){PKW(pB0,0),PKW(pB0,2),PKW(pB0,4),PKW(pB0,6)};pw1=(u32x4){PKW(pB0,8),PKW(pB0,10),PKW(pB0,12),PKW(pB0,14)};pw2=(u32x4){PKW(pB1,0),PKW(pB1,2),PKW(pB1,4),PKW(pB1,6)};pw3=(u32x4){PKW(pB1,8),PKW(pB1,10),PKW(pB1,12),PKW(pB1,14)};
    SBAR(); pv(o,vb0+sl_cur,PAF(0),PAF(1),PAF(2),PAF(3)); }
  #undef PKW
  #undef PAF
  #undef VFR
  #undef PIN
  #undef MX3
  #undef GAPA
  #undef GAPB
  #undef EX
  #undef VRD
  #undef KRD
  #undef STEP
  #undef ENDW
  {auto rr=__builtin_amdgcn_permlane32_swap(__float_as_uint(l_reg),__float_as_uint(l_reg),false,false);l_reg=__uint_as_float(rr[0])+__uint_as_float(rr[1]);}
  if(hi==0)wsf[32+r32]=l_reg;asm volatile("s_waitcnt lgkmcnt(0)":::"memory");
  float rli[16];
  #pragma unroll
  for(int r=0;r<16;++r)rli[r]=__builtin_amdgcn_rcpf(wsf[32+crow(r,hi)]);
  bf16*Ow=O+(long)(q0+wid*QBLK)*DM;
  { bf16*stg=(bf16*)(shm+LDS_OST)+wid*2048;
    #pragma unroll
    for(int r=0;r<16;++r){const int orow=crow(r,hi);
      #pragma unroll
      for(int d0=0;d0<2;++d0)stg[orow*64+d0*32+r32]=__float2bfloat16(o[d0][r]*rli[r]);}
    asm volatile("s_waitcnt lgkmcnt(0)":::"memory");
    #pragma unroll
    for(int i=0;i<4;++i){const int row=i*8+(lane>>3),ch=lane&7; const u32x4 v=*(const u32x4*)(stg+row*64+ch*8); ATTN_STORE16(Ow+(long)row*DM+ch*8,v);} }
  asm volatile("s_waitcnt lgkmcnt(0)\n\ts_barrier":::"memory");
  __builtin_amdgcn_sched_barrier(0);
  #undef DMA_K
  #undef DMA_V
  #undef CMASK
  #undef START
  #undef RESC
  #undef ROT
}
constexpr int ATTN_LDS_BYTES=LDS_BYTES;
#undef SBAR
#undef WAIT_BAR
}
constexpr int SEQ = 8192, DMODEL = 1024, M = 4 * SEQ, FF = 4096, COLS_A = 4608, COLS_B2 = 5120;
constexpr float LN_EPS = 1e-5f, LOG2E = 1.4426950408889634f;
constexpr float DN_ALPHA = 1.189207115002721f;
constexpr size_t MiB = 1u << 20;
constexpr size_t WS_WIN = 0, WS_WPA = 19 * MiB, WS_WPB = 20 * MiB, WS_WO = 22 * MiB, WS_W1 = 24 * MiB, WS_W2 = 32 * MiB;
constexpr size_t WS_R1 = 40 * MiB;
constexpr size_t WS_R2 = 328 * MiB;
constexpr size_t WS_OG = WS_R2, WS_LSE = WS_R2 + 96 * MiB;
constexpr size_t WS_XB = 427 * MiB;
constexpr size_t WS_OA = WS_R1, WS_QB = WS_R1 + 32 * MiB, WS_O1 = WS_R1 + 224 * MiB, WS_O2 = WS_R2;
constexpr size_t WS_OB = WS_R1 + 32 * MiB, WS_GATES = WS_R1 + 96 * MiB, WS_TMP = WS_R1 + 224 * MiB, WS_MERGED = WS_XB;
constexpr size_t WS_Z = WS_R1, WS_X1B = WS_XB, WS_H = WS_R1 + 128 * MiB, WS_CTL = 496 * MiB, CTL_BYTES = 16384, WS_END = 497 * MiB;
constexpr int RING_BYTES = 131072, LDS_BYTES = 147456;

#define GAS __attribute__((address_space(1)))
#define LAS __attribute__((address_space(3)))
typedef unsigned short bf16;
typedef unsigned v4u __attribute__((ext_vector_type(4)));
typedef unsigned v2u __attribute__((ext_vector_type(2)));
typedef float f32x4 __attribute__((ext_vector_type(4)));
typedef float f32x16 __attribute__((ext_vector_type(16)));
typedef short bf16x8 __attribute__((ext_vector_type(8)));
typedef short s16x4 __attribute__((ext_vector_type(4)));
#define LDS_WAIT() asm volatile("s_waitcnt lgkmcnt(0)" ::: "memory")
__device__ __forceinline__ unsigned f2bf(float f) { unsigned u = __builtin_bit_cast(unsigned, f); return (u + 0x7fffu + ((u >> 16) & 1u)) >> 16; }
__device__ __forceinline__ unsigned pk2(float lo, float hi) { return f2bf(lo) | (f2bf(hi) << 16); }
__device__ __forceinline__ float blo(unsigned w) { return __uint_as_float(w << 16); }
__device__ __forceinline__ float bhi(unsigned w) { return __uint_as_float(w & 0xffff0000u); }
__device__ __forceinline__ float wave_sum(float v) {
#pragma unroll
    for (int o = 1; o < 64; o <<= 1) v += __shfl_xor(v, o);
    return v;
}
__device__ __forceinline__ int t5_bucket(int n) {
    if (n < 16) return n;
    const float v = logf((float)n / 16.0f) / 2.0794415416798357f * 16.0f;
    int l = 16 + (int)v; return l > 31 ? 31 : l;
}
__device__ __forceinline__ void p0_transpose_item(const float* W, int K, int N, bf16* WT, LAS float* scr, int item, int lane) {
    const int nblk = N / 32, kb = item / nblk, nb = item % nblk, k0 = 64 * kb, n0 = 32 * nb;
#pragma unroll 8
    for (int i = 0; i < 32; ++i) { const int kk = 2 * i + (lane >> 5); scr[kk * 33 + (lane & 31)] = W[(size_t)(k0 + kk) * N + n0 + (lane & 31)]; }
    LDS_WAIT(); asm volatile("" ::: "memory");
    const int c = lane & 7;
#pragma unroll
    for (int j = 0; j < 4; ++j) { const int n = (lane >> 3) + 8 * j; const LAS float* s = scr + (8 * c) * 33 + n;
        v4u o; o.x = pk2(s[0 * 33], s[1 * 33]); o.y = pk2(s[2 * 33], s[3 * 33]); o.z = pk2(s[4 * 33], s[5 * 33]); o.w = pk2(s[6 * 33], s[7 * 33]);
        *(v4u*)(WT + (size_t)(n0 + n) * K + k0 + 8 * c) = o; }
    LDS_WAIT(); asm volatile("" ::: "memory");
}

namespace attn_a {
constexpr int KP = 144, VP = 192, LDS_KS = 0, LDS_VS = 384 * KP, LDS_TAB = 384 * KP + 384 * VP;
typedef __attribute__((address_space(3))) const char* lds_cptr;
typedef short v4i16_t __attribute__((ext_vector_type(4)));
__device__ __forceinline__ s16x4 vtr(lds_cptr p) { return __builtin_bit_cast(s16x4, __builtin_amdgcn_ds_read_tr16_b64_v4i16((__attribute__((address_space(3))) v4i16_t*)p)); }
typedef float f32x2_t __attribute__((ext_vector_type(2))); typedef __bf16 bf16x2_t __attribute__((ext_vector_type(2)));
__device__ __forceinline__ unsigned cvtpk(float lo, float hi) { f32x2_t v = {lo, hi}; bf16x2_t b = __builtin_convertvector(v, bf16x2_t); return __builtin_bit_cast(unsigned, b); }
__device__ __forceinline__ void unit(int g, int h, int blk, const bf16* qa, const bf16* ka, const bf16* va, bf16* og, float* lse, const float* rel_bias, LAS unsigned char* lds) {
    const int tid = threadIdx.x, lane = tid & 63, r32 = lane & 31, hi = lane >> 5; const int wid = __builtin_amdgcn_readfirstlane(tid >> 6);
    const int sh = 2 * g, Lm1 = (SEQ >> sh) - 1, p0 = blk * 256;
    const bool first = ((p0 & Lm1) == 0);
    const size_t gofs = (size_t)g * ((size_t)M * 512);
    const bf16* kg = ka + gofs + h * 64; const bf16* vg = va + gofs + h * 64;
#pragma unroll
    for (int it = 0; it < 6; ++it) { const int idx = it * 512 + tid, row = idx >> 3, ch = idx & 7; const long prow = (long)p0 - 128 + row;
        v4u kv4 = {0u, 0u, 0u, 0u}, vv4 = {0u, 0u, 0u, 0u};
        if (!(first && row < 128)) { kv4 = *(const v4u*)(kg + prow * 512 + ch * 8); vv4 = *(const v4u*)(vg + prow * 512 + ch * 8); }
        *(LAS v4u*)(lds + LDS_KS + row * KP + ch * 16) = kv4; *(LAS v4u*)(lds + LDS_VS + row * VP + ch * 16) = vv4; }
    LAS float* tab = (LAS float*)(lds + LDS_TAB);
    if (tid < 192) { const int st = tid - 32; tab[tid] = (st >= 0 && st <= 128) ? rel_bias[t5_bucket(st << sh) * 32 + g * 8 + h] * LOG2E : -INFINITY; }
    bf16x8 qr[4];
    { const bf16* qrow = qa + gofs + (size_t)(p0 + wid * 32 + r32) * 512 + h * 64 + hi * 8;
#pragma unroll
      for (int d0 = 0; d0 < 4; ++d0) qr[d0] = *(const bf16x8*)(qrow + d0 * 16); }
    __syncthreads();
    f32x16 S[5];
    { const LAS unsigned char* kb = lds + LDS_KS + (wid * 32 + r32) * KP + hi * 16;
#pragma unroll
      for (int c = 0; c < 5; ++c) { f32x16 a = {};
#pragma unroll
          for (int d0 = 0; d0 < 4; ++d0) { const bf16x8 kf = *(const LAS bf16x8*)(kb + c * 32 * KP + d0 * 32); a = __builtin_amdgcn_mfma_f32_32x32x16_bf16(kf, qr[d0], a, 0, 0, 0); }
          S[c] = a; } }
    float mx = -INFINITY;
    { const LAS float* tp = tab + (r32 - 4 * hi + 5);
#pragma unroll
      for (int c = 0; c < 5; ++c)
#pragma unroll
          for (int i = 0; i < 16; ++i) S[c][i] += tp[155 - 32 * c - ((i & 3) + 8 * (i >> 2))];
      if (first) {
#pragma unroll
          for (int c = 0; c < 5; ++c)
#pragma unroll
              for (int i = 0; i < 16; ++i) { const int cr = (i & 3) + 8 * (i >> 2) + 4 * hi; if (wid * 32 + 32 * c + cr < 128) S[c][i] = -INFINITY; } }
#pragma unroll
      for (int c = 0; c < 5; ++c)
#pragma unroll
          for (int i = 0; i < 16; i += 2) mx = fmaxf(fmaxf(mx, S[c][i]), S[c][i + 1]); }
    mx = fmaxf(mx, __shfl_xor(mx, 32));
    float l = 0.f;
#pragma unroll
    for (int c = 0; c < 5; ++c)
#pragma unroll
        for (int i = 0; i < 16; ++i) { const float p = __builtin_amdgcn_exp2f(S[c][i] - mx); S[c][i] = p; l += p; }
    l += __shfl_xor(l, 32);
    f32x16 O[2]; O[0] = f32x16{}; O[1] = f32x16{};
    { const lds_cptr vb = (lds_cptr)(lds + LDS_VS) + (wid * 32 + 4 * hi + ((lane & 15) >> 2)) * VP + ((lane >> 4) & 1) * 32 + (lane & 3) * 8;
#pragma unroll
      for (int c = 0; c < 5; ++c)
#pragma unroll
          for (int s = 0; s < 2; ++s) { v4u pw; pw.x = cvtpk(S[c][8 * s], S[c][8 * s + 1]); pw.y = cvtpk(S[c][8 * s + 2], S[c][8 * s + 3]); pw.z = cvtpk(S[c][8 * s + 4], S[c][8 * s + 5]); pw.w = cvtpk(S[c][8 * s + 6], S[c][8 * s + 7]);
              const bf16x8 pk = __builtin_bit_cast(bf16x8, pw);
#pragma unroll
              for (int db = 0; db < 2; ++db) { const s16x4 lo = vtr(vb + (c * 32 + 16 * s) * VP + db * 64), h4 = vtr(vb + (c * 32 + 16 * s + 8) * VP + db * 64);
                  const bf16x8 vf = (bf16x8){lo[0], lo[1], lo[2], lo[3], h4[0], h4[1], h4[2], h4[3]};
                  O[db] = __builtin_amdgcn_mfma_f32_32x32x16_bf16(vf, pk, O[db], 0, 0, 0); } } }
    const float rl = 1.0f / l;
    const int p = p0 + wid * 32 + r32, bb = p >> 13, pp = p & 8191, rr = pp >> (13 - sh), ii = pp & Lm1; const int tok = (bb << 13) + (ii << sh) + rr;
    bf16* orow = og + gofs + (size_t)tok * 512 + h * 64 + 4 * hi;
#pragma unroll
    for (int db = 0; db < 2; ++db)
#pragma unroll
        for (int k4 = 0; k4 < 4; ++k4) { v2u w; w.x = cvtpk(O[db][4 * k4] * rl, O[db][4 * k4 + 1] * rl); w.y = cvtpk(O[db][4 * k4 + 2] * rl, O[db][4 * k4 + 3] * rl);
            *(v2u*)(orow + 32 * db + 8 * k4) = w; }
    if (hi == 0) lse[(size_t)g * ((size_t)M * 8) + (size_t)tok * 8 + h] = mx + __builtin_amdgcn_logf(l);
    __syncthreads();
}
}
namespace attn_b2 {
constexpr int KBUF = 8192, VBUF = 16384, NKS = 4, NVS = 4, L_K = 0, L_V = NKS * KBUF, L_END = NKS * KBUF + NVS * VBUF;
typedef __attribute__((address_space(3))) const char* lds_cptr;
using attn_a::vtr; using attn_a::cvtpk;
__device__ __forceinline__ void glds16(const void* gsrc, unsigned lds_dst) { unsigned keep;
    asm volatile("s_mov_b32 %0, m0\n\ts_mov_b32 m0, %2\n\ts_nop 0\n\tglobal_load_lds_dwordx4 %1, off\n\ts_mov_b32 m0, %0" : "=&s"(keep) : "v"(gsrc), "s"(lds_dst) : "memory"); }
template <int THR> __device__ __forceinline__ void unit(int qb, const bf16* Q, const bf16* K, const bf16* V, bf16* O, attn_body::lds_fptr tab, LAS unsigned char* lds) {
    const int tid = threadIdx.x, lane = tid & 63, r32 = lane & 31, hi = lane >> 5; const int wid = __builtin_amdgcn_readfirstlane(tid >> 6);
    const int q0 = qb * 256, NT = 4 * qb + 4, qrel = wid * 32 + r32;
    const unsigned lds0 = (unsigned)(uintptr_t)lds;
    const int krow = 8 * wid + (lane >> 3), kc = (lane & 7) ^ ((krow >> 1) & 7);
    const bf16* ksrc = K + krow * 64 + kc * 8;
    const int vrow0 = 8 * wid + (lane >> 4), vrow1 = vrow0 + 4, vc0 = (lane & 15) ^ ((vrow0 & 3) << 2), vc1 = (lane & 15) ^ ((vrow1 & 3) << 2);
    const bf16* vsrc0 = V + vrow0 * 128 + vc0 * 8; const bf16* vsrc1 = V + vrow1 * 128 + vc1 * 8;
    const unsigned kdst = lds0 + L_K + wid * 1024, vdst = lds0 + L_V + wid * 2048;
#define B2_DMA(tile, ks, vs) do { const int tt_ = (tile) < NT ? (tile) : NT - 1; \
        glds16(ksrc + (size_t)tt_ * 4096, (unsigned)__builtin_amdgcn_readfirstlane(kdst + (ks) * KBUF)); \
        glds16(vsrc0 + (size_t)tt_ * 8192, (unsigned)__builtin_amdgcn_readfirstlane(vdst + (vs) * VBUF)); \
        glds16(vsrc1 + (size_t)tt_ * 8192, (unsigned)__builtin_amdgcn_readfirstlane(vdst + (vs) * VBUF + 1024)); } while (0)
#define B2_WAITBAR(n) asm volatile("s_waitcnt vmcnt(" #n ") lgkmcnt(0)\n\ts_barrier" ::: "memory")
    B2_DMA(0, 0, 0); B2_DMA(1, 1, 1);
    bf16x8 qr[4];
    { const bf16* qrow = Q + (size_t)(q0 + qrel) * 64 + hi * 8;
#pragma unroll
      for (int d0 = 0; d0 < 4; ++d0) qr[d0] = *(const bf16x8*)(qrow + d0 * 16); }
    asm volatile("s_waitcnt vmcnt(0)" ::: "memory");
    B2_WAITBAR(0);
    float m = 0.f, l = 0.f;
    f32x16 negm = f32x16{};
    f32x16 Oa[4]; Oa[0] = f32x16{}; Oa[1] = f32x16{}; Oa[2] = f32x16{}; Oa[3] = f32x16{};
    const int sw = (r32 >> 1) & 7;
    int aK[4];
#pragma unroll
    for (int d0 = 0; d0 < 4; ++d0) aK[d0] = L_K + r32 * 128 + (((2 * d0 + hi) ^ sw) << 4);
    const int q4 = (lane & 15) >> 2, blk = (lane >> 4) & 1, p = lane & 3;
    int aV[4];
#pragma unroll
    for (int db = 0; db < 4; ++db) aV[db] = L_V + (4 * hi + q4) * 256 + ((((db ^ q4) << 2) + blk * 2 + (p >> 1)) << 4) + (p & 1) * 8;
    const lds_cptr L3 = (lds_cptr)lds;
#define MX3(a, b, c) __builtin_fmaxf(__builtin_fmaxf((a), (b)), (c))
#define B2_PV(vslot, PK0) do { const int vo_ = (vslot) * VBUF; \
_Pragma("unroll") \
        for (int s = 0; s < 4; ++s) \
_Pragma("unroll") \
            for (int db = 0; db < 4; ++db) { const s16x4 lo = vtr(L3 + aV[db] + vo_ + s * 4096), h4 = vtr(L3 + aV[db] + vo_ + s * 4096 + 2048); \
                const bf16x8 vf = (bf16x8){lo[0], lo[1], lo[2], lo[3], h4[0], h4[1], h4[2], h4[3]}; \
                Oa[db] = __builtin_amdgcn_mfma_f32_32x32x16_bf16(vf, pk[(PK0) + s], Oa[db], 0, 0, 0); } } while (0)
#define B2_PACK(P0, P1, PK0) do { \
_Pragma("unroll") \
        for (int s = 0; s < 2; ++s) { v4u w0, w1; \
            w0.x = cvtpk(P0[8 * s], P0[8 * s + 1]); w0.y = cvtpk(P0[8 * s + 2], P0[8 * s + 3]); w0.z = cvtpk(P0[8 * s + 4], P0[8 * s + 5]); w0.w = cvtpk(P0[8 * s + 6], P0[8 * s + 7]); \
            w1.x = cvtpk(P1[8 * s], P1[8 * s + 1]); w1.y = cvtpk(P1[8 * s + 2], P1[8 * s + 3]); w1.z = cvtpk(P1[8 * s + 4], P1[8 * s + 5]); w1.w = cvtpk(P1[8 * s + 6], P1[8 * s + 7]); \
            pk[(PK0) + s] = __builtin_bit_cast(bf16x8, w0); pk[(PK0) + 2 + s] = __builtin_bit_cast(bf16x8, w1); } } while (0)
    bf16x8 pk[8];
#define B2_STEP2(t, FIRST) do { \
        const int sa = (t) & 2;                                          \
        B2_DMA((t) + 2, (sa + 2) & 3, (sa + 2) & 3); B2_DMA((t) + 3, (sa + 3) & 3, (sa + 3) & 3); \
        f32x16 p0 = negm, p1 = negm, p2 = negm, p3 = negm; \
_Pragma("unroll") \
        for (int d0 = 0; d0 < 4; ++d0) { \
            const bf16x8 ka0 = *(const LAS bf16x8*)(lds + aK[d0] + sa * KBUF), ka1 = *(const LAS bf16x8*)(lds + aK[d0] + sa * KBUF + 4096); \
            const bf16x8 kb0 = *(const LAS bf16x8*)(lds + aK[d0] + sa * KBUF + KBUF), kb1 = *(const LAS bf16x8*)(lds + aK[d0] + sa * KBUF + KBUF + 4096); \
            p0 = __builtin_amdgcn_mfma_f32_32x32x16_bf16(ka0, qr[d0], p0, 0, 0, 0); p1 = __builtin_amdgcn_mfma_f32_32x32x16_bf16(ka1, qr[d0], p1, 0, 0, 0); \
            p2 = __builtin_amdgcn_mfma_f32_32x32x16_bf16(kb0, qr[d0], p2, 0, 0, 0); p3 = __builtin_amdgcn_mfma_f32_32x32x16_bf16(kb1, qr[d0], p3, 0, 0, 0); } \
        if ((t) >= NT - 6) { attn_body::bmask(p0, p1, (t) - (NT - 4), qrel, hi, tab); attn_body::bmask(p2, p3, (t) + 1 - (NT - 4), qrel, hi, tab); } \
        float ra = MX3(p0[0], p0[1], p1[0]), rb = MX3(p0[2], p0[3], p1[1]); ra = MX3(ra, p1[2], p1[3]); \
        float rc = MX3(p2[0], p2[1], p3[0]), rd = MX3(p2[2], p2[3], p3[1]); rc = MX3(rc, p3[2], p3[3]); \
_Pragma("unroll") \
        for (int i = 4; i < 16; i += 4) { ra = MX3(ra, p0[i], p0[i + 1]); rb = MX3(rb, p0[i + 2], p0[i + 3]); ra = MX3(ra, p1[i], p1[i + 1]); rb = MX3(rb, p1[i + 2], p1[i + 3]); \
                                          rc = MX3(rc, p2[i], p2[i + 1]); rd = MX3(rd, p2[i + 2], p2[i + 3]); rc = MX3(rc, p3[i], p3[i + 1]); rd = MX3(rd, p3[i + 2], p3[i + 3]); } \
        float rm = fmaxf(fmaxf(ra, rb), fmaxf(rc, rd)); rm = fmaxf(rm, __shfl_xor(rm, 32)); \
        if ((FIRST) || __any(rm > (float)THR)) { const float dl = (FIRST) ? rm : fmaxf(rm, 0.f); m += dl; \
            if (!(FIRST)) { const float al = __builtin_amdgcn_exp2f(-dl); l *= al; \
_Pragma("unroll") \
                for (int db = 0; db < 4; ++db) \
_Pragma("unroll") \
                    for (int i = 0; i < 16; ++i) Oa[db][i] *= al; } \
_Pragma("unroll") \
            for (int i = 0; i < 16; ++i) { p0[i] -= dl; p1[i] -= dl; p2[i] -= dl; p3[i] -= dl; negm[i] = -m; } } \
        float sum = 0.f, sum2 = 0.f; \
_Pragma("unroll") \
        for (int i = 0; i < 16; ++i) { p0[i] = __builtin_amdgcn_exp2f(p0[i]); p1[i] = __builtin_amdgcn_exp2f(p1[i]); sum += p0[i] + p1[i]; } \
        B2_PACK(p0, p1, 0); \
_Pragma("unroll") \
        for (int i = 0; i < 16; ++i) { p2[i] = __builtin_amdgcn_exp2f(p2[i]); p3[i] = __builtin_amdgcn_exp2f(p3[i]); sum2 += p2[i] + p3[i]; } \
        l += sum + sum2; \
        B2_PACK(p2, p3, 4); \
        B2_PV(sa, 0); B2_PV(sa + 1, 4); \
        B2_WAITBAR(0); \
    } while (0)
    B2_STEP2(0, true);
    for (int t = 2; t < NT; t += 2) B2_STEP2(t, false);
#undef B2_STEP2
#undef B2_PACK
#undef MX3
#undef B2_PV
#undef B2_DMA
    l += __shfl_xor(l, 32);
    const float rl = 1.0f / l;
    bf16* orow = O + (size_t)(q0 + qrel) * 1024 + 4 * hi;
#pragma unroll
    for (int db = 0; db < 4; ++db)
#pragma unroll
        for (int k4 = 0; k4 < 4; ++k4) { v2u w; w.x = cvtpk(Oa[db][4 * k4] * rl, Oa[db][4 * k4 + 1] * rl); w.y = cvtpk(Oa[db][4 * k4 + 2] * rl, Oa[db][4 * k4 + 3] * rl);
            *(v2u*)(orow + 32 * db + 8 * k4) = w; }
    B2_WAITBAR(0);
#undef B2_WAITBAR
}
}

#define XB_TMO      128
#define XB_XCNT(j)  (256  + 64 * (j))
#define XB_XSUB(j)  (1280 + 64 * (j))
#define XB_XGEN(j)  (2304 + 64 * (j))
#define XB_TOP      3328
#define XB_TOPGEN   3392
#define XCD_BAR_WORDS 3456
#define XB_SPIN_CAP (1u << 18)

__device__ __forceinline__ unsigned xb_ld(unsigned* p)              { return __hip_atomic_load(p, __ATOMIC_RELAXED, __HIP_MEMORY_SCOPE_AGENT); }
__device__ __forceinline__ unsigned xb_add(unsigned* p, unsigned v) { return __hip_atomic_fetch_add(p, v, __ATOMIC_RELAXED, __HIP_MEMORY_SCOPE_AGENT); }
__device__ __forceinline__ unsigned xb_xcc_id() { return (unsigned)__builtin_amdgcn_s_getreg((3 << 11) | 20) & 0xFu; }
#define XB_SPIN(cond, bar) do { unsigned _sp = 0; while (cond) { __builtin_amdgcn_s_sleep(1); \
    if ((++_sp & 255u) == 0u) { if (xb_ld(&(bar)[XB_TMO])) break; if (_sp > XB_SPIN_CAP) { atomicAdd(&(bar)[XB_TMO], 1u); break; } } } } while (0)

struct XcdBarrier {
    unsigned* bar; unsigned x;
    volatile LAS unsigned* st;
};

__device__ __forceinline__ XcdBarrier xcd_barrier_post(unsigned* bar, volatile LAS unsigned* st) {
    XcdBarrier b; b.bar = bar; b.x = xb_xcc_id(); b.st = st;
    if (threadIdx.x == 0) (void)xb_add(&bar[XB_XCNT(b.x)], 1u);
    return b;
}
__device__ __forceinline__ void xcd_barrier_complete(unsigned* bar, unsigned x, unsigned& nloc, unsigned& nx) {
    const unsigned G = gridDim.x * gridDim.y * gridDim.z;
    unsigned sum, cnt, mine, sp = 0u;
    for (;;) {
        sum = 0u; cnt = 0u; mine = 0u;
#pragma unroll
        for (unsigned j = 0; j < 16; ++j) { const unsigned c = xb_ld(&bar[XB_XCNT(j)]); sum += c; cnt += (c > 0u) ? 1u : 0u; mine = (j == x) ? c : mine; }
        if (sum == G) break;
        __builtin_amdgcn_s_sleep(1);
        if ((++sp & 255u) == 0u) { if (xb_ld(&bar[XB_TMO])) break; if (sp > XB_SPIN_CAP) { atomicAdd(&bar[XB_TMO], 1u); break; } }
    }
    nloc = mine > 0u ? mine : 1u; nx = cnt > 0u ? cnt : 1u;
}

__device__ __forceinline__ void xcd_barrier(const XcdBarrier& b) {
    asm volatile("s_waitcnt vmcnt(0)" ::: "memory");
    __syncthreads();
    if (threadIdx.x == 0) {
        unsigned* bar = b.bar;
        __builtin_amdgcn_s_waitcnt(0);
        unsigned nloc = b.st[0], nx = b.st[1];
        if (nloc == 0u) { xcd_barrier_complete(bar, b.x, nloc, nx); b.st[0] = nloc; b.st[1] = nx; }
        const unsigned old = xb_add(&bar[XB_XSUB(b.x)], 1u);
        const unsigned gen = old / nloc;
        if (old + 1u == (gen + 1u) * nloc) {
            __builtin_amdgcn_fence(__ATOMIC_RELEASE, "agent");
            asm volatile("s_waitcnt vmcnt(0)" ::: "memory");
            const unsigned og = xb_add(&bar[XB_TOP], 1u);
            const unsigned tg = og / nx;
            if (og + 1u == (tg + 1u) * nx) xb_add(&bar[XB_TOPGEN], 1u);
            else XB_SPIN(xb_ld(&bar[XB_TOPGEN]) == tg, bar);
            __builtin_amdgcn_fence(__ATOMIC_ACQUIRE, "agent");
            xb_add(&bar[XB_XGEN(b.x)], 1u);
            asm volatile("s_waitcnt vmcnt(0)" ::: "memory");
        } else {
            XB_SPIN(xb_ld(&bar[XB_XGEN(b.x)]) == gen, bar);
            __builtin_amdgcn_fence(__ATOMIC_ACQUIRE, "agent");
            asm volatile("s_waitcnt vmcnt(0)" ::: "memory");
        }
    }
    __syncthreads();
}

constexpr int NPHASE = 12;
#ifndef MK_N_LAUNCHES
#define MK_N_LAUNCHES 1
#endif
struct Args { const float* in[18]; float* out; unsigned char* ws; int ph_lo, ph_hi; };
__device__ __forceinline__ void ln_rows(const float* zin, float* fout, bf16* bout, const float* gam, const float* bet, int gw, int ngw, int lane) {
    f32x4 gv[4], bv[4];
#pragma unroll
    for (int j = 0; j < 4; ++j) { gv[j] = *(const f32x4*)(gam + 4 * (64 * j + lane)); bv[j] = *(const f32x4*)(bet + 4 * (64 * j + lane)); }
    for (int m0 = gw; m0 < M; m0 += 2 * ngw) {
        f32x4 v[2][4]; float s1[2] = {0.f, 0.f};
#pragma unroll
        for (int r = 0; r < 2; ++r) { const f32x4* xr = (const f32x4*)(zin + (size_t)(m0 + r * ngw) * 1024) + lane;
#pragma unroll
            for (int j = 0; j < 4; ++j) v[r][j] = xr[64 * j]; }
#pragma unroll
        for (int r = 0; r < 2; ++r)
#pragma unroll
            for (int j = 0; j < 4; ++j) s1[r] += (v[r][j].x + v[r][j].y) + (v[r][j].z + v[r][j].w);
        float rstd[2];
#pragma unroll
        for (int r = 0; r < 2; ++r) { const float mean = wave_sum(s1[r]) * (1.f / 1024.f); float s2 = 0.f;
#pragma unroll
            for (int j = 0; j < 4; ++j) { v[r][j] = v[r][j] - mean; s2 += (v[r][j].x * v[r][j].x + v[r][j].y * v[r][j].y) + (v[r][j].z * v[r][j].z + v[r][j].w * v[r][j].w); }
            rstd[r] = 1.f / sqrtf(wave_sum(s2) * (1.f / 1024.f) + LN_EPS); }
#pragma unroll
        for (int r = 0; r < 2; ++r) { const size_t m = (size_t)(m0 + r * ngw); f32x4* fo = (f32x4*)(fout + m * 1024) + lane;
#pragma unroll
            for (int j = 0; j < 4; ++j) { v[r][j] = v[r][j] * rstd[r] * gv[j] + bv[j]; fo[64 * j] = v[r][j]; }
            if (bout) { v2u* bo = (v2u*)(bout + m * 1024) + lane;
#pragma unroll
                for (int j = 0; j < 4; ++j) { v2u w; w.x = pk2(v[r][j].x, v[r][j].y); w.y = pk2(v[r][j].z, v[r][j].w); bo[64 * j] = w; } } }
    }
}

__global__ void __launch_bounds__(512, 2) fwd_mega(Args args) {
    extern __shared__ __attribute__((aligned(16))) unsigned char lds[];
    cg::grid_group grid = cg::this_grid();
    LAS unsigned char* L = (LAS unsigned char*)lds;
    volatile LAS unsigned* bst = (volatile LAS unsigned*)(L + LDS_BYTES - 16);
    if (threadIdx.x < 2) bst[threadIdx.x] = 0u;
    __syncthreads();
    const XcdBarrier xbar = xcd_barrier_post((unsigned*)(args.ws + WS_CTL), bst);
    grid.sync();
#define TIDS const int tid = threadIdx.x, lane = tid & 63, wave = __builtin_amdgcn_readfirstlane(tid >> 6); (void)tid; (void)lane; (void)wave
#define GRIDV const int G = gridDim.x, bx = blockIdx.x, vcu = (bx & 7) * (G >> 3) + (bx >> 3); (void)vcu
#define WSP(name, off) bf16* name = (bf16*)(args.ws + (off))
#define IN(k) (args.ph_lo <= (k) && (k) < args.ph_hi)
#define SEAM(k) do { if (IN(k) && IN((k) + 1)) xcd_barrier(xbar); } while (0)

    if (IN(0)) {
        TIDS; GRIDV; const int gw = vcu * 8 + wave, ngw = G * 8; const float* x = args.in[0];
        WSP(WinT, WS_WIN); WSP(WpaT, WS_WPA); WSP(WpbT, WS_WPB); WSP(WoT, WS_WO); WSP(W1T, WS_W1); WSP(W2T, WS_W2); WSP(XB, WS_XB);
        LAS float* scr = (LAS float*)(L + wave * 16384);
        constexpr int I_IN = 16 * 304, I_PA = 8 * 32, I_PB = 16 * 32, I_O = 16 * 32, I_1 = 16 * 128, I_2 = 64 * 32;
        constexpr int NITEMS = I_IN + I_PA + I_PB + I_O + I_1 + I_2;
        for (int it = gw; it < NITEMS; it += ngw) {
            int r = it;
            if (r < I_IN) { p0_transpose_item(args.in[1], 1024, 9728, WinT, scr, r, lane); continue; } r -= I_IN;
            if (r < I_PA) { p0_transpose_item(args.in[9], 512, 1024, WpaT, scr, r, lane); continue; } r -= I_PA;
            if (r < I_PB) { p0_transpose_item(args.in[10], 1024, 1024, WpbT, scr, r, lane); continue; } r -= I_PB;
            if (r < I_O) { p0_transpose_item(args.in[11], 1024, 1024, WoT, scr, r, lane); continue; } r -= I_O;
            if (r < I_1) { p0_transpose_item(args.in[16], 1024, 4096, W1T, scr, r, lane); continue; } r -= I_1;
            p0_transpose_item(args.in[17], 4096, 1024, W2T, scr, r, lane);
        }
        for (int m = gw; m < M; m += ngw) {
            const f32x4* xr = (const f32x4*)(x + (size_t)m * 1024) + lane; v2u* bo = (v2u*)(XB + (size_t)m * 1024) + lane;
#pragma unroll
            for (int j = 0; j < 4; ++j) { const f32x4 v = xr[64 * j]; v2u w; w.x = pk2(v.x, v.y); w.y = pk2(v.z, v.w); bo[64 * j] = w; }
        }
    }
    SEAM(0);
    if (IN(1)) {
        GRIDV; WSP(XB, WS_XB); WSP(WinT, WS_WIN); WSP(QA, WS_R1);
        pg8::Gemm g{XB, WinT, M, COLS_A, 1024}; pg8::StaticOrder S; S.init(M, COLS_A, G, bx);
        pg8::EpiA E{QA};
        pg8::gemm_phase<pg8::EpiA, pg8::StaticOrder, true, true>(L, g, S, E);
    }
    SEAM(1);
    if (IN(2)) {
        GRIDV; WSP(QA, WS_R1); WSP(OG, WS_OG); float* LSE = (float*)(args.ws + WS_LSE);
        const bf16* KA = QA + (size_t)3 * M * 512; const bf16* VA = KA + (size_t)3 * M * 512;
        for (int u = vcu; u < 3072; u += G) attn_a::unit(u >> 10, (u >> 7) & 7, u & 127, QA, KA, VA, OG, LSE, args.in[8], L);
    }
    SEAM(2);
    if (IN(3)) {
        { TIDS; GRIDV; const int gw = vcu * 8 + wave, ngw = G * 8; WSP(OG, WS_OG); const float* LSE = (const float*)(args.ws + WS_LSE); WSP(OA, WS_OA);
          for (int m = gw; m < M; m += ngw) {
            { const int hh = lane >> 3; float l0 = LSE[(size_t)m * 8 + hh], l1 = LSE[(size_t)M * 8 + (size_t)m * 8 + hh], l2 = LSE[(size_t)2 * M * 8 + (size_t)m * 8 + hh];
              const float mx = fmaxf(l0, fmaxf(l1, l2)); float w0 = exp2f(l0 - mx), w1 = exp2f(l1 - mx), w2 = exp2f(l2 - mx); const float rs = 1.f / (w0 + w1 + w2); w0 *= rs; w1 *= rs; w2 *= rs;
              const v4u a = *(const v4u*)(OG + (size_t)m * 512 + lane * 8), b = *(const v4u*)(OG + (size_t)M * 512 + (size_t)m * 512 + lane * 8), c = *(const v4u*)(OG + (size_t)2 * M * 512 + (size_t)m * 512 + lane * 8);
              v4u o;
              o.x = pk2(w0 * blo(a.x) + w1 * blo(b.x) + w2 * blo(c.x), w0 * bhi(a.x) + w1 * bhi(b.x) + w2 * bhi(c.x));
              o.y = pk2(w0 * blo(a.y) + w1 * blo(b.y) + w2 * blo(c.y), w0 * bhi(a.y) + w1 * bhi(b.y) + w2 * bhi(c.y));
              o.z = pk2(w0 * blo(a.z) + w1 * blo(b.z) + w2 * blo(c.z), w0 * bhi(a.z) + w1 * bhi(b.z) + w2 * bhi(c.z));
              o.w = pk2(w0 * blo(a.w) + w1 * blo(b.w) + w2 * blo(c.w), w0 * bhi(a.w) + w1 * bhi(b.w) + w2 * bhi(c.w));
              *(v4u*)(OA + (size_t)m * 512 + lane * 8) = o; }
          } }
        GRIDV; WSP(XB, WS_XB); WSP(WinT, WS_WIN); WSP(QB, WS_QB);
        pg8::Gemm g{XB, WinT + (size_t)COLS_A * 1024, M, 3072, 1024}; pg8::StaticOrder S; S.init(M, 3072, G, bx);
        pg8::EpiB E{QB};
        pg8::gemm_phase<pg8::EpiB, pg8::StaticOrder, true, true>(L, g, S, E);
    }
    SEAM(3);
    if (IN(4)) {
        TIDS; GRIDV; WSP(QB, WS_QB); WSP(O1, WS_O1); WSP(O2, WS_O2);
        LAS float* btab = (LAS float*)(L + 100352);
        const float* rb = args.in[8];
        for (int i = tid; i < 8 * 640; i += 512) { const int hh = i / 640, d = i - hh * 640 - 255;
            btab[i] = d < 0 ? -INFINITY : (d < 128 ? (rb[t5_bucket(d) * 32 + 24 + hh] - rb[31 * 32 + 24 + hh]) * LOG2E : 0.f); }
        __syncthreads();
        const bf16* KB = QB + (size_t)M * 1024; const bf16* VB = KB + (size_t)M * 1024;
        for (int i = 0; i < 8; ++i) {
            const int sq = (vcu >> 3) * 2 + (i >> 2), k = i & 3, s = vcu & 7;
            const int qb = (k == 0) ? s : (k == 1) ? 15 - s : (k == 2) ? 16 + s : 31 - s;
            const int mp = sq & 1, hh = (sq >> 1) & 7, bb = sq >> 4;
            const size_t rb0 = (size_t)bb * SEQ * 1024;
            const size_t qk0 = (size_t)((bb * 16 + mp * 8 + hh) * SEQ) * 64, v0 = (size_t)((bb * 8 + hh) * SEQ) * 128;
            attn_b2::unit<8>(qb, QB + qk0, KB + qk0, VB + v0, (mp ? O2 : O1) + rb0 + hh * 128, (attn_body::lds_fptr)(btab + hh * 640), L);
        }
    }
    SEAM(4);
    if (IN(5)) {
        { TIDS; GRIDV; const int gw = vcu * 8 + wave, ngw = G * 8; WSP(O1, WS_O1); WSP(O2, WS_O2); WSP(OB, WS_OB);
          const float d1 = wave_sum(args.in[3][lane] * args.in[4][lane]), d2 = wave_sum(args.in[5][lane] * args.in[6][lane]);
          const float lam = expf(d1) - expf(d2) + 0.2f;
          const float* sg = args.in[7] + (lane & 7) * 16;
          float gsc[16];
#pragma unroll
          for (int e = 0; e < 16; ++e) gsc[e] = sg[e] * 0.8f;
          for (int m = gw; m < M; m += ngw) {
            { const v4u a0 = *(const v4u*)(O1 + (size_t)m * 1024 + lane * 16), a1 = *(const v4u*)(O1 + (size_t)m * 1024 + lane * 16 + 8);
              const v4u b0 = *(const v4u*)(O2 + (size_t)m * 1024 + lane * 16), b1 = *(const v4u*)(O2 + (size_t)m * 1024 + lane * 16 + 8);
              float d[16];
              d[0] = blo(a0.x) - lam * blo(b0.x); d[1] = bhi(a0.x) - lam * bhi(b0.x); d[2] = blo(a0.y) - lam * blo(b0.y); d[3] = bhi(a0.y) - lam * bhi(b0.y);
              d[4] = blo(a0.z) - lam * blo(b0.z); d[5] = bhi(a0.z) - lam * bhi(b0.z); d[6] = blo(a0.w) - lam * blo(b0.w); d[7] = bhi(a0.w) - lam * bhi(b0.w);
              d[8] = blo(a1.x) - lam * blo(b1.x); d[9] = bhi(a1.x) - lam * bhi(b1.x); d[10] = blo(a1.y) - lam * blo(b1.y); d[11] = bhi(a1.y) - lam * bhi(b1.y);
              d[12] = blo(a1.z) - lam * blo(b1.z); d[13] = bhi(a1.z) - lam * bhi(b1.z); d[14] = blo(a1.w) - lam * blo(b1.w); d[15] = bhi(a1.w) - lam * bhi(b1.w);
              float ss = 0.f;
#pragma unroll
              for (int e = 0; e < 16; ++e) ss += d[e] * d[e];
              ss += __shfl_xor(ss, 1); ss += __shfl_xor(ss, 2); ss += __shfl_xor(ss, 4);
              const float rn = 1.f / sqrtf(ss * (1.f / 128.f) + LN_EPS);
              v4u o0, o1;
              o0.x = pk2(d[0] * rn * gsc[0], d[1] * rn * gsc[1]); o0.y = pk2(d[2] * rn * gsc[2], d[3] * rn * gsc[3]); o0.z = pk2(d[4] * rn * gsc[4], d[5] * rn * gsc[5]); o0.w = pk2(d[6] * rn * gsc[6], d[7] * rn * gsc[7]);
              o1.x = pk2(d[8] * rn * gsc[8], d[9] * rn * gsc[9]); o1.y = pk2(d[10] * rn * gsc[10], d[11] * rn * gsc[11]); o1.z = pk2(d[12] * rn * gsc[12], d[13] * rn * gsc[13]); o1.w = pk2(d[14] * rn * gsc[14], d[15] * rn * gsc[15]);
              *(v4u*)(OB + (size_t)m * 1024 + lane * 16) = o0; *(v4u*)(OB + (size_t)m * 1024 + lane * 16 + 8) = o1; }
          } }
        GRIDV; WSP(XB, WS_XB); WSP(WinT, WS_WIN); WSP(GATES, WS_GATES);
        pg8::Gemm g{XB, WinT + (size_t)7680 * 1024, M, 2048, 1024}; pg8::StaticOrder S; S.init(M, 2048, G, bx);
        pg8::EpiSig E{GATES, args.in[2]};
        pg8::gemm_phase<pg8::EpiSig, pg8::StaticOrder, true, true>(L, g, S, E);
    }
    SEAM(5);
    if (IN(6)) {
        GRIDV; WSP(OA, WS_OA); WSP(OB, WS_OB); WSP(WpaT, WS_WPA); WSP(WpbT, WS_WPB); WSP(TMP, WS_TMP); WSP(MERGED, WS_MERGED); WSP(GATES, WS_GATES);
        { pg8::Gemm g{OA, WpaT, M, 1024, 512}; pg8::StaticOrder S; S.init(M, 1024, G, bx);
          pg8::EpiGate<false> E{GATES, nullptr, TMP};
          pg8::gemm_phase<pg8::EpiGate<false>, pg8::StaticOrder, true, true>(L, g, S, E); }
        { pg8::Gemm g{OB, WpbT, M, 1024, 1024}; pg8::StaticOrder S; S.init(M, 1024, G, bx);
          pg8::EpiGate<true> E{GATES + 1024, TMP, MERGED};
          pg8::gemm_phase<pg8::EpiGate<true>, pg8::StaticOrder, true, true>(L, g, S, E); }
    }
    SEAM(6);
    if (IN(7)) {
        GRIDV; WSP(MERGED, WS_MERGED); WSP(WoT, WS_WO); const float* x = args.in[0]; float* Z = (float*)(args.ws + WS_Z);
        pg8::Gemm g{MERGED, WoT, M, 1024, 1024}; pg8::StaticOrder S; S.init(M, 1024, G, bx);
        pg8::EpiZ E{x, Z, DN_ALPHA};
        pg8::gemm_phase<pg8::EpiZ, pg8::StaticOrder, true, true>(L, g, S, E);
    }
    SEAM(7);
    if (IN(8)) { TIDS; GRIDV; WSP(X1B, WS_X1B); float* Z = (float*)(args.ws + WS_Z); ln_rows(Z, Z, X1B, args.in[12], args.in[13], vcu * 8 + wave, G * 8, lane); }
    SEAM(8);
    if (IN(9)) {
        GRIDV; WSP(X1B, WS_X1B); WSP(W1T, WS_W1); WSP(HB, WS_H);
        pg8::Gemm g{X1B, W1T, M, FF, 1024}; pg8::StaticOrder S; S.init(M, FF, G, bx);
        pg8::EpiRelu2 E{HB};
        pg8::gemm_phase<pg8::EpiRelu2, pg8::StaticOrder, true, true>(L, g, S, E);
    }
    SEAM(9);
    if (IN(10)) {
        GRIDV; WSP(HB, WS_H); WSP(W2T, WS_W2);
        pg8::Gemm g{HB, W2T, M, 1024, FF}; pg8::StaticOrder S; S.init(M, 1024, G, bx);
        float* Z = (float*)(args.ws + WS_Z); pg8::EpiZ E{Z, Z, DN_ALPHA};
        pg8::gemm_phase<pg8::EpiZ, pg8::StaticOrder, true, true>(L, g, S, E);
    }
    SEAM(10);
    if (IN(11)) { TIDS; GRIDV; const float* Z = (const float*)(args.ws + WS_Z); ln_rows(Z, args.out, nullptr, args.in[14], args.in[15], vcu * 8 + wave, G * 8, lane); }
#undef IN
#undef SEAM
}

extern "C" void kernel_launch(void* const* d_in, const int* in_sizes, int n_in, void* d_out, int out_size, void* d_ws, size_t ws_size, hipStream_t stream) {
    static int grid = 0;
    if (grid == 0) {
        if (n_in != 18 || in_sizes[0] != M * DMODEL || out_size != M * DMODEL || ws_size < WS_END) { fprintf(stderr, "kernel_launch: unexpected shapes (n_in %d, x %d, out %d, ws %zu)\n", n_in, n_in > 0 ? in_sizes[0] : -1, out_size, ws_size); grid = -1; return; }
        int dev = 0, cus = 0, per_cu = 0;
        hipGetDevice(&dev); hipDeviceGetAttribute(&cus, hipDeviceAttributeMultiprocessorCount, dev);
        if (hipFuncSetAttribute((const void*)fwd_mega, hipFuncAttributeMaxDynamicSharedMemorySize, LDS_BYTES) != hipSuccess) { fprintf(stderr, "kernel_launch: hipFuncSetAttribute failed\n"); grid = -1; return; }
        if (hipOccupancyMaxActiveBlocksPerMultiprocessor(&per_cu, (const void*)fwd_mega, 512, LDS_BYTES) != hipSuccess || per_cu < 1) { fprintf(stderr, "kernel_launch: occupancy query says %d\n", per_cu); per_cu = 1; }
        (void)hipGetLastError();
        grid = cus * 1;
    }
    if (grid < 0) return;
    if (hipMemsetAsync((char*)d_ws + WS_CTL, 0, CTL_BYTES, stream) != hipSuccess) { fprintf(stderr, "kernel_launch: memset of the barrier words failed\n"); return; }
    Args a{};
    for (int i = 0; i < 18; ++i) a.in[i] = (const float*)d_in[i];
    a.out = (float*)d_out; a.ws = (unsigned char*)d_ws;
    constexpr int NL = MK_N_LAUNCHES;
    for (int li = 0; li < NL; ++li) {
        a.ph_lo = (NL == 1) ? 0 : li; a.ph_hi = (NL == 1) ? NPHASE : li + 1;
        void* kargs[] = {&a};
        const hipError_t e = hipLaunchCooperativeKernel((const void*)fwd_mega, dim3(grid), dim3(512), kargs, LDS_BYTES, stream);
        if (e != hipSuccess) { fprintf(stderr, "kernel_launch: cooperative launch %d failed: %s (grid %d)\n", li, hipGetErrorString(e), grid); break; }
    }
}
```
